# Optimizing an MI355X kernel written in HIP

```python
import jax, jax.numpy as jnp
from jax import lax
import numpy as np

D_MODEL = 1024
BATCH = 8
SEQ = 4096
DEPTH = 4

MIX_WIDTH = D_MODEL
HG_WIDTH = MIX_WIDTH // 2
LRU_WIDTH = MIX_WIDTH - HG_WIDTH
HG_HEADS = 4
HG_HEAD_DIM = HG_WIDTH // HG_HEADS
HG_CHUNK = 32
LB_FLOOR = 1e-30
LRU_HEADS = 8
LRU_HEAD_DIM = LRU_WIDTH // LRU_HEADS
LRU_C = 8.0
CONV_WIDTH = 4
CONV_PAD = (2, 1)
N_EXPERTS = 32
TOP_K = 4
D_EXPERT = D_MODEL
SWIGLU_LIMIT = 7.0
SWIGLU_ALPHA = 1.702
EXPERT_BLOCK = 256
DN_ALPHA = float((2 * DEPTH) ** 0.25)
DN_BETA = float((8 * DEPTH) ** -0.25)
LN_EPS = 1e-5
RMS_EPS = 1e-6
IN_COLS = 5 * HG_WIDTH + 2 * LRU_WIDTH

kernel_name = "hybrid_hgrn2_rglru_moe_deepnorm_encoder"


def _layernorm(t, g, b):
    tf = t.astype(jnp.float32)
    mu = jnp.mean(tf, axis=-1, keepdims=True)
    var = jnp.mean(jnp.square(tf - mu), axis=-1, keepdims=True)
    y = (tf - mu) * lax.rsqrt(var + LN_EPS) * g.astype(jnp.float32) + b.astype(jnp.float32)
    return y.astype(t.dtype)


def _rmsnorm(t, g):
    return t * lax.rsqrt(jnp.mean(jnp.square(t), axis=-1, keepdims=True) + RMS_EPS) * g


def _hgrn2_chunked(q, k, v, logf):
    b, sl, h, dk = q.shape
    dv = v.shape[-1]
    n = sl // HG_CHUNK
    blk = lambda t: t.reshape(b, n, HG_CHUNK, h, t.shape[-1])
    q, k, v, logf = blk(q), blk(k), blk(v), blk(logf)
    g = jnp.cumsum(logf, axis=2)
    g_ref = g[:, :, HG_CHUNK // 2 - 1:HG_CHUNK // 2]
    g_last = g[:, :, -1:]
    tri = jnp.tril(jnp.ones((HG_CHUNK, HG_CHUNK), dtype=bool))
    scores = jnp.einsum('bnthd,bnshd->bnhts', q * jnp.exp(g - g_ref), k * jnp.exp(g_ref - g))
    scores = jnp.where(tri, scores, 0.0)
    o_intra = jnp.einsum('bnhts,bnshv->bnthv', scores, v)
    chunk_kv = jnp.einsum('bnshd,bnshv->nbhdv', k * jnp.exp(g_last - g), v)
    chunk_decay = jnp.moveaxis(jnp.exp(g_last[:, :, 0]), 1, 0)

    def step(state, inp):
        dec, kv = inp
        return state * dec[..., None] + kv, state

    _, s_in = lax.scan(step, jnp.zeros((b, h, dk, dv), q.dtype), (chunk_decay, chunk_kv))
    o_inter = jnp.einsum('bnthd,nbhdv->bnthv', q * jnp.exp(g), s_in)
    return (o_intra + o_inter).reshape(b, sl, h, dv)


def _hgrn2_mixer(zq, zi, zf, zb, zg, lb, norm_g):
    b, sl, _ = zq.shape
    heads = lambda t: t.reshape(b, sl, HG_HEADS, HG_HEAD_DIM)
    q = heads(jax.nn.silu(zq.astype(jnp.float32)))
    v = heads(zi.astype(jnp.float32))

    def gates(z, lb_d):
        z = z.astype(jnp.float32)
        log_lb = jnp.log(jnp.maximum(lb_d, LB_FLOOR))
        logf = jnp.logaddexp(log_lb, jnp.log1p(-lb_d) + jax.nn.log_sigmoid(z))
        k = (1.0 - lb_d) * jax.nn.sigmoid(-z)
        return heads(k), heads(logf)

    k_f, logf_f = gates(zf, lb[0])
    k_b, logf_b = gates(zb, lb[1])
    o_f = _hgrn2_chunked(q, k_f, v, logf_f)
    rev = lambda t: jnp.flip(t, axis=1)
    o_b = rev(_hgrn2_chunked(rev(q), rev(k_b), rev(v), rev(logf_b)))
    o = _rmsnorm(o_f + o_b, norm_g.astype(jnp.float32).reshape(HG_HEADS, HG_HEAD_DIM))
    o = o.reshape(b, sl, HG_WIDTH) * jax.nn.silu(zg.astype(jnp.float32))
    return o


def _rg_lru(xc, wa, ba, wx, bx, lam, reverse):
    b, sl, w = xc.shape
    xh = xc.reshape(b, sl, LRU_HEADS, LRU_HEAD_DIM)
    r = jax.nn.sigmoid(jnp.einsum('bshi,hij->bshj', xh, wa.astype(jnp.float32)).reshape(b, sl, w)
                       + ba.astype(jnp.float32))
    i = jax.nn.sigmoid(jnp.einsum('bshi,hij->bshj', xh, wx.astype(jnp.float32)).reshape(b, sl, w)
                       + bx.astype(jnp.float32))
    log_a = -LRU_C * r * jax.nn.softplus(-lam.astype(jnp.float32))
    a = jnp.exp(log_a)
    u = jnp.sqrt(jnp.maximum(-jnp.expm1(2.0 * log_a), 0.0)) * (i * xc)

    def combine(e1, e2):
        a1, b1 = e1
        a2, b2 = e2
        return a1 * a2, a2 * b1 + b2

    _, h = lax.associative_scan(combine, (a, u), axis=1, reverse=reverse)
    return h


def _griffin_mixer(zx, zy, conv_w, conv_b, wa, ba, wx, bx, lam, norm_g):
    xc = lax.conv_general_dilated(zx, conv_w[:, None, :], window_strides=(1,), padding=[CONV_PAD],
                                  dimension_numbers=('NWC', 'WIO', 'NWC'),
                                  feature_group_count=LRU_WIDTH)
    xc = (xc + conv_b).astype(jnp.float32)
    h = (_rg_lru(xc, wa[0], ba[0], wx[0], bx[0], lam[0], False)
         + _rg_lru(xc, wa[1], ba[1], wx[1], bx[1], lam[1], True))
    return _rmsnorm(h, norm_g.astype(jnp.float32)) * jax.nn.gelu(zy.astype(jnp.float32))


def _moe(x2, router_w, router_b, w_gu, b_gu, w_dn, b_dn):
    t, d = x2.shape
    dt = x2.dtype
    logits = jnp.einsum('td,de->te', x2, router_w).astype(jnp.float32) + router_b.astype(jnp.float32)
    top_logits, top_idx = lax.top_k(logits, TOP_K)
    gates = jax.nn.softmax(top_logits, axis=-1)
    n_assign = t * TOP_K
    flat_e = top_idx.reshape(-1).astype(jnp.int32)
    flat_tok = jnp.arange(n_assign, dtype=jnp.int32) // TOP_K
    flat_w = gates.reshape(-1)
    order = jnp.argsort(flat_e)
    s_e, s_tok, s_w = flat_e[order], flat_tok[order], flat_w[order]
    counts = jnp.bincount(flat_e, length=N_EXPERTS).astype(jnp.int32)
    starts = jnp.cumsum(counts) - counts
    padded = ((counts + EXPERT_BLOCK - 1) // EXPERT_BLOCK) * EXPERT_BLOCK
    pends = jnp.cumsum(padded)
    pstarts = pends - padded
    dest = pstarts[s_e] + jnp.arange(n_assign, dtype=jnp.int32) - starts[s_e]
    n_rows = ((n_assign + EXPERT_BLOCK - 1) // EXPERT_BLOCK) * EXPERT_BLOCK + N_EXPERTS * EXPERT_BLOCK
    n_blocks = n_rows // EXPERT_BLOCK
    row_tok = jnp.zeros((n_rows,), jnp.int32).at[dest].set(s_tok).reshape(n_blocks, EXPERT_BLOCK)
    row_w = jnp.zeros((n_rows,), dt).at[dest].set(s_w.astype(dt)).reshape(n_blocks, EXPERT_BLOCK)
    blk_start = jnp.arange(n_blocks, dtype=jnp.int32) * EXPERT_BLOCK
    blk_e = jnp.minimum(jnp.searchsorted(pends, blk_start, side='right'), N_EXPERTS - 1).astype(jnp.int32)

    def body(out, inp):
        tok, wgt, e = inp
        xb = x2[tok]
        gu = xb @ w_gu[e] + b_gu[e]
        gate = jnp.minimum(gu[:, :D_EXPERT], SWIGLU_LIMIT)
        up = jnp.clip(gu[:, D_EXPERT:], -SWIGLU_LIMIT, SWIGLU_LIMIT)
        hid = (up + 1.0) * (gate * jax.nn.sigmoid(SWIGLU_ALPHA * gate))
        y = hid @ w_dn[e] + b_dn[e]
        return out.at[tok].add(y * wgt[:, None]), None

    out, _ = lax.scan(body, jnp.zeros_like(x2), (row_tok, row_w, blk_e))
    return out


def setup_inputs(seed: int = 0) -> dict:
    key = jax.random.key(seed)
    ks = jax.random.split(key, 24)
    f32 = jnp.float32
    L = DEPTH
    nrm = lambda k, shape, scale: jax.random.normal(k, shape, f32) * scale
    a0 = jax.random.uniform(ks[10], (L, 2, LRU_WIDTH), f32, 0.9, 0.999)
    return {
        "x": nrm(ks[0], (BATCH, SEQ, D_MODEL), 1.0),
        "w_in": nrm(ks[1], (L, D_MODEL, IN_COLS), D_MODEL ** -0.5),
        "hg_lb": nrm(ks[2], (L, 2, HG_WIDTH), 0.5),
        "hg_norm": 1.0 + nrm(ks[3], (L, HG_WIDTH), 0.02),
        "lru_conv_w": nrm(ks[4], (L, CONV_WIDTH, LRU_WIDTH), CONV_WIDTH ** -0.5),
        "lru_conv_b": nrm(ks[5], (L, LRU_WIDTH), 0.02),
        "lru_wa": nrm(ks[6], (L, 2, LRU_HEADS, LRU_HEAD_DIM, LRU_HEAD_DIM), LRU_HEAD_DIM ** -0.5),
        "lru_ba": nrm(ks[7], (L, 2, LRU_WIDTH), 0.02),
        "lru_wx": nrm(ks[8], (L, 2, LRU_HEADS, LRU_HEAD_DIM, LRU_HEAD_DIM), LRU_HEAD_DIM ** -0.5),
        "lru_bx": nrm(ks[9], (L, 2, LRU_WIDTH), 0.02),
        "lru_lambda": jnp.log(a0) - jnp.log1p(-a0),
        "lru_norm": 1.0 + nrm(ks[11], (L, LRU_WIDTH), 0.02),
        "w_out": nrm(ks[12], (L, MIX_WIDTH, D_MODEL), MIX_WIDTH ** -0.5 * DN_BETA),
        "ln1_g": 1.0 + nrm(ks[13], (L, D_MODEL), 0.02),
        "ln1_b": nrm(ks[14], (L, D_MODEL), 0.02),
        "router_w": nrm(ks[15], (L, D_MODEL, N_EXPERTS), D_MODEL ** -0.5),
        "router_b": nrm(ks[16], (L, N_EXPERTS), 0.01),
        "w_gate_up": nrm(ks[17], (L, N_EXPERTS, D_MODEL, 2 * D_EXPERT), D_MODEL ** -0.5),
        "b_gate_up": nrm(ks[18], (L, N_EXPERTS, 2 * D_EXPERT), 0.02),
        "w_down": nrm(ks[19], (L, N_EXPERTS, D_EXPERT, D_MODEL), D_EXPERT ** -0.5 * DN_BETA),
        "b_down": nrm(ks[20], (L, N_EXPERTS, D_MODEL), 0.02),
        "ln2_g": 1.0 + nrm(ks[21], (L, D_MODEL), 0.02),
        "ln2_b": nrm(ks[22], (L, D_MODEL), 0.02),
    }


def reference(x, w_in, hg_lb, hg_norm, lru_conv_w, lru_conv_b, lru_wa, lru_ba, lru_wx, lru_bx,
              lru_lambda, lru_norm, w_out, ln1_g, ln1_b, router_w, router_b, w_gate_up, b_gate_up,
              w_down, b_down, ln2_g, ln2_b):
    dt = x.dtype
    b, sl, d = x.shape
    p = jax.nn.softmax(hg_lb.astype(jnp.float32), axis=0)
    lower_bounds = jnp.clip(jnp.cumsum(p, axis=0) - p[0:1], 0.0, 1.0 - 1e-6)
    split_at = [HG_WIDTH * j for j in range(1, 6)] + [5 * HG_WIDTH + LRU_WIDTH]
    for l in range(DEPTH):
        proj = jnp.einsum('bsd,dc->bsc', x, w_in[l])
        zq, zi, zf, zb, zg, zx, zy = jnp.split(proj, split_at, axis=-1)
        o_hg = _hgrn2_mixer(zq, zi, zf, zb, zg, lower_bounds[l], hg_norm[l])
        o_lru = _griffin_mixer(zx, zy, lru_conv_w[l], lru_conv_b[l], lru_wa[l], lru_ba[l],
                               lru_wx[l], lru_bx[l], lru_lambda[l], lru_norm[l])
        mix = jnp.concatenate([o_hg, o_lru], axis=-1).astype(dt)
        y = jnp.einsum('bsc,cd->bsd', mix, w_out[l])
        x = _layernorm(DN_ALPHA * x + y, ln1_g[l], ln1_b[l])
        m = _moe(x.reshape(b * sl, d), router_w[l], router_b[l], w_gate_up[l], b_gate_up[l],
                 w_down[l], b_down[l]).reshape(b, sl, d)
        x = _layernorm(DN_ALPHA * x + m, ln2_g[l], ln2_b[l])
    return x
```

```cpp
#include <hip/hip_runtime.h>
#include <cstdio>
#include <cstdint>

#define GAS __attribute__((address_space(1)))
#define LAS __attribute__((address_space(3)))
typedef unsigned short bf16_t;
typedef short bf16x8 __attribute__((ext_vector_type(8)));
typedef float f32x4 __attribute__((ext_vector_type(4)));
typedef float f32x2 __attribute__((ext_vector_type(2)));
typedef unsigned u32x4 __attribute__((ext_vector_type(4)));
typedef unsigned u32x2 __attribute__((ext_vector_type(2)));

constexpr int BATCH = 8, SEQ = 4096, D = 1024, T = BATCH * SEQ, NL = 4;
constexpr int HGW = 512, LRW = 512, HGH = 4, HD = 128, LRH = 8, LHD = 64;
constexpr int INC = 3584, NE = 32, TOPK = 4, DE = 1024;
constexpr int ECAP = 32768;
constexpr int NSLOT = T * TOPK + NE * 256;
constexpr float ALPHA = 1.6817928305074290f;
constexpr float LN_EPS = 1e-5f, RMS_EPS = 1e-6f;
constexpr int NWAVES = 8, NTHR = 512;
constexpr int LDS_BYTES = 147456;

constexpr size_t MiB = 1u << 20;
constexpr size_t WS_CTL = 0, CTL_BYTES = 1 * MiB;
constexpr size_t WS_LBT = 1 * MiB;
constexpr size_t WS_RWH = 2 * MiB, WS_RWL = 3 * MiB;
constexpr size_t WS_WIN = 4 * MiB;
constexpr size_t WS_WOUT = 32 * MiB;
constexpr size_t WS_WGU = 40 * MiB;
constexpr size_t WS_WDN = 552 * MiB;
constexpr size_t WS_XB = 808 * MiB;
constexpr size_t WS_XRES = 872 * MiB;
constexpr size_t WS_PROJ = 1000 * MiB;
constexpr size_t WS_MIX = 1224 * MiB;
constexpr size_t WS_Y = 1288 * MiB;
constexpr size_t WS_X1 = 1416 * MiB;
constexpr size_t WS_X1B = 1544 * MiB;
constexpr size_t WS_HID = 1608 * MiB;
constexpr size_t WS_YS = 1880 * MiB;
constexpr size_t WS_RTOK = 2152 * MiB;
constexpr size_t WS_RGATE = 2156 * MiB;
constexpr size_t WS_TSLOT = 2160 * MiB;
constexpr size_t WS_ODIR = 2162 * MiB;
constexpr size_t WS_HDIR = 2290 * MiB;
constexpr size_t WS_AU = 2418 * MiB;
constexpr size_t WS_END = 2674 * MiB;
constexpr int CW_CNT = 1024;

#define LDS_WAIT() asm volatile("s_waitcnt lgkmcnt(0)" ::: "memory")
__device__ __forceinline__ unsigned f2bf(float f) { unsigned u = __builtin_bit_cast(unsigned, f); return (u + 0x7fffu + ((u >> 16) & 1u)) >> 16; }
__device__ __forceinline__ unsigned pk2(float lo, float hi) { return f2bf(lo) | (f2bf(hi) << 16); }
__device__ __forceinline__ float bf2f(unsigned b) { return __builtin_bit_cast(float, b << 16); }
__device__ __forceinline__ float wave_sum(float v) {
#pragma unroll
    for (int o = 1; o < 64; o <<= 1) v += __shfl_xor(v, o);
    return v;
}
__device__ __forceinline__ float sigmoidf_(float z) { return 1.0f / (1.0f + __expf(-z)); }

namespace pg8 {
constexpr int BM = 256, BK = 64, HALF = 128, HTB = HALF * BK * 2, STAGE_BYTES = 8 * HTB, NXCD = 8, WGM = 8;
constexpr int KD = 1024;
__host__ __device__ __forceinline__ int lds_byte(int r, int c) { const int st = (r >> 4) * 2 + (c >> 5), rr = r & 15, cc = c & 31, ob = rr * 64 + cc * 2; return st * 1024 + (ob ^ (((ob >> 9) & 1) << 5)); }
__host__ __device__ __forceinline__ void stage_rc(int b, int& R, int& C) { const int st = b / 1024, sb = b % 1024, swz = sb ^ (((sb >> 9) & 1) << 5); R = (st >> 1) * 16 + swz / 64; C = (st & 1) * 32 + (swz % 64) / 2; }
__host__ __device__ __forceinline__ int perm32(int rho) { const int n = rho >> 4, i = rho & 15; return 8 * (i >> 2) + 4 * n + (i & 3); }
struct Unit { int pm, pn, e, j; };
__device__ __forceinline__ unsigned cvt_pk_bf16(float lo, float hi) { unsigned r; asm volatile("v_cvt_pk_bf16_f32 %0, %1, %2" : "=v"(r) : "v"(lo), "v"(hi)); return r; }

struct StaticOrder {
    int nM, nN, nwg, G, c;
    __device__ void init(int M, int N, int G_, int c_) { nM = M / BM; nN = N / BM; nwg = nM * nN; G = G_; c = c_; }
    __device__ bool next(int i, Unit& u) const {
        const long L = (long)i * G + c; if (L >= nwg) return false;
        int wgid = (int)L; { const int q = nwg / NXCD, r = nwg % NXCD, xcd = wgid % NXCD, off = wgid / NXCD; wgid = (xcd < r ? xcd * (q + 1) : r * (q + 1) + (xcd - r) * q) + off; }
        const int nig = WGM * nN, gid = wgid / nig, fm = gid * WGM, gsz = (nM - fm) < WGM ? (nM - fm) : WGM;
        u.pm = fm + ((wgid % nig) % gsz); u.pn = (wgid % nig) / gsz; u.e = 0; u.j = 0; return true;
    }
};

template <class P>
__device__ __forceinline__ void gemm_phase(LAS unsigned char* lds, const P& p) {
    const int tid = threadIdx.x, wid = __builtin_amdgcn_readfirstlane(tid >> 6), lane = tid & 63, wr = wid >> 2, wc = wid & 3, fr = lane & 15, fq = lane >> 4;
    constexpr int K = KD, nt = K / BK;
    int RR[2], CC[2]; unsigned voffB[2];
#pragma unroll
    for (int i = 0; i < 2; ++i) { int R, C; stage_rc(tid * 16 + i * 8192, R, C); const int Rb = P::PERM ? ((R & ~31) + perm32(R & 31)) : R; RR[i] = R; CC[i] = C; voffB[i] = (unsigned)(Rb * K + C) * 2u; }
    constexpr unsigned hstepB = (unsigned)HALF * K * 2;
    const unsigned ldsw = (unsigned)wid * 1024u;
    const int aoff = lds_byte(wr * 64 + fr, fq * 8), boff = lds_byte(wc * 32 + fr, fq * 8);
    const char* const abase = p.a_base();
#define PG8_SA(b, h) (((b) * 2 + (h)) * HTB)
#define PG8_SB(b, h) ((4 + (b) * 2 + (h)) * HTB)
#define PG8_STAGE_A(bufoff, o, koff) do { _Pragma("unroll") for (int _i = 0; _i < 2; ++_i) \
        __builtin_amdgcn_global_load_lds((const unsigned*)(abase + (size_t)(o)[_i] + (koff)), (LAS unsigned*)(lds + (bufoff) + ldsw + _i * 8192), 16, 0, 0); } while (0)
#define PG8_STAGE_B(bufoff, gbase, koff) do { _Pragma("unroll") for (int _i = 0; _i < 2; ++_i) \
        __builtin_amdgcn_global_load_lds((const unsigned*)((gbase) + (size_t)(voffB[_i] + (koff))), (LAS unsigned*)(lds + (bufoff) + ldsw + _i * 8192), 16, 0, 0); } while (0)
#define PG8_LDA(dst, b, h) do { _Pragma("unroll") for (int m = 0; m < 4; ++m) _Pragma("unroll") for (int k = 0; k < 2; ++k) dst[m][k] = *(const LAS bf16x8*)(lds + PG8_SA(b, h) + aoff + m * 2048 + k * 1024); } while (0)
#define PG8_LDB(dst, b, h) do { _Pragma("unroll") for (int n = 0; n < 2; ++n) _Pragma("unroll") for (int k = 0; k < 2; ++k) dst[n][k] = *(const LAS bf16x8*)(lds + PG8_SB(b, h) + boff + n * 2048 + k * 1024); } while (0)
#define PG8_MMA(ai, bj, At, Bt) do { __builtin_amdgcn_s_setprio(1); _Pragma("unroll") for (int m = 0; m < 4; ++m) _Pragma("unroll") for (int n = 0; n < 2; ++n) _Pragma("unroll") for (int k = 0; k < 2; ++k) \
        acc[ai][bj][m][n] = __builtin_amdgcn_mfma_f32_16x16x32_bf16(Bt[n][k], At[m][k], acc[ai][bj][m][n], 0, 0, 0); __builtin_amdgcn_s_setprio(0); } while (0)
#define PG8_WAIT_V(n) asm volatile("s_waitcnt vmcnt(" #n ")" ::: "memory")
#define PG8_WAIT_L(n) asm volatile("s_waitcnt lgkmcnt(" #n ")" ::: "memory")
#define PG8_BAR __builtin_amdgcn_s_barrier()
#define PG8_SCHED __builtin_amdgcn_sched_barrier(0)
    Unit cur, nxt; int ui = 0;
    if (!p.next(0, cur)) return;
    f32x4 acc[2][2][4][2];
#pragma unroll
    for (int a = 0; a < 2; ++a)
#pragma unroll
        for (int b = 0; b < 2; ++b)
#pragma unroll
            for (int m = 0; m < 4; ++m)
#pragma unroll
                for (int n = 0; n < 2; ++n) acc[a][b][m][n] = (f32x4){0.f, 0.f, 0.f, 0.f};
    bf16x8 At[4][2], B0[2][2], B1[2][2];
    unsigned oC[2][2], oN[2][2];
    p.a_off(cur, RR, CC, oC);
    const char* cB = p.b_base(cur);
    PG8_STAGE_B(PG8_SB(0, 0), cB, 0u); PG8_STAGE_B(PG8_SB(0, 1), cB + hstepB, 0u); PG8_STAGE_A(PG8_SA(0, 0), oC[0], 0u); PG8_STAGE_A(PG8_SA(0, 1), oC[1], 0u);
    if (wr == 1) PG8_BAR;
    PG8_WAIT_V(2); PG8_BAR;
    PG8_STAGE_B(PG8_SB(1, 0), cB, 128u); PG8_STAGE_A(PG8_SA(1, 0), oC[0], 128u); PG8_STAGE_B(PG8_SB(1, 1), cB + hstepB, 128u);
    PG8_WAIT_V(6); PG8_BAR;
    for (;;) {
        const bool has_next = p.next(ui + 1, nxt);
        const char* nB = cB;
        if (has_next) { p.a_off(nxt, RR, CC, oN); nB = p.b_base(nxt); }
        else {
#pragma unroll
            for (int h = 0; h < 2; ++h)
#pragma unroll
                for (int i = 0; i < 2; ++i) oN[h][i] = oC[h][i];
        }
        for (int t = 0; t < nt; t += 2) {
            const bool last = (t == nt - 2);
            const unsigned k1 = (unsigned)(t + 1) * 128u, k2 = last ? 0u : (unsigned)(t + 2) * 128u, k3 = k2 + 128u;
            unsigned o2[2][2];
#pragma unroll
            for (int h = 0; h < 2; ++h)
#pragma unroll
                for (int i = 0; i < 2; ++i) o2[h][i] = last ? oN[h][i] : oC[h][i];
            const char* b2 = last ? nB : cB;
            PG8_LDB(B0, 0, 0); PG8_LDB(B1, 0, 1); PG8_SCHED; PG8_LDA(At, 0, 0); PG8_STAGE_A(PG8_SA(1, 1), oC[1], k1);
            PG8_WAIT_V(8); PG8_WAIT_L(0); PG8_BAR; PG8_MMA(0, 0, At, B0); PG8_MMA(0, 1, At, B1); PG8_BAR; PG8_SCHED;
            PG8_LDA(At, 0, 1); PG8_STAGE_B(PG8_SB(0, 0), b2, k2); PG8_STAGE_B(PG8_SB(0, 1), b2 + hstepB, k2); PG8_STAGE_A(PG8_SA(0, 0), o2[0], k2);
            PG8_WAIT_V(8); PG8_WAIT_L(0); PG8_BAR; PG8_MMA(1, 0, At, B0); PG8_MMA(1, 1, At, B1); PG8_BAR; PG8_SCHED;
            PG8_LDB(B0, 1, 0); PG8_LDB(B1, 1, 1); PG8_SCHED; PG8_LDA(At, 1, 0); PG8_STAGE_A(PG8_SA(0, 1), o2[1], k2);
            PG8_WAIT_V(8); PG8_WAIT_L(0); PG8_BAR; PG8_MMA(0, 0, At, B0); PG8_MMA(0, 1, At, B1); PG8_BAR; PG8_SCHED;
            PG8_LDA(At, 1, 1); PG8_STAGE_B(PG8_SB(1, 0), b2, k3); PG8_STAGE_B(PG8_SB(1, 1), b2 + hstepB, k3); PG8_STAGE_A(PG8_SA(1, 0), o2[0], k3);
            PG8_WAIT_V(8); PG8_WAIT_L(0); PG8_BAR; PG8_MMA(1, 0, At, B0); PG8_MMA(1, 1, At, B1); PG8_BAR; PG8_SCHED;
        }
        if (wr == 0) PG8_BAR;
        p.epi(acc, cur, wr, wc, fr, fq);
        if (!has_next) break;
#pragma unroll
        for (int a = 0; a < 2; ++a)
#pragma unroll
            for (int b = 0; b < 2; ++b)
#pragma unroll
                for (int m = 0; m < 4; ++m)
#pragma unroll
                    for (int n = 0; n < 2; ++n) acc[a][b][m][n] = (f32x4){0.f, 0.f, 0.f, 0.f};
        cur = nxt; cB = nB; ++ui;
#pragma unroll
        for (int h = 0; h < 2; ++h)
#pragma unroll
            for (int i = 0; i < 2; ++i) oC[h][i] = oN[h][i];
        if (wr == 1) PG8_BAR;
    }
    PG8_WAIT_V(0);
    PG8_BAR;
#undef PG8_SA
#undef PG8_SB
#undef PG8_STAGE_A
#undef PG8_STAGE_B
#undef PG8_LDA
#undef PG8_LDB
#undef PG8_MMA
#undef PG8_WAIT_V
#undef PG8_WAIT_L
#undef PG8_BAR
#undef PG8_SCHED
}
}

struct ProbProj {
    static constexpr bool PERM = true;
    const bf16_t* A; const bf16_t* Bt; bf16_t* C; int ldc; pg8::StaticOrder S;
    __device__ __forceinline__ bool next(int i, pg8::Unit& u) const { return S.next(i, u); }
    __device__ __forceinline__ const char* a_base() const { return (const char*)A; }
    __device__ __forceinline__ void a_off(const pg8::Unit& u, const int (&R)[2], const int (&C_)[2], unsigned (&o)[2][2]) const {
#pragma unroll
        for (int h = 0; h < 2; ++h)
#pragma unroll
            for (int i = 0; i < 2; ++i) o[h][i] = (unsigned)((u.pm * 256 + h * 128 + R[i]) * pg8::KD + C_[i]) * 2u;
    }
    __device__ __forceinline__ const char* b_base(const pg8::Unit& u) const { return (const char*)Bt + (size_t)u.pn * 256 * pg8::KD * 2; }
    __device__ __forceinline__ void epi(const f32x4 (&acc)[2][2][4][2], const pg8::Unit& u, int wr, int wc, int fr, int fq) const {
        const int row0 = u.pm * 256 + wr * 64 + fr, col0 = u.pn * 256 + wc * 32 + 8 * fq;
#pragma unroll
        for (int ai = 0; ai < 2; ++ai)
#pragma unroll
            for (int m = 0; m < 4; ++m) { bf16_t* rowp = C + (size_t)(row0 + ai * 128 + m * 16) * ldc + col0;
#pragma unroll
                for (int bj = 0; bj < 2; ++bj) { const f32x4 v0 = acc[ai][bj][m][0], v1 = acc[ai][bj][m][1];
                    u32x4 w; w.x = pg8::cvt_pk_bf16(v0[0], v0[1]); w.y = pg8::cvt_pk_bf16(v0[2], v0[3]); w.z = pg8::cvt_pk_bf16(v1[0], v1[1]); w.w = pg8::cvt_pk_bf16(v1[2], v1[3]);
                    *(u32x4*)(rowp + bj * 128) = w; } }
    }
};
struct ProbOut {
    static constexpr bool PERM = false;
    const bf16_t* A; const bf16_t* Bt; float* C; pg8::StaticOrder S;
    __device__ __forceinline__ bool next(int i, pg8::Unit& u) const { return S.next(i, u); }
    __device__ __forceinline__ const char* a_base() const { return (const char*)A; }
    __device__ __forceinline__ void a_off(const pg8::Unit& u, const int (&R)[2], const int (&C_)[2], unsigned (&o)[2][2]) const {
#pragma unroll
        for (int h = 0; h < 2; ++h)
#pragma unroll
            for (int i = 0; i < 2; ++i) o[h][i] = (unsigned)((u.pm * 256 + h * 128 + R[i]) * pg8::KD + C_[i]) * 2u;
    }
    __device__ __forceinline__ const char* b_base(const pg8::Unit& u) const { return (const char*)Bt + (size_t)u.pn * 256 * pg8::KD * 2; }
    __device__ __forceinline__ void epi(const f32x4 (&acc)[2][2][4][2], const pg8::Unit& u, int wr, int wc, int fr, int fq) const {
        const int row0 = u.pm * 256 + wr * 64 + fr, col0 = u.pn * 256 + wc * 32 + 4 * fq;
#pragma unroll
        for (int ai = 0; ai < 2; ++ai)
#pragma unroll
            for (int m = 0; m < 4; ++m) { float* rowp = C + (size_t)(row0 + ai * 128 + m * 16) * D + col0;
#pragma unroll
                for (int bj = 0; bj < 2; ++bj)
#pragma unroll
                    for (int n = 0; n < 2; ++n) *(f32x4*)(rowp + bj * 128 + n * 16) = acc[ai][bj][m][n]; }
    }
};
struct MoeTab { const LAS int* cnt; const LAS int* pblk; };
__device__ __forceinline__ bool moe_next(const MoeTab& tb, int npn, int G, int c, int i, pg8::Unit& u) {
    const int nb = tb.pblk[32]; const long L = (long)i * G + c; if (L >= (long)nb * npn) return false;
    const int blk = (int)(L / npn); u.pn = (int)(L % npn); u.pm = blk;
    int e = 0;
    for (int q = 1; q < 32; ++q) e += (tb.pblk[q] <= blk) ? 1 : 0;
    while (e < 31 && tb.pblk[e + 1] <= blk) ++e;
    u.e = __builtin_amdgcn_readfirstlane(e); u.j = blk - tb.pblk[u.e]; u.pm = __builtin_amdgcn_readfirstlane(u.pm); u.pn = __builtin_amdgcn_readfirstlane(u.pn); u.j = __builtin_amdgcn_readfirstlane(u.j);
    return true;
}
struct ProbMoe1 {
    static constexpr bool PERM = true;
    const bf16_t* X; const bf16_t* Wgu; const float* bgu; bf16_t* hid; const int* rtok; MoeTab tb; int G, c;
    __device__ __forceinline__ bool next(int i, pg8::Unit& u) const { return moe_next(tb, 8, G, c, i, u); }
    __device__ __forceinline__ const char* a_base() const { return (const char*)X; }
    __device__ __forceinline__ void a_off(const pg8::Unit& u, const int (&R)[2], const int (&C_)[2], unsigned (&o)[2][2]) const {
        const int n = tb.cnt[u.e];
#pragma unroll
        for (int h = 0; h < 2; ++h)
#pragma unroll
            for (int i = 0; i < 2; ++i) { const int rank = u.j * 256 + h * 128 + R[i]; const int tok = rank < n ? rtok[u.e * ECAP + rank] : 0; o[h][i] = (unsigned)(tok * pg8::KD + C_[i]) * 2u; }
    }
    __device__ __forceinline__ const char* b_base(const pg8::Unit& u) const { return (const char*)Wgu + ((size_t)u.e * 2048 + (size_t)u.pn * 256) * pg8::KD * 2; }
    __device__ __forceinline__ void epi(const f32x4 (&acc)[2][2][4][2], const pg8::Unit& u, int wr, int wc, int fr, int fq) const {
        const int row0 = u.pm * 256 + wr * 64 + fr, col0 = u.pn * 128 + wc * 32 + 8 * fq;
        const float* bg = bgu + (size_t)u.e * 2048 + col0; const float* bu = bg + 1024;
        const f32x4 bg0 = *(const f32x4*)bg, bg1 = *(const f32x4*)(bg + 4), bu0 = *(const f32x4*)bu, bu1 = *(const f32x4*)(bu + 4);
#pragma unroll
        for (int ai = 0; ai < 2; ++ai)
#pragma unroll
            for (int m = 0; m < 4; ++m) {
                float hv[8];
#pragma unroll
                for (int n = 0; n < 2; ++n) { const f32x4 g4 = acc[ai][0][m][n] + (n ? bg1 : bg0), u4 = acc[ai][1][m][n] + (n ? bu1 : bu0);
#pragma unroll
                    for (int q = 0; q < 4; ++q) { const float g = fminf(g4[q], 7.0f), up = fminf(fmaxf(u4[q], -7.0f), 7.0f); hv[n * 4 + q] = (up + 1.0f) * (g * sigmoidf_(1.702f * g)); } }
                u32x4 w; w.x = pg8::cvt_pk_bf16(hv[0], hv[1]); w.y = pg8::cvt_pk_bf16(hv[2], hv[3]); w.z = pg8::cvt_pk_bf16(hv[4], hv[5]); w.w = pg8::cvt_pk_bf16(hv[6], hv[7]);
                *(u32x4*)(hid + (size_t)(row0 + ai * 128 + m * 16) * DE + col0) = w; }
    }
};
struct ProbMoe2 {
    static constexpr bool PERM = true;
    const bf16_t* hid; const bf16_t* Wdn; const float* bdn; bf16_t* ys; const float* rgate; MoeTab tb; int G, c;
    __device__ __forceinline__ bool next(int i, pg8::Unit& u) const { return moe_next(tb, 4, G, c, i, u); }
    __device__ __forceinline__ const char* a_base() const { return (const char*)hid; }
    __device__ __forceinline__ void a_off(const pg8::Unit& u, const int (&R)[2], const int (&C_)[2], unsigned (&o)[2][2]) const {
#pragma unroll
        for (int h = 0; h < 2; ++h)
#pragma unroll
            for (int i = 0; i < 2; ++i) o[h][i] = (unsigned)((u.pm * 256 + h * 128 + R[i]) * pg8::KD + C_[i]) * 2u;
    }
    __device__ __forceinline__ const char* b_base(const pg8::Unit& u) const { return (const char*)Wdn + ((size_t)u.e * 1024 + (size_t)u.pn * 256) * pg8::KD * 2; }
    __device__ __forceinline__ void epi(const f32x4 (&acc)[2][2][4][2], const pg8::Unit& u, int wr, int wc, int fr, int fq) const {
        const int row0 = u.pm * 256 + wr * 64 + fr, col0 = u.pn * 256 + wc * 32 + 8 * fq; const int n_e = tb.cnt[u.e];
        f32x4 bv[2][2];
#pragma unroll
        for (int bj = 0; bj < 2; ++bj)
#pragma unroll
            for (int n = 0; n < 2; ++n) bv[bj][n] = *(const f32x4*)(bdn + (size_t)u.e * 1024 + col0 + bj * 128 + 4 * n);
#pragma unroll
        for (int ai = 0; ai < 2; ++ai)
#pragma unroll
            for (int m = 0; m < 4; ++m) { const int pr = wr * 64 + fr + ai * 128 + m * 16, rank = u.j * 256 + pr; const float gt = rank < n_e ? rgate[u.e * ECAP + rank] : 0.0f;
                bf16_t* rowp = ys + (size_t)(row0 + ai * 128 + m * 16) * D + col0;
#pragma unroll
                for (int bj = 0; bj < 2; ++bj) { const f32x4 v0 = (acc[ai][bj][m][0] + bv[bj][0]) * gt, v1 = (acc[ai][bj][m][1] + bv[bj][1]) * gt;
                    u32x4 w; w.x = pg8::cvt_pk_bf16(v0[0], v0[1]); w.y = pg8::cvt_pk_bf16(v0[2], v0[3]); w.z = pg8::cvt_pk_bf16(v1[0], v1[1]); w.w = pg8::cvt_pk_bf16(v1[2], v1[3]);
                    *(u32x4*)(rowp + bj * 128) = w; } }
    }
};

struct Args { const float* in[23]; float* out; unsigned char* ws; int l_lo, l_hi, ph_lo, ph_hi, pro, pad; };
enum { I_X = 0, I_WIN, I_HGLB, I_HGNORM, I_CONVW, I_CONVB, I_WA, I_BA, I_WX, I_BX, I_LAM, I_LRUNORM, I_WOUT, I_LN1G, I_LN1B, I_RW, I_RB, I_WGU, I_BGU, I_WDN, I_BDN, I_LN2G, I_LN2B };
enum { PH_PROJ = 1, PH_HG = 2, PH_LRUAU = 3, PH_LRUSCAN = 4, PH_COMB = 5, PH_OUTG = 6, PH_LN1R = 7, PH_MOE1 = 8, PH_MOE2 = 9, PH_LN2 = 10, PH_END = 11 };

__device__ __forceinline__ void transpose_item(const float* W, int N, int k0, int n0, bf16_t* WT, size_t dst_row0, int KP, LAS float* scr, int lane) {
#pragma unroll 8
    for (int i = 0; i < 32; ++i) { const int kk = 2 * i + (lane >> 5); scr[kk * 33 + (lane & 31)] = W[(size_t)(k0 + kk) * N + n0 + (lane & 31)]; }
    LDS_WAIT(); asm volatile("" ::: "memory");
    const int c = lane & 7;
#pragma unroll
    for (int j = 0; j < 4; ++j) { const int n = (lane >> 3) + 8 * j; const LAS float* s = scr + (8 * c) * 33 + n;
        u32x4 o; o.x = pk2(s[0 * 33], s[1 * 33]); o.y = pk2(s[2 * 33], s[3 * 33]); o.z = pk2(s[4 * 33], s[5 * 33]); o.w = pk2(s[6 * 33], s[7 * 33]);
        *(u32x4*)(WT + (dst_row0 + n) * KP + k0 + 8 * c) = o; }
    LDS_WAIT(); asm volatile("" ::: "memory");
}

template <int PH> __global__ void __launch_bounds__(NTHR, 2) mk_fwd(Args args) {
    extern __shared__ __attribute__((aligned(16))) unsigned char lds_raw[];
    LAS unsigned char* lds = (LAS unsigned char*)lds_raw;
    const int tid = threadIdx.x, lane = tid & 63, wave = __builtin_amdgcn_readfirstlane(tid >> 6);
    const int G = gridDim.x, bid = blockIdx.x;
    const int gw = bid * NWAVES + wave, NGW = G * NWAVES;
    unsigned char* ws = args.ws;
    unsigned* ctl = (unsigned*)(ws + WS_CTL);
    float* lbt = (float*)(ws + WS_LBT);
    bf16_t* rwh = (bf16_t*)(ws + WS_RWH); bf16_t* rwl = (bf16_t*)(ws + WS_RWL);
    bf16_t* win_t = (bf16_t*)(ws + WS_WIN); bf16_t* wout_t = (bf16_t*)(ws + WS_WOUT); bf16_t* wgu_t = (bf16_t*)(ws + WS_WGU); bf16_t* wdn_t = (bf16_t*)(ws + WS_WDN);
    bf16_t* xb = (bf16_t*)(ws + WS_XB); float* xres = (float*)(ws + WS_XRES); bf16_t* proj = (bf16_t*)(ws + WS_PROJ); bf16_t* mix = (bf16_t*)(ws + WS_MIX);
    float* ybuf = (float*)(ws + WS_Y); float* x1 = (float*)(ws + WS_X1); bf16_t* x1b = (bf16_t*)(ws + WS_X1B); bf16_t* hid = (bf16_t*)(ws + WS_HID); bf16_t* ysl = (bf16_t*)(ws + WS_YS);
    int* rtok = (int*)(ws + WS_RTOK); float* rgate = (float*)(ws + WS_RGATE); int* tslot = (int*)(ws + WS_TSLOT);
    float* odir = (float*)(ws + WS_ODIR); float* hdir = (float*)(ws + WS_HDIR); float* aub = (float*)(ws + WS_AU);
    LAS int* tabcnt = (LAS int*)(lds + 131072 + 1024); LAS int* tabpblk = (LAS int*)(lds + 131072 + 1024 + 256);

    if (PH == -1) {
        LAS float* scr = (LAS float*)(lds + wave * 16384);
        { constexpr int per = 16 * 112; for (int it = gw; it < NL * per; it += NGW) { const int l = it / per, r = it % per, kb = r / 112, nb = r % 112;
            transpose_item(args.in[I_WIN] + (size_t)l * D * INC, INC, kb * 64, nb * 32, win_t + (size_t)l * INC * D, (size_t)nb * 32, D, scr, lane); } }
        { constexpr int per = 16 * 32; for (int it = gw; it < NL * per; it += NGW) { const int l = it / per, r = it % per, kb = r / 32, nb = r % 32;
            transpose_item(args.in[I_WOUT] + (size_t)l * D * D, D, kb * 64, nb * 32, wout_t + (size_t)l * D * D, (size_t)nb * 32, D, scr, lane); } }
        { constexpr int per = 16 * 64; for (int it = gw; it < NL * NE * per; it += NGW) { const int le = it / per, r = it % per, kb = r / 64, nb = r % 64;
            const int n0 = nb * 32, cc = n0 & 1023, isup = n0 >> 10; const size_t drow = (size_t)(cc >> 7) * 256 + (size_t)isup * 128 + (cc & 127);
            transpose_item(args.in[I_WGU] + (size_t)le * D * 2048, 2048, kb * 64, n0, wgu_t + (size_t)le * 2048 * D, drow, D, scr, lane); } }
        { constexpr int per = 16 * 32; for (int it = gw; it < NL * NE * per; it += NGW) { const int le = it / per, r = it % per, kb = r / 32, nb = r % 32;
            transpose_item(args.in[I_WDN] + (size_t)le * DE * D, D, kb * 64, nb * 32, wdn_t + (size_t)le * D * DE, (size_t)nb * 32, DE, scr, lane); } }
        for (int i = bid * NTHR + tid; i < NL * NE * D; i += G * NTHR) { const int l = i / (NE * D), r = i % (NE * D), e = r / D, d = r % D; const float w = args.in[I_RW][(size_t)l * D * NE + (size_t)d * NE + e];
            const unsigned h = f2bf(w); rwh[i] = (bf16_t)h; rwl[i] = (bf16_t)f2bf(w - bf2f(h)); }
        for (size_t i = (size_t)bid * NTHR + tid; i < (size_t)T * D / 4; i += (size_t)G * NTHR) { const f32x4 v = ((const f32x4*)args.in[I_X])[i]; u32x2 o; o.x = pk2(v[0], v[1]); o.y = pk2(v[2], v[3]); ((u32x2*)xb)[i] = o; }
        for (int i = bid * NTHR + tid; i < 2 * HGW; i += G * NTHR) { const float* p = args.in[I_HGLB] + i; float v[NL], mx = -3.0e38f;
#pragma unroll
            for (int l = 0; l < NL; ++l) { v[l] = p[(size_t)l * 2 * HGW]; mx = fmaxf(mx, v[l]); }
            float s = 0.f;
#pragma unroll
            for (int l = 0; l < NL; ++l) { v[l] = expf(v[l] - mx); s += v[l]; }
            float cum = 0.f;
#pragma unroll
            for (int l = 0; l < NL; ++l) { if (l > 0) cum += v[l] / s; lbt[(size_t)l * 2 * HGW + i] = fminf(fmaxf(cum, 0.f), 1.0f - 1e-6f); } }
    }

    for (int l = args.l_lo; l < args.l_hi; ++l) {
#define IN(k) (PH == (k))
        const float* xin = (l == 0) ? args.in[I_X] : xres;
        float* xout = (l == NL - 1) ? args.out : xres;
        unsigned* cntg = ctl + CW_CNT + 64 * l;

        if (IN(PH_PROJ)) {
            ProbProj p; p.A = xb; p.Bt = win_t + (size_t)l * INC * D; p.C = proj; p.ldc = INC; p.S.init(T, INC, G, bid);
            pg8::gemm_phase(lds, p);
        }
        if (IN(PH_HG)) {
            LAS float* Qs = (LAS float*)lds; LAS float* Ks = Qs + 32 * 128; LAS float* Fs = Ks + 32 * 128; LAS float* Vs = Fs + 32 * 128; LAS float* Rs = Vs + 32 * 128;
            for (int item = bid; item < BATCH * HGH * 2; item += G) {
                const int dir = item & 1, h = (item >> 1) & 3, b = item >> 3;
                const int v = tid & 127, dq = tid >> 7;
                float S[32];
#pragma unroll
                for (int j = 0; j < 32; ++j) S[j] = 0.f;
                for (int p0 = 0; p0 < SEQ; p0 += 32) {
                    for (int idx = tid; idx < 32 * 128; idx += NTHR) { const int p = idx >> 7, d = idx & 127; const int t = dir ? (SEQ - 1 - (p0 + p)) : (p0 + p); const size_t row = (size_t)b * SEQ + t;
                        const bf16_t* pr = proj + row * INC + h * 128 + d;
                        const float zq = bf2f(pr[0]), zi = bf2f(pr[512]), z = bf2f(pr[1024 + dir * 512]);
                        const float lb = lbt[(size_t)l * 2 * HGW + dir * HGW + h * 128 + d];
                        const float sg = sigmoidf_(z);
                        Qs[idx] = zq * sigmoidf_(zq); Ks[idx] = (1.0f - lb) * (1.0f - sg); Fs[idx] = lb + (1.0f - lb) * sg; Vs[idx] = zi; }
                    __syncthreads();
                    for (int p = 0; p < 32; ++p) { const float vv = Vs[p * 128 + v]; float part = 0.f;
#pragma unroll
                        for (int j = 0; j < 32; ++j) { const int d = dq * 32 + j; S[j] = Fs[p * 128 + d] * S[j] + Ks[p * 128 + d] * vv; part += S[j] * Qs[p * 128 + d]; }
                        Rs[(p * 4 + dq) * 128 + v] = part; }
                    __syncthreads();
                    for (int idx = tid; idx < 32 * 128; idx += NTHR) { const int p = idx >> 7, vv = idx & 127; const int t = dir ? (SEQ - 1 - (p0 + p)) : (p0 + p);
                        const float o = (Rs[(p * 4 + 0) * 128 + vv] + Rs[(p * 4 + 1) * 128 + vv]) + (Rs[(p * 4 + 2) * 128 + vv] + Rs[(p * 4 + 3) * 128 + vv]);
                        odir[((size_t)dir * T + (size_t)b * SEQ + t) * HGW + h * 128 + vv] = o; }
                    __syncthreads();
                }
            }
        }
        if (IN(PH_LRUAU)) {
            LAS float* xcs = (LAS float*)lds;
            const float* cw = args.in[I_CONVW] + (size_t)l * 4 * LRW; const float* cb = args.in[I_CONVB] + (size_t)l * LRW;
            const int c = tid, hh = c >> 6, jj = c & 63;
            for (int tile = bid; tile < T / 8; tile += G) {
                const int row0 = tile * 8;
#pragma unroll
                for (int q = 0; q < 8; ++q) { const int row = row0 + q, t = row & (SEQ - 1); float a = cb[c];
#pragma unroll
                    for (int j = 0; j < 4; ++j) { const int tt = t + j - 2; if (tt >= 0 && tt < SEQ) a += cw[j * LRW + c] * bf2f(proj[(size_t)(row + j - 2) * INC + 2560 + c]); }
                    xcs[q * 512 + c] = a; }
                __syncthreads();
                float acc[8][4];
#pragma unroll
                for (int q = 0; q < 8; ++q)
#pragma unroll
                    for (int w = 0; w < 4; ++w) acc[q][w] = 0.f;
                const float* waf = args.in[I_WA] + ((size_t)(l * 2 + 0) * LRH + hh) * LHD * LHD + jj; const float* wab = args.in[I_WA] + ((size_t)(l * 2 + 1) * LRH + hh) * LHD * LHD + jj;
                const float* wxf = args.in[I_WX] + ((size_t)(l * 2 + 0) * LRH + hh) * LHD * LHD + jj; const float* wxb = args.in[I_WX] + ((size_t)(l * 2 + 1) * LRH + hh) * LHD * LHD + jj;
                for (int i = 0; i < LHD; ++i) { const float w0 = waf[i * LHD], w1 = wxf[i * LHD], w2 = wab[i * LHD], w3 = wxb[i * LHD];
#pragma unroll
                    for (int q = 0; q < 8; ++q) { const float xv = xcs[q * 512 + hh * 64 + i]; acc[q][0] += xv * w0; acc[q][1] += xv * w1; acc[q][2] += xv * w2; acc[q][3] += xv * w3; } }
#pragma unroll
                for (int dir = 0; dir < 2; ++dir) { const float ba = args.in[I_BA][(size_t)(l * 2 + dir) * LRW + c], bx = args.in[I_BX][(size_t)(l * 2 + dir) * LRW + c], lam = args.in[I_LAM][(size_t)(l * 2 + dir) * LRW + c];
                    const float sp = (lam < -20.f) ? -lam : log1pf(expf(-lam));
#pragma unroll
                    for (int q = 0; q < 8; ++q) { const float r = sigmoidf_(acc[q][dir * 2 + 0] + ba), ig = sigmoidf_(acc[q][dir * 2 + 1] + bx); const float la = -8.0f * r * sp; const float a = expf(la);
                        const float u = sqrtf(fmaxf(-expm1f(2.0f * la), 0.f)) * (ig * xcs[q * 512 + c]);
                        aub[((size_t)(dir * 2 + 0) * T + row0 + q) * LRW + c] = a; aub[((size_t)(dir * 2 + 1) * T + row0 + q) * LRW + c] = u; } }
                __syncthreads();
            }
        }
        if (IN(PH_LRUSCAN)) {
            const int gid = bid * NTHR + tid;
            if (gid < BATCH * LRW * 2) { const int c = gid & 511, b = (gid >> 9) & 7, dir = gid >> 12;
                const float* ap = aub + ((size_t)(dir * 2 + 0) * T + (size_t)b * SEQ) * LRW + c; const float* up = aub + ((size_t)(dir * 2 + 1) * T + (size_t)b * SEQ) * LRW + c;
                float* hp = hdir + ((size_t)dir * T + (size_t)b * SEQ) * LRW + c; float h = 0.f;
                for (int s0 = 0; s0 < SEQ; s0 += 16) { float av[16], uv[16];
#pragma unroll
                    for (int q = 0; q < 16; ++q) { const int t = dir ? (SEQ - 1 - (s0 + q)) : (s0 + q); av[q] = ap[(size_t)t * LRW]; uv[q] = up[(size_t)t * LRW]; }
#pragma unroll
                    for (int q = 0; q < 16; ++q) { const int t = dir ? (SEQ - 1 - (s0 + q)) : (s0 + q); h = av[q] * h + uv[q]; hp[(size_t)t * LRW] = h; } } }
        }
        if (IN(PH_COMB)) {
            const float* hgn = args.in[I_HGNORM] + (size_t)l * HGW; const float* lrn = args.in[I_LRUNORM] + (size_t)l * LRW;
            for (int row = gw; row < T; row += NGW) {
                const f32x4* of = (const f32x4*)(odir + (size_t)row * HGW) + lane * 2; const f32x4* ob = (const f32x4*)(odir + ((size_t)T + row) * HGW) + lane * 2;
                float o[8]; { const f32x4 a0 = of[0], a1 = of[1], b0 = ob[0], b1 = ob[1];
#pragma unroll
                    for (int q = 0; q < 4; ++q) { o[q] = a0[q] + b0[q]; o[4 + q] = a1[q] + b1[q]; } }
                float ss = 0.f;
#pragma unroll
                for (int q = 0; q < 8; ++q) ss += o[q] * o[q];
                ss += __shfl_xor(ss, 1); ss += __shfl_xor(ss, 2); ss += __shfl_xor(ss, 4); ss += __shfl_xor(ss, 8);
                const float rs = 1.0f / sqrtf(ss * (1.0f / 128.f) + RMS_EPS);
                const bf16_t* pz = proj + (size_t)row * INC + 2048 + lane * 8; const u32x4 zg = *(const u32x4*)pz;
                unsigned ow[4];
#pragma unroll
                for (int q = 0; q < 4; ++q) { const unsigned zw = zg[q]; const float z0 = bf2f(zw & 0xffffu), z1 = bf2f(zw >> 16);
                    const float r0 = o[2 * q] * rs * hgn[lane * 8 + 2 * q] * (z0 * sigmoidf_(z0)), r1 = o[2 * q + 1] * rs * hgn[lane * 8 + 2 * q + 1] * (z1 * sigmoidf_(z1)); ow[q] = pk2(r0, r1); }
                *(u32x4*)(mix + (size_t)row * D + lane * 8) = (u32x4){ow[0], ow[1], ow[2], ow[3]};
                const f32x4* hf = (const f32x4*)(hdir + (size_t)row * LRW) + lane * 2; const f32x4* hb = (const f32x4*)(hdir + ((size_t)T + row) * LRW) + lane * 2;
                float hsum[8]; { const f32x4 a0 = hf[0], a1 = hf[1], b0 = hb[0], b1 = hb[1];
#pragma unroll
                    for (int q = 0; q < 4; ++q) { hsum[q] = a0[q] + b0[q]; hsum[4 + q] = a1[q] + b1[q]; } }
                float s2 = 0.f;
#pragma unroll
                for (int q = 0; q < 8; ++q) s2 += hsum[q] * hsum[q];
                s2 = wave_sum(s2); const float rs2 = 1.0f / sqrtf(s2 * (1.0f / 512.f) + RMS_EPS);
                const u32x4 zy = *(const u32x4*)(proj + (size_t)row * INC + 3072 + lane * 8);
#pragma unroll
                for (int q = 0; q < 4; ++q) { const unsigned zw = zy[q]; float zz[2] = {bf2f(zw & 0xffffu), bf2f(zw >> 16)}; float rr[2];
#pragma unroll
                    for (int e2 = 0; e2 < 2; ++e2) { const float z = zz[e2]; const float ge = 0.5f * z * (1.0f + tanhf(0.7978845608028654f * (z + 0.044715f * z * z * z))); rr[e2] = hsum[2 * q + e2] * rs2 * lrn[lane * 8 + 2 * q + e2] * ge; }
                    ow[q] = pk2(rr[0], rr[1]); }
                *(u32x4*)(mix + (size_t)row * D + 512 + lane * 8) = (u32x4){ow[0], ow[1], ow[2], ow[3]};
            }
        }
        if (IN(PH_OUTG)) {
            ProbOut p; p.A = mix; p.Bt = wout_t + (size_t)l * D * D; p.C = ybuf; p.S.init(T, D, G, bid);
            pg8::gemm_phase(lds, p);
        }
        if (IN(PH_LN1R)) {
            constexpr int AROW = 2064;
            LAS unsigned char* Ahi = lds; LAS unsigned char* Alo = lds + 32 * AROW; LAS float* Lg = (LAS float*)(lds + 64 * AROW);
            LAS int* hist = (LAS int*)(lds + 64 * AROW + 32 * 33 * 4); LAS int* basee = hist + 32; LAS int* sel = basee + 32; LAS float* gsel = (LAS float*)(sel + 128);
            const float* g1 = args.in[I_LN1G] + (size_t)l * D; const float* b1 = args.in[I_LN1B] + (size_t)l * D; const float* rb = args.in[I_RB] + (size_t)l * NE;
            const bf16_t* wh = rwh + (size_t)l * NE * D; const bf16_t* wl = rwl + (size_t)l * NE * D;
            for (int tile = bid; tile < T / 32; tile += G) {
                if (tid < 32) hist[tid] = 0;
                for (int q = 0; q < 4; ++q) { const int lr = wave * 4 + q; const size_t row = (size_t)tile * 32 + lr;
                    const f32x4* xr = (const f32x4*)(xin + row * D) + lane; const f32x4* yr = (const f32x4*)(ybuf + row * D) + lane;
                    f32x4 v[4]; float s = 0.f;
#pragma unroll
                    for (int j = 0; j < 4; ++j) { v[j] = xr[64 * j] * ALPHA + yr[64 * j]; s += (v[j][0] + v[j][1]) + (v[j][2] + v[j][3]); }
                    const float mean = wave_sum(s) * (1.f / D); float s2 = 0.f;
#pragma unroll
                    for (int j = 0; j < 4; ++j) { v[j] = v[j] - mean; s2 += (v[j][0] * v[j][0] + v[j][1] * v[j][1]) + (v[j][2] * v[j][2] + v[j][3] * v[j][3]); }
                    const float rstd = 1.0f / sqrtf(wave_sum(s2) * (1.f / D) + LN_EPS);
#pragma unroll
                    for (int j = 0; j < 4; ++j) { const f32x4 gg = ((const f32x4*)g1)[lane + 64 * j], bb = ((const f32x4*)b1)[lane + 64 * j]; const f32x4 o = v[j] * rstd * gg + bb;
                        ((f32x4*)(x1 + row * D))[lane + 64 * j] = o;
                        const unsigned h0 = f2bf(o[0]), h1 = f2bf(o[1]), h2 = f2bf(o[2]), h3 = f2bf(o[3]);
                        u32x2 hw; hw.x = h0 | (h1 << 16); hw.y = h2 | (h3 << 16);
                        ((u32x2*)(x1b + row * D))[lane + 64 * j] = hw;
                        u32x2 lw; lw.x = pk2(o[0] - bf2f(h0), o[1] - bf2f(h1)); lw.y = pk2(o[2] - bf2f(h2), o[3] - bf2f(h3));
                        *(LAS u32x2*)(Ahi + lr * AROW + (lane * 4 + 256 * j) * 2) = hw; *(LAS u32x2*)(Alo + lr * AROW + (lane * 4 + 256 * j) * 2) = lw; } }
                __syncthreads();
                if (wave < 4) { const int rt = wave & 1, et = wave >> 1; f32x4 acc = (f32x4){0.f, 0.f, 0.f, 0.f};
                    const LAS unsigned char* ah = Ahi + (rt * 16 + (lane & 15)) * AROW + (lane >> 4) * 16; const LAS unsigned char* al = Alo + (rt * 16 + (lane & 15)) * AROW + (lane >> 4) * 16;
                    const bf16_t* bh = wh + (size_t)(et * 16 + (lane & 15)) * D + (lane >> 4) * 8; const bf16_t* bl = wl + (size_t)(et * 16 + (lane & 15)) * D + (lane >> 4) * 8;
#pragma unroll 4
                    for (int ks = 0; ks < 32; ++ks) { const bf16x8 a_h = *(const LAS bf16x8*)(ah + ks * 64), a_l = *(const LAS bf16x8*)(al + ks * 64); const bf16x8 b_h = *(const bf16x8*)(bh + ks * 32), b_l = *(const bf16x8*)(bl + ks * 32);
                        acc = __builtin_amdgcn_mfma_f32_16x16x32_bf16(a_h, b_h, acc, 0, 0, 0); acc = __builtin_amdgcn_mfma_f32_16x16x32_bf16(a_h, b_l, acc, 0, 0, 0); acc = __builtin_amdgcn_mfma_f32_16x16x32_bf16(a_l, b_h, acc, 0, 0, 0); }
                    const int e = et * 16 + (lane & 15); const float bias = rb[e];
#pragma unroll
                    for (int r = 0; r < 4; ++r) Lg[(rt * 16 + 4 * (lane >> 4) + r) * 33 + e] = acc[r] + bias; }
                __syncthreads();
                if (tid < 32) { float tv[4]; int te[4];
#pragma unroll
                    for (int k = 0; k < 4; ++k) { float best = -3.0e38f; int bi = 0; for (int e = 0; e < 32; ++e) { const float x = Lg[tid * 33 + e]; if (x > best) { best = x; bi = e; } } tv[k] = best; te[k] = bi; Lg[tid * 33 + bi] = -3.3e38f; }
                    float wsum = 0.f, wv[4];
#pragma unroll
                    for (int k = 0; k < 4; ++k) { wv[k] = expf(tv[k] - tv[0]); wsum += wv[k]; }
#pragma unroll
                    for (int k = 0; k < 4; ++k) { const int lr = atomicAdd((int*)(hist + te[k]), 1); sel[tid * 4 + k] = te[k] * 65536 + lr; gsel[tid * 4 + k] = wv[k] / wsum; } }
                __syncthreads();
                if (tid < 32) { const int hh = hist[tid]; basee[tid] = hh ? (int)atomicAdd(cntg + tid, (unsigned)hh) : 0; }
                __syncthreads();
                if (tid < 128) { const int sv = sel[tid], e = sv >> 16, rank = basee[e] + (sv & 65535); const int tok = tile * 32 + (tid >> 2); const int idx = e * ECAP + rank;
                    rtok[idx] = tok; rgate[idx] = gsel[tid]; tslot[tok * 4 + (tid & 3)] = idx; }
                __syncthreads();
            }
        }
        if (IN(PH_MOE1) || IN(PH_MOE2) || IN(PH_LN2)) {
            __syncthreads();
            if (tid < 32) tabcnt[tid] = (int)__hip_atomic_load(cntg + tid, __ATOMIC_RELAXED, __HIP_MEMORY_SCOPE_AGENT);
            __syncthreads();
            if (tid == 0) { int s = 0; for (int e = 0; e < 32; ++e) { tabpblk[e] = s; s += (tabcnt[e] + 255) >> 8; } tabpblk[32] = s; }
            __syncthreads();
        }
        if (IN(PH_MOE1)) {
            ProbMoe1 p; p.X = x1b; p.Wgu = wgu_t + (size_t)l * NE * 2048 * D; p.bgu = args.in[I_BGU] + (size_t)l * NE * 2048; p.hid = hid; p.rtok = rtok; p.tb.cnt = tabcnt; p.tb.pblk = tabpblk; p.G = G; p.c = bid;
            pg8::gemm_phase(lds, p);
        }
        if (IN(PH_MOE2)) {
            ProbMoe2 p; p.hid = hid; p.Wdn = wdn_t + (size_t)l * NE * D * DE; p.bdn = args.in[I_BDN] + (size_t)l * NE * D; p.ys = ysl; p.rgate = rgate; p.tb.cnt = tabcnt; p.tb.pblk = tabpblk; p.G = G; p.c = bid;
            pg8::gemm_phase(lds, p);
        }
        if (IN(PH_LN2)) {
            const float* g2 = args.in[I_LN2G] + (size_t)l * D; const float* b2 = args.in[I_LN2B] + (size_t)l * D;
            for (int row = gw; row < T; row += NGW) {
                int sl[4];
#pragma unroll
                for (int k = 0; k < 4; ++k) { const int idx = tslot[row * 4 + k]; const int e = idx >> 15, rank = idx & (ECAP - 1); sl[k] = tabpblk[e] * 256 + rank; }
                const f32x4* xr = (const f32x4*)(x1 + (size_t)row * D) + lane;
                f32x4 v[4]; float s = 0.f;
#pragma unroll
                for (int j = 0; j < 4; ++j) { f32x4 m = (f32x4){0.f, 0.f, 0.f, 0.f};
#pragma unroll
                    for (int k = 0; k < 4; ++k) { const u32x2 w = ((const u32x2*)(ysl + (size_t)sl[k] * D))[lane + 64 * j]; m[0] += bf2f(w.x & 0xffffu); m[1] += bf2f(w.x >> 16); m[2] += bf2f(w.y & 0xffffu); m[3] += bf2f(w.y >> 16); }
                    v[j] = xr[64 * j] * ALPHA + m; s += (v[j][0] + v[j][1]) + (v[j][2] + v[j][3]); }
                const float mean = wave_sum(s) * (1.f / D); float s2 = 0.f;
#pragma unroll
                for (int j = 0; j < 4; ++j) { v[j] = v[j] - mean; s2 += (v[j][0] * v[j][0] + v[j][1] * v[j][1]) + (v[j][2] * v[j][2] + v[j][3] * v[j][3]); }
                const float rstd = 1.0f / sqrtf(wave_sum(s2) * (1.f / D) + LN_EPS);
#pragma unroll
                for (int j = 0; j < 4; ++j) { const f32x4 gg = ((const f32x4*)g2)[lane + 64 * j], bb = ((const f32x4*)b2)[lane + 64 * j]; const f32x4 o = v[j] * rstd * gg + bb;
                    ((f32x4*)(xout + (size_t)row * D))[lane + 64 * j] = o; u32x2 hw; hw.x = pk2(o[0], o[1]); hw.y = pk2(o[2], o[3]); ((u32x2*)(xb + (size_t)row * D))[lane + 64 * j] = hw; }
            }
        }
#undef IN
    }
}

extern "C" void kernel_launch(void* const* d_in, const int* in_sizes, int n_in, void* d_out, int out_size, void* d_ws, size_t ws_size, hipStream_t stream) {
    static int grid = 0;
    if (grid == 0) {
        if (n_in != 23 || out_size != T * D || ws_size < WS_END) { fprintf(stderr, "kernel_launch: unexpected shapes (n_in %d, out %d, ws %zu)\n", n_in, out_size, ws_size); grid = -1; return; }
        int dev = 0, cus = 0;
        if (hipGetDevice(&dev) != hipSuccess || hipDeviceGetAttribute(&cus, hipDeviceAttributeMultiprocessorCount, dev) != hipSuccess) { grid = -1; return; }
        bool ok = true;
#define SETA(k) ok = ok && (hipFuncSetAttribute((const void*)mk_fwd<k>, hipFuncAttributeMaxDynamicSharedMemorySize, LDS_BYTES) == hipSuccess)
        SETA(-1); SETA(PH_PROJ); SETA(PH_HG); SETA(PH_LRUAU); SETA(PH_LRUSCAN); SETA(PH_COMB); SETA(PH_OUTG); SETA(PH_LN1R); SETA(PH_MOE1); SETA(PH_MOE2); SETA(PH_LN2);
#undef SETA
        if (!ok) { fprintf(stderr, "kernel_launch: hipFuncSetAttribute failed\n"); grid = -1; return; }
        (void)hipGetLastError();
        grid = cus;
    }
    if (grid < 0) return;
    (void)hipMemsetAsync((char*)d_ws + WS_CTL, 0, CTL_BYTES, stream);
    Args a{};
    for (int i = 0; i < 23; ++i) a.in[i] = (const float*)d_in[i];
    a.out = (float*)d_out; a.ws = (unsigned char*)d_ws;
    a.l_lo = 0; a.l_hi = 0; a.ph_lo = 0; a.ph_hi = 0; a.pro = 0; a.pad = 0;
    hipLaunchKernelGGL(mk_fwd<-1>, dim3(grid), dim3(NTHR), LDS_BYTES, stream, a);
    for (int l = 0; l < NL; ++l) {
        a.l_lo = l; a.l_hi = l + 1;
        hipLaunchKernelGGL(mk_fwd<PH_PROJ>, dim3(grid), dim3(NTHR), LDS_BYTES, stream, a);
        hipLaunchKernelGGL(mk_fwd<PH_HG>, dim3(grid), dim3(NTHR), LDS_BYTES, stream, a);
        hipLaunchKernelGGL(mk_fwd<PH_LRUAU>, dim3(grid), dim3(NTHR), LDS_BYTES, stream, a);
        hipLaunchKernelGGL(mk_fwd<PH_LRUSCAN>, dim3(grid), dim3(NTHR), LDS_BYTES, stream, a);
        hipLaunchKernelGGL(mk_fwd<PH_COMB>, dim3(grid), dim3(NTHR), LDS_BYTES, stream, a);
        hipLaunchKernelGGL(mk_fwd<PH_OUTG>, dim3(grid), dim3(NTHR), LDS_BYTES, stream, a);
        hipLaunchKernelGGL(mk_fwd<PH_LN1R>, dim3(grid), dim3(NTHR), LDS_BYTES, stream, a);
        hipLaunchKernelGGL(mk_fwd<PH_MOE1>, dim3(grid), dim3(NTHR), LDS_BYTES, stream, a);
        hipLaunchKernelGGL(mk_fwd<PH_MOE2>, dim3(grid), dim3(NTHR), LDS_BYTES, stream, a);
        hipLaunchKernelGGL(mk_fwd<PH_LN2>, dim3(grid), dim3(NTHR), LDS_BYTES, stream, a);
    }
}
```

```cpp
#include <hip/hip_runtime.h>
#include <cstdio>
#include <cstdint>

#define GAS __attribute__((address_space(1)))
#define LAS __attribute__((address_space(3)))
typedef unsigned short bf16_t;
typedef short bf16x8 __attribute__((ext_vector_type(8)));
typedef float f32x4 __attribute__((ext_vector_type(4)));
typedef float f32x2 __attribute__((ext_vector_type(2)));
typedef unsigned u32x4 __attribute__((ext_vector_type(4)));
typedef unsigned u32x2 __attribute__((ext_vector_type(2)));

constexpr int BATCH = 8, SEQ = 4096, D = 1024, T = BATCH * SEQ, NL = 4;
constexpr int HGW = 512, LRW = 512, HGH = 4, HD = 128, LRH = 8, LHD = 64;
constexpr int INC = 3584, NE = 32, TOPK = 4, DE = 1024;
constexpr int ECAP = 32768;
constexpr int NSLOT = T * TOPK + NE * 256;
constexpr float ALPHA = 1.6817928305074290f;
constexpr float LN_EPS = 1e-5f, RMS_EPS = 1e-6f;
constexpr int NWAVES = 8, NTHR = 512;
constexpr int LDS_BYTES = 147456;

constexpr size_t MiB = 1u << 20;
constexpr size_t WS_CTL = 0, CTL_BYTES = 1 * MiB;
constexpr size_t WS_LBT = 1 * MiB;
constexpr size_t WS_RWH = 2 * MiB, WS_RWL = 3 * MiB;
constexpr size_t WS_WIN = 4 * MiB;
constexpr size_t WS_WOUT = 32 * MiB;
constexpr size_t WS_WGU = 40 * MiB;
constexpr size_t WS_WDN = 552 * MiB;
constexpr size_t WS_XB = 808 * MiB;
constexpr size_t WS_XRES = 872 * MiB;
constexpr size_t WS_PROJ = 1000 * MiB;
constexpr size_t WS_MIX = 1224 * MiB;
constexpr size_t WS_Y = 1288 * MiB;
constexpr size_t WS_X1 = 1416 * MiB;
constexpr size_t WS_X1B = 1544 * MiB;
constexpr size_t WS_HID = 1608 * MiB;
constexpr size_t WS_YS = 1880 * MiB;
constexpr size_t WS_RTOK = 2152 * MiB;
constexpr size_t WS_RGATE = 2156 * MiB;
constexpr size_t WS_TSLOT = 2160 * MiB;
constexpr size_t WS_ODIR = 2162 * MiB;
constexpr size_t WS_HDIR = 2290 * MiB;
constexpr size_t WS_AU = 2418 * MiB;
constexpr size_t WS_SFIN = 2674 * MiB;
constexpr size_t WS_DSEG = 2690 * MiB;
constexpr size_t WS_LSUM = 2691 * MiB;
constexpr size_t WS_LRUW = 2696 * MiB;
constexpr size_t WS_END = 2700 * MiB;
constexpr size_t WS_OLOC = WS_ODIR, WS_QSEG = WS_ODIR + 64 * MiB;
constexpr size_t WS_XQ = WS_XRES, WS_WINQ = WS_XRES + 64 * MiB;
constexpr size_t WS_X1Q = WS_X1;
constexpr int CW_CNT = 16384, CW_SGU = 2048, CW_SDN = 2304, CW_SIN = 2560, CW_BAR = 8192;

#define LDS_WAIT() asm volatile("s_waitcnt lgkmcnt(0)" ::: "memory")
typedef __bf16 bf16x2_t __attribute__((ext_vector_type(2)));
__device__ __forceinline__ unsigned pk2(float lo, float hi) { bf16x2_t v; v[0] = (__bf16)lo; v[1] = (__bf16)hi; return __builtin_bit_cast(unsigned, v); }
__device__ __forceinline__ unsigned f2bf(float f) { return pk2(f, 0.f) & 0xffffu; }
__device__ __forceinline__ float bf2f(unsigned b) { return __builtin_bit_cast(float, b << 16); }
__device__ __forceinline__ float wave_sum(float v) {
#pragma unroll
    for (int o = 1; o < 64; o <<= 1) v += __shfl_xor(v, o);
    return v;
}
__device__ __forceinline__ float rcpf_(float x) { return __builtin_amdgcn_rcpf(x); }
__device__ __forceinline__ float rsqf_(float x) { return __builtin_amdgcn_rsqf(x); }
__device__ __forceinline__ float exp_(float x) { return __builtin_amdgcn_exp2f(x * 1.4426950408889634f); }
__device__ __forceinline__ float log_(float x) { return __builtin_amdgcn_logf(x) * 0.6931471805599453f; }
__device__ __forceinline__ float sigmoidf_(float z) { return rcpf_(1.0f + __builtin_amdgcn_exp2f(z * -1.4426950408889634f)); }
__device__ __forceinline__ float gelu_tanh_(float z) { return z * sigmoidf_(1.5957691216057308f * (z + 0.044715f * z * z * z)); }

namespace pg8 {
constexpr int BM = 256, BK = 64, HALF = 128, HTB = HALF * BK * 2, STAGE_BYTES = 8 * HTB, NXCD = 8, WGM = 8;
constexpr int KD = 1024;
__host__ __device__ __forceinline__ int lds_byte(int r, int c) { const int st = (r >> 4) * 2 + (c >> 5), rr = r & 15, cc = c & 31, ob = rr * 64 + cc * 2; return st * 1024 + (ob ^ (((ob >> 9) & 1) << 5)); }
__host__ __device__ __forceinline__ void stage_rc(int b, int& R, int& C) { const int st = b / 1024, sb = b % 1024, swz = sb ^ (((sb >> 9) & 1) << 5); R = (st >> 1) * 16 + swz / 64; C = (st & 1) * 32 + (swz % 64) / 2; }
__host__ __device__ __forceinline__ int perm32(int rho) { const int n = rho >> 4, i = rho & 15; return 8 * (i >> 2) + 4 * n + (i & 3); }
struct Unit { int pm, pn, e, j; };
typedef int i32x8 __attribute__((ext_vector_type(8)));
__device__ __forceinline__ i32x8 cat8(bf16x8 a, bf16x8 b) { const u32x4 x = __builtin_bit_cast(u32x4, a), y = __builtin_bit_cast(u32x4, b); return (i32x8){(int)x[0], (int)x[1], (int)x[2], (int)x[3], (int)y[0], (int)y[1], (int)y[2], (int)y[3]}; }
__device__ __forceinline__ unsigned cvt_pk_bf16(float lo, float hi) { return pk2(lo, hi); }

struct StaticOrder {
    int nM, nN, nwg, G, c;
    __device__ void init(int M, int N, int G_, int c_) { nM = M / BM; nN = N / BM; nwg = nM * nN; G = G_; c = c_; }
    __device__ bool next(int i, Unit& u) const {
        const long L = (long)i * G + c; if (L >= nwg) return false;
        int wgid = (int)L; { const int q = nwg / NXCD, r = nwg % NXCD, xcd = wgid % NXCD, off = wgid / NXCD; wgid = (xcd < r ? xcd * (q + 1) : r * (q + 1) + (xcd - r) * q) + off; }
        const int nig = WGM * nN, gid = wgid / nig, fm = gid * WGM, gsz = (nM - fm) < WGM ? (nM - fm) : WGM;
        u.pm = fm + ((wgid % nig) % gsz); u.pn = (wgid % nig) / gsz; u.e = 0; u.j = 0; return true;
    }
};

template <class P>
__device__ __forceinline__ void gemm_phase(LAS unsigned char* lds, const P& p) {
    int tid_l = (int)threadIdx.x; asm volatile("" : "+v"(tid_l));
    const int tid = tid_l, wid = __builtin_amdgcn_readfirstlane(tid >> 6), lane = tid & 63, wr = wid >> 2, wc = wid & 3, fr = lane & 15, fq = lane >> 4;
    constexpr int RB = P::FP8 ? KD : 2 * KD;
    constexpr int nt = RB / 128;
    unsigned voffB[2];
#pragma unroll
    for (int i = 0; i < 2; ++i) { int R, C; stage_rc(tid * 16 + i * 8192, R, C); const int r32_ = R & 31;
        const int Rb = P::WIDE ? (64 * (R >> 5) + 16 * ((r32_ & 15) >> 2) + 4 * (r32_ >> 4) + (r32_ & 3))
                             : (P::PERM ? ((R & ~31) + perm32(r32_)) : R);
        voffB[i] = (unsigned)(Rb * RB + C * 2); }
    constexpr unsigned hstepB = (unsigned)(P::WIDE ? 8 : HALF) * RB;
    const unsigned ldsw = (unsigned)wid * 1024u;
    const int aoff = lds_byte(wr * 64 + fr, fq * 8), boff = lds_byte(wc * 32 + fr, fq * 8);
    const char* const abase = p.a_base();
#define PG8_SA(b, h) (((b) * 2 + (h)) * HTB)
#define PG8_SB(b, h) ((4 + (b) * 2 + (h)) * HTB)
#define PG8_STAGE_A(bufoff, o, koff) do { _Pragma("unroll") for (int _i = 0; _i < 2; ++_i) \
        __builtin_amdgcn_global_load_lds((const unsigned*)(abase + (size_t)(o)[_i] + (koff)), (LAS unsigned*)(lds + (bufoff) + ldsw + _i * 8192), 16, 0, 0); } while (0)
#define PG8_STAGE_B(bufoff, gbase, koff) do { _Pragma("unroll") for (int _i = 0; _i < 2; ++_i) \
        __builtin_amdgcn_global_load_lds((const unsigned*)((gbase) + (size_t)(voffB[_i] + (koff))), (LAS unsigned*)(lds + (bufoff) + ldsw + _i * 8192), 16, 0, 0); } while (0)
#define PG8_LDA(dst, b, h) do { _Pragma("unroll") for (int m = 0; m < 4; ++m) _Pragma("unroll") for (int k = 0; k < 2; ++k) dst[m][k] = *(const LAS bf16x8*)(lds + PG8_SA(b, h) + aoff + m * 2048 + k * 1024); } while (0)
#define PG8_LDB(dst, b, h) do { _Pragma("unroll") for (int n = 0; n < 2; ++n) _Pragma("unroll") for (int k = 0; k < 2; ++k) dst[n][k] = *(const LAS bf16x8*)(lds + PG8_SB(b, h) + boff + n * 2048 + k * 1024); } while (0)
#define PG8_MMA(ai, bj, At, Bt) do { __builtin_amdgcn_s_setprio(1); _Pragma("unroll") for (int m = 0; m < 4; ++m) _Pragma("unroll") for (int n = 0; n < 2; ++n) { \
        if constexpr (P::FP8) { const i32x8 b8_ = cat8(Bt[n][0], Bt[n][1]), a8_ = cat8(At[m][0], At[m][1]); \
            asm volatile("v_mfma_scale_f32_16x16x128_f8f6f4 %0, %1, %2, %0, %3, %4 op_sel_hi:[0,0,0]" : "+v"(acc[ai][bj][m][n]) : "v"(b8_), "v"(a8_), "v"(sclW), "v"(sclX)); } \
        else { _Pragma("unroll") for (int k = 0; k < 2; ++k) acc[ai][bj][m][n] = __builtin_amdgcn_mfma_f32_16x16x32_bf16(Bt[n][k], At[m][k], acc[ai][bj][m][n], 0, 0, 0); } } __builtin_amdgcn_s_setprio(0); } while (0)
#define PG8_WAIT_V(n) asm volatile("s_waitcnt vmcnt(" #n ")" ::: "memory")
#define PG8_WAIT_L(n) asm volatile("s_waitcnt lgkmcnt(" #n ")" ::: "memory")
#define PG8_BAR __builtin_amdgcn_s_barrier()
#define PG8_SCHED __builtin_amdgcn_sched_barrier(0)
    Unit cur, nxt; int ui = 0; nxt.pm = nxt.pn = nxt.e = nxt.j = 0;
    if (!p.next(0, cur)) return;
    f32x4 acc[2][2][4][2];
#pragma unroll
    for (int a = 0; a < 2; ++a)
#pragma unroll
        for (int b = 0; b < 2; ++b)
#pragma unroll
            for (int m = 0; m < 4; ++m)
#pragma unroll
                for (int n = 0; n < 2; ++n) acc[a][b][m][n] = (f32x4){0.f, 0.f, 0.f, 0.f};
    bf16x8 At[4][2], B0[2][2], B1[2][2];
    unsigned oC[2][2];
    int kN[2][2];
#define PG8_RC(i, R_, C_) int R_, C_; { int t2_ = tid; asm volatile("" : "+v"(t2_)); stage_rc(t2_ * 16 + (i) * 8192, R_, C_); }
    { PG8_RC(0, R0, C0); PG8_RC(1, R1, C1); const int RR[2] = {R0, R1}; p.a_key(cur, RR, kN);
#pragma unroll
      for (int h = 0; h < 2; ++h) { oC[h][0] = (unsigned)(kN[h][0] * RB + C0 * 2); oC[h][1] = (unsigned)(kN[h][1] * RB + C1 * 2); } }
    const char* cB = p.b_base(cur);
    constexpr int BIAS_OFF = STAGE_BYTES + 2048;
    if (P::HAS_BIAS && wid == 0) p.dma_bias(cur, (LAS unsigned*)(lds + BIAS_OFF), lane);
    int sclW = p.scale_w(cur); const int sclX = p.scale_x();
    PG8_STAGE_B(PG8_SB(0, 0), cB, 0u); PG8_STAGE_B(PG8_SB(0, 1), cB + hstepB, 0u); PG8_STAGE_A(PG8_SA(0, 0), oC[0], 0u); PG8_STAGE_A(PG8_SA(0, 1), oC[1], 0u);
    if (wr == 1) PG8_BAR;
    PG8_WAIT_V(2); PG8_BAR;
    PG8_STAGE_B(PG8_SB(1, 0), cB, 128u); PG8_STAGE_A(PG8_SA(1, 0), oC[0], 128u); PG8_STAGE_B(PG8_SB(1, 1), cB + hstepB, 128u);
    PG8_WAIT_V(6); PG8_BAR;
    for (;;) {
        const bool has_next = p.next(ui + 1, nxt);
        const char* nB = cB;
        if (has_next) { PG8_RC(0, R0, C0); PG8_RC(1, R1, C1); (void)C0; (void)C1; const int RR[2] = {R0, R1}; p.a_key(nxt, RR, kN); nB = p.b_base(nxt);
            if (P::HAS_BIAS && wid == 0) p.dma_bias(nxt, (LAS unsigned*)(lds + BIAS_OFF + ((ui + 1) & 1) * 1024), lane); }
#pragma unroll 1
        for (int t = 0; t < nt; t += 2) {
            const bool last = (t == nt - 2);
            const unsigned k1 = (unsigned)(t + 1) * 128u, k2 = last ? 0u : (unsigned)(t + 2) * 128u, k3 = k2 + 128u;
            unsigned o2[2][2];
            if (last) { asm volatile("" : "+v"(kN[0][0]), "+v"(kN[0][1]), "+v"(kN[1][0]), "+v"(kN[1][1])); PG8_RC(0, R0, C0); PG8_RC(1, R1, C1); (void)R0; (void)R1;
#pragma unroll
                for (int h = 0; h < 2; ++h) { o2[h][0] = (unsigned)(kN[h][0] * RB + C0 * 2); o2[h][1] = (unsigned)(kN[h][1] * RB + C1 * 2); } }
            else {
#pragma unroll
                for (int h = 0; h < 2; ++h)
#pragma unroll
                    for (int i = 0; i < 2; ++i) o2[h][i] = oC[h][i]; }
            const char* b2 = last ? nB : cB;
            PG8_LDB(B0, 0, 0); PG8_LDB(B1, 0, 1); PG8_SCHED; PG8_LDA(At, 0, 0); PG8_STAGE_A(PG8_SA(1, 1), oC[1], k1);
            PG8_WAIT_V(8); PG8_WAIT_L(0); PG8_BAR; PG8_MMA(0, 0, At, B0); PG8_MMA(0, 1, At, B1); PG8_BAR; PG8_SCHED;
            PG8_LDA(At, 0, 1); PG8_STAGE_B(PG8_SB(0, 0), b2, k2); PG8_STAGE_B(PG8_SB(0, 1), b2 + hstepB, k2); PG8_STAGE_A(PG8_SA(0, 0), o2[0], k2);
            PG8_WAIT_V(8); PG8_WAIT_L(0); PG8_BAR; PG8_MMA(1, 0, At, B0); PG8_MMA(1, 1, At, B1); PG8_BAR; PG8_SCHED;
            PG8_LDB(B0, 1, 0); PG8_LDB(B1, 1, 1); PG8_SCHED; PG8_LDA(At, 1, 0); PG8_STAGE_A(PG8_SA(0, 1), o2[1], k2);
            PG8_WAIT_V(8); PG8_WAIT_L(0); PG8_BAR; PG8_MMA(0, 0, At, B0); PG8_MMA(0, 1, At, B1); PG8_BAR; PG8_SCHED;
            PG8_LDA(At, 1, 1); PG8_STAGE_B(PG8_SB(1, 0), b2, k3); PG8_STAGE_B(PG8_SB(1, 1), b2 + hstepB, k3); PG8_STAGE_A(PG8_SA(1, 0), o2[0], k3);
            PG8_WAIT_V(8); PG8_WAIT_L(0); PG8_BAR; PG8_MMA(1, 0, At, B0); PG8_MMA(1, 1, At, B1); PG8_BAR; PG8_SCHED;
        }
        if (wr == 0) PG8_BAR;
        if constexpr (P::FP8) asm volatile("s_nop 15\n\ts_nop 7" ::: "memory");
        p.epi(acc, cur, (const LAS float*)(lds + BIAS_OFF + (ui & 1) * 1024), wr, wc, fr, fq);
        if (!has_next) break;
#pragma unroll
        for (int a = 0; a < 2; ++a)
#pragma unroll
            for (int b = 0; b < 2; ++b)
#pragma unroll
                for (int m = 0; m < 4; ++m)
#pragma unroll
                    for (int n = 0; n < 2; ++n) acc[a][b][m][n] = (f32x4){0.f, 0.f, 0.f, 0.f};
        cur = nxt; cB = nB; ++ui; sclW = p.scale_w(cur);
        { PG8_RC(0, R0, C0); PG8_RC(1, R1, C1); (void)R0; (void)R1;
#pragma unroll
          for (int h = 0; h < 2; ++h) { oC[h][0] = (unsigned)(kN[h][0] * RB + C0 * 2); oC[h][1] = (unsigned)(kN[h][1] * RB + C1 * 2); } }
        if (wr == 1) PG8_BAR;
    }
    PG8_WAIT_V(0);
    PG8_BAR;
#undef PG8_RC
#undef PG8_SA
#undef PG8_SB
#undef PG8_STAGE_A
#undef PG8_STAGE_B
#undef PG8_LDA
#undef PG8_LDB
#undef PG8_MMA
#undef PG8_WAIT_V
#undef PG8_WAIT_L
#undef PG8_BAR
#undef PG8_SCHED
}
}

template <bool Q> struct ProbProjT {
    static constexpr bool WIDE = false;
    static constexpr bool HAS_BIAS = false; __device__ __forceinline__ void dma_bias(const pg8::Unit&, LAS unsigned*, int) const {}
    static constexpr bool PERM = true, FP8 = Q;
    __device__ __forceinline__ int scale_w(const pg8::Unit&) const { return (127 - sw) * 0x01010101; }
    __device__ __forceinline__ int scale_x() const { return 0x7f7f7f7f; }
    const void* A; const void* Bt; bf16_t* C; int ldc; int sw; pg8::StaticOrder S;
    __device__ __forceinline__ bool next(int i, pg8::Unit& u) const { return S.next(i, u); }
    __device__ __forceinline__ const char* a_base() const { return (const char*)A; }
    __device__ __forceinline__ void a_key(const pg8::Unit& u, const int (&R)[2], int (&k)[2][2]) const {
#pragma unroll
        for (int h = 0; h < 2; ++h)
#pragma unroll
            for (int i = 0; i < 2; ++i) k[h][i] = u.pm * 256 + h * 128 + R[i];
    }
    __device__ __forceinline__ const char* b_base(const pg8::Unit& u) const { return (const char*)Bt + (size_t)u.pn * 256 * pg8::KD * (Q ? 1 : 2); }
    __device__ __forceinline__ void epi(const f32x4 (&acc)[2][2][4][2], const pg8::Unit& u, const LAS float*, int wr, int wc, int fr, int fq) const {
        const int row0 = u.pm * 256 + wr * 64 + fr, col0 = u.pn * 256 + wc * 32 + 8 * fq;
#pragma unroll
        for (int ai = 0; ai < 2; ++ai)
#pragma unroll
            for (int m = 0; m < 4; ++m) { bf16_t* rowp = C + (size_t)(row0 + ai * 128 + m * 16) * ldc + col0;
#pragma unroll
                for (int bj = 0; bj < 2; ++bj) { const f32x4 v0 = acc[ai][bj][m][0], v1 = acc[ai][bj][m][1];
                    u32x4 w; w.x = pg8::cvt_pk_bf16(v0[0], v0[1]); w.y = pg8::cvt_pk_bf16(v0[2], v0[3]); w.z = pg8::cvt_pk_bf16(v1[0], v1[1]); w.w = pg8::cvt_pk_bf16(v1[2], v1[3]);
                    *(u32x4*)(rowp + bj * 128) = w; } }
    }
};
struct ProbOut {
    static constexpr bool WIDE = false;
    static constexpr bool HAS_BIAS = false; __device__ __forceinline__ void dma_bias(const pg8::Unit&, LAS unsigned*, int) const {}
    static constexpr bool PERM = false, FP8 = false;
    __device__ __forceinline__ int scale_w(const pg8::Unit&) const { return 0; }
    __device__ __forceinline__ int scale_x() const { return 0; }
    const bf16_t* A; const bf16_t* Bt; float* C; pg8::StaticOrder S;
    __device__ __forceinline__ bool next(int i, pg8::Unit& u) const { return S.next(i, u); }
    __device__ __forceinline__ const char* a_base() const { return (const char*)A; }
    __device__ __forceinline__ void a_key(const pg8::Unit& u, const int (&R)[2], int (&k)[2][2]) const {
#pragma unroll
        for (int h = 0; h < 2; ++h)
#pragma unroll
            for (int i = 0; i < 2; ++i) k[h][i] = u.pm * 256 + h * 128 + R[i];
    }
    __device__ __forceinline__ const char* b_base(const pg8::Unit& u) const { return (const char*)Bt + (size_t)u.pn * 256 * pg8::KD * 2; }
    __device__ __forceinline__ void epi(const f32x4 (&acc)[2][2][4][2], const pg8::Unit& u, const LAS float*, int wr, int wc, int fr, int fq) const {
        const int row0 = u.pm * 256 + wr * 64 + fr, col0 = u.pn * 256 + wc * 32 + 4 * fq;
#pragma unroll
        for (int ai = 0; ai < 2; ++ai)
#pragma unroll
            for (int m = 0; m < 4; ++m) { float* rowp = C + (size_t)(row0 + ai * 128 + m * 16) * D + col0;
#pragma unroll
                for (int bj = 0; bj < 2; ++bj)
#pragma unroll
                    for (int n = 0; n < 2; ++n) *(f32x4*)(rowp + bj * 128 + n * 16) = acc[ai][bj][m][n]; }
    }
};
struct MoeTab { const LAS int* cnt; const LAS int* pblk; const LAS int* scl; const LAS unsigned short* eb; };
__device__ __forceinline__ bool moe_next(const MoeTab& tb, int npn, int G, int c, int i, pg8::Unit& u) {
    const int nb = tb.pblk[32]; int blk, pn;
    if (G == 256) {
        const int x = c & 7, q = c >> 3, npnh = npn >> 2, tau = 8 * i + x, sr = tau / npnh, pnh = tau - sr * npnh;
        blk = sr * 8 + (q & 7); pn = pnh * 4 + (q >> 3); if (blk >= nb) return false;
    } else { const long L = (long)i * G + c; if (L >= (long)nb * npn) return false; blk = (int)(L / npn); pn = (int)(L % npn); }
    const int e = tb.eb[blk];
    u.e = __builtin_amdgcn_readfirstlane(e); u.pm = __builtin_amdgcn_readfirstlane(blk); u.pn = __builtin_amdgcn_readfirstlane(pn); u.j = u.pm - tb.pblk[u.e]; u.j = __builtin_amdgcn_readfirstlane(u.j);
    return true;
}
constexpr float YS_SCALE = 8.0f;
constexpr float HID_SCALE = 4.0f; constexpr int HID_SCALE_LOG2 = 2;
struct ProbMoe1 {
    static constexpr bool WIDE = false;
    static constexpr bool HAS_BIAS = true;
    __device__ __forceinline__ void dma_bias(const pg8::Unit& u, LAS unsigned* slot, int lane) const {
        const float* src = bgu + (size_t)u.e * 2048 + u.pn * 128 + (lane < 32 ? 4 * lane : 1024 + 4 * (lane - 32)); __builtin_amdgcn_global_load_lds((const unsigned*)src, slot, 16, 0, 0); }
    static constexpr bool PERM = true, FP8 = true;
    const unsigned char* X; const unsigned char* Wgu; const float* bgu; unsigned char* hid; const int* rtok; MoeTab tb; int G, c;
    __device__ __forceinline__ int scale_w(const pg8::Unit& u) const { return (127 - tb.scl[u.e]) * 0x01010101; }
    __device__ __forceinline__ int scale_x() const { return 0x7f7f7f7f; }
    __device__ __forceinline__ bool next(int i, pg8::Unit& u) const { return moe_next(tb, 8, G, c, i, u); }
    __device__ __forceinline__ const char* a_base() const { return (const char*)X; }
    __device__ __forceinline__ void a_key(const pg8::Unit& u, const int (&R)[2], int (&k)[2][2]) const {
        const int n1 = tb.cnt[u.e] - 1;
#pragma unroll
        for (int h = 0; h < 2; ++h)
#pragma unroll
            for (int i = 0; i < 2; ++i) { const int rank = u.j * 256 + h * 128 + R[i]; k[h][i] = rtok[u.e * ECAP + (rank < n1 ? rank : n1)]; }
    }
    __device__ __forceinline__ const char* b_base(const pg8::Unit& u) const { return (const char*)Wgu + ((size_t)u.e * 2048 + (size_t)u.pn * 256) * pg8::KD; }
    __device__ __forceinline__ void epi(const f32x4 (&acc)[2][2][4][2], const pg8::Unit& u, const LAS float* bs, int wr, int wc, int fr, int fq) const {
        const int row0 = u.pm * 256 + wr * 64 + fr, col0 = u.pn * 128 + wc * 32 + 8 * fq; const int cl = wc * 32 + 8 * fq;
        const f32x4 bg0 = *(const LAS f32x4*)(bs + cl), bg1 = *(const LAS f32x4*)(bs + cl + 4), bu0 = *(const LAS f32x4*)(bs + 128 + cl), bu1 = *(const LAS f32x4*)(bs + 128 + cl + 4);
#pragma unroll
        for (int ai = 0; ai < 2; ++ai)
#pragma unroll
            for (int m = 0; m < 4; ++m) {
                float hv[8];
#pragma unroll
                for (int n = 0; n < 2; ++n) { const f32x4 g4 = acc[ai][0][m][n] + (n ? bg1 : bg0), u4 = acc[ai][1][m][n] + (n ? bu1 : bu0);
#pragma unroll
                    for (int q = 0; q < 4; q += 2) {
                        f32x2 g = {fminf(g4[q], 7.0f), fminf(g4[q + 1], 7.0f)}, up = {__builtin_amdgcn_fmed3f(u4[q], -7.0f, 7.0f), __builtin_amdgcn_fmed3f(u4[q + 1], -7.0f, 7.0f)};
                        const f32x2 ar = g * (f32x2){-1.702f * 1.4426950408889634f, -1.702f * 1.4426950408889634f};
                        f32x2 den = {__builtin_amdgcn_exp2f(ar[0]), __builtin_amdgcn_exp2f(ar[1])}; den = den + (f32x2){1.0f, 1.0f};
                        const f32x2 sg = {__builtin_amdgcn_rcpf(den[0]), __builtin_amdgcn_rcpf(den[1])};
                        const f32x2 r = (up * (f32x2){HID_SCALE, HID_SCALE} + (f32x2){HID_SCALE, HID_SCALE}) * (g * sg);
                        hv[n * 4 + q] = r[0]; hv[n * 4 + q + 1] = r[1]; } }
                int w0 = 0, w1 = 0;
                w0 = __builtin_amdgcn_cvt_pk_fp8_f32(hv[0], hv[1], w0, false); w0 = __builtin_amdgcn_cvt_pk_fp8_f32(hv[2], hv[3], w0, true);
                w1 = __builtin_amdgcn_cvt_pk_fp8_f32(hv[4], hv[5], w1, false); w1 = __builtin_amdgcn_cvt_pk_fp8_f32(hv[6], hv[7], w1, true);
                *(u32x2*)(hid + (size_t)(row0 + ai * 128 + m * 16) * DE + col0) = (u32x2){(unsigned)w0, (unsigned)w1}; }
    }
};
struct ProbMoe2 {
    static constexpr bool WIDE = true;
    static constexpr bool HAS_BIAS = true;
    __device__ __forceinline__ void dma_bias(const pg8::Unit& u, LAS unsigned* slot, int lane) const { __builtin_amdgcn_global_load_lds((const unsigned*)(bdn + (size_t)u.e * 1024 + u.pn * 256 + 4 * lane), slot, 16, 0, 0); }
    static constexpr bool PERM = true, FP8 = true;
    const unsigned char* hid; const unsigned char* Wdn; const float* bdn; unsigned char* ys; const float* rgate; MoeTab tb; int G, c;
    __device__ __forceinline__ int scale_w(const pg8::Unit& u) const { return (127 - tb.scl[u.e]) * 0x01010101; }
    __device__ __forceinline__ int scale_x() const { return (127 - HID_SCALE_LOG2) * 0x01010101; }
    __device__ __forceinline__ bool next(int i, pg8::Unit& u) const { return moe_next(tb, 4, G, c, i, u); }
    __device__ __forceinline__ const char* a_base() const { return (const char*)hid; }
    __device__ __forceinline__ void a_key(const pg8::Unit& u, const int (&R)[2], int (&k)[2][2]) const {
#pragma unroll
        for (int h = 0; h < 2; ++h)
#pragma unroll
            for (int i = 0; i < 2; ++i) k[h][i] = u.pm * 256 + h * 128 + R[i];
    }
    __device__ __forceinline__ const char* b_base(const pg8::Unit& u) const { return (const char*)Wdn + ((size_t)u.e * 1024 + (size_t)u.pn * 256) * pg8::KD; }
    __device__ __forceinline__ void epi(const f32x4 (&acc)[2][2][4][2], const pg8::Unit& u, const LAS float* bs, int wr, int wc, int fr, int fq) const {
        const int row0 = u.pm * 256 + wr * 64 + fr, col0 = u.pn * 256 + wc * 64 + 16 * fq; const int cl = wc * 64 + 16 * fq;
        f32x4 bv[2][2];
#pragma unroll
        for (int bj = 0; bj < 2; ++bj)
#pragma unroll
            for (int n = 0; n < 2; ++n) bv[bj][n] = *(const LAS f32x4*)(bs + cl + 8 * bj + 4 * n) * YS_SCALE;
#pragma unroll
        for (int ai = 0; ai < 2; ++ai)
#pragma unroll
            for (int m = 0; m < 4; ++m) { int w4[4];
#pragma unroll
                for (int bj = 0; bj < 2; ++bj)
#pragma unroll
                    for (int n = 0; n < 2; ++n) { const f32x4 v = acc[ai][bj][m][n] * YS_SCALE + bv[bj][n]; int t_ = 0; t_ = __builtin_amdgcn_cvt_pk_fp8_f32(v[0], v[1], t_, false); t_ = __builtin_amdgcn_cvt_pk_fp8_f32(v[2], v[3], t_, true); w4[bj * 2 + n] = t_; }
                *(u32x4*)(ys + (size_t)(row0 + ai * 128 + m * 16) * D + col0) = (u32x4){(unsigned)w4[0], (unsigned)w4[1], (unsigned)w4[2], (unsigned)w4[3]}; }
    }
};

constexpr int HA_QH = 0, HA_KH = 8704, HA_QT = 17408, HA_KT = 26112, HA_VT = 36352, HA_DEC = 46592, HA_OPB = 47104;
constexpr int HA_ST = 2 * HA_OPB, HA_P = HA_ST + 34816, HA_TOT = HA_P + 2560;
__device__ __forceinline__ void hg_phase_a(LAS unsigned char* lds, int item, int l, const bf16_t* proj, const float* lbt, bf16_t* oloc, bf16_t* qseg, float* sfin, float* dseg) {
    int tid_l = (int)threadIdx.x; asm volatile("" : "+v"(tid_l));
    const int tid = tid_l, lane = tid & 63, w = __builtin_amdgcn_readfirstlane(tid >> 6), fr = lane & 15, fq = lane >> 4;
    const int seg = item & 3, dir = (item >> 2) & 1, h = (item >> 3) & 3, b = item >> 5;
    const int d0 = 2 * lane;
    const f32x2 lb2 = *(const f32x2*)(lbt + (size_t)l * 2 * HGW + dir * HGW + h * 128 + d0); const f32x2 omlb2 = (f32x2){1.0f, 1.0f} - lb2;
    LAS float* tot = (LAS float*)(lds + HA_TOT);
    __syncthreads();
    { unsigned z_ = 0u; asm volatile("" : "+v"(z_));
      for (int i = tid; i < 34816 / 16; i += NTHR) *(LAS u32x4*)(lds + HA_ST + i * 16) = (u32x4){z_, z_, z_, z_}; }
    f32x4 accS[8];
#pragma unroll
    for (int i = 0; i < 8; ++i) accS[i] = (f32x4){0.f, 0.f, 0.f, 0.f};
    float Gc[2] = {0.f, 0.f};
    unsigned rq[4], ri[4], rf[4];
    float cs[2][4], kk[2][4], qq[2][4]; unsigned vv[4];
    const unsigned colq2_ = (unsigned)(h * 128 + d0) * 2u;
    const unsigned oloff_ = ((unsigned)(dir ? 15 - fr : fr) * (unsigned)HGW + (unsigned)(h * 128 + w * 16 + 4 * fq)) * 2u;
#define HG_ROW(c, p) ((unsigned)(b * SEQ + (dir ? (SEQ - 1 - (seg * 1024 + (c) * 32 + (p))) : (seg * 1024 + (c) * 32 + (p)))))
#define HG_LOAD(c) do { unsigned colq2 = colq2_; asm volatile("" : "+v"(colq2)); _Pragma("unroll") for (int i = 0; i < 4; ++i) { const char* rp_ = (const char*)proj + (size_t)HG_ROW(c, 4 * w + i) * (INC * 2); const char* rpf_ = rp_ + (size_t)dir * 1024; \
            rq[i] = *(const unsigned*)(rp_ + colq2); ri[i] = *(const unsigned*)(rp_ + (colq2 + 1024u)); rf[i] = *(const unsigned*)(rpf_ + (colq2 + 2048u)); } } while (0)
#define HG_E1() do { f32x2 run2; _Pragma("unroll") for (int e = 0; e < 2; ++e) { float run = 0.f; const float lb = lb2[e], omlb = omlb2[e]; \
            _Pragma("unroll") for (int i = 0; i < 4; ++i) { const float z = e ? bf2f(rf[i] >> 16) : bf2f(rf[i] & 0xffffu), sg = sigmoidf_(z); const float f = lb + omlb * sg; run += log_(f); cs[e][i] = run; kk[e][i] = omlb * (1.0f - sg); \
                const float zq = e ? bf2f(rq[i] >> 16) : bf2f(rq[i] & 0xffffu); qq[e][i] = zq * sigmoidf_(zq); } run2[e] = run; } \
            _Pragma("unroll") for (int i = 0; i < 4; ++i) vv[i] = ri[i]; *(LAS f32x2*)(tot + w * 128 + d0) = run2; } while (0)
#define HG_E2(c, ob) do { unsigned colq2 = colq2_; asm volatile("" : "+v"(colq2)); f32x2 off = {0.f, 0.f}, gref = {0.f, 0.f}, glast = {0.f, 0.f}; \
          _Pragma("unroll") for (int g_ = 0; g_ < 8; ++g_) { const f32x2 t_ = *(const LAS f32x2*)(tot + g_ * 128 + d0); if (g_ < w) off += t_; if (g_ < 4) gref += t_; glast += t_; } \
          float egref[2], eglr[2], egc[2]; _Pragma("unroll") for (int e = 0; e < 2; ++e) { egref[e] = exp_(gref[e]); eglr[e] = exp_(glast[e] - gref[e]); egc[e] = exp_(gref[e] + Gc[e]); } \
          float kt[2][4]; \
          _Pragma("unroll") for (int i = 0; i < 4; ++i) { const int p = 4 * w + i; float qh[2], kh[2]; \
              _Pragma("unroll") for (int e = 0; e < 2; ++e) { const float g = off[e] + cs[e][i]; const float e1 = exp_(g - gref[e]), e2 = rcpf_(e1); qh[e] = qq[e][i] * e1; kh[e] = kk[e][i] * e2; kt[e][i] = kh[e] * eglr[e]; } \
              *(LAS unsigned*)(lds + (ob) + HA_QH + p * 272 + d0 * 2) = pk2(qh[0], qh[1]); *(LAS unsigned*)(lds + (ob) + HA_KH + p * 272 + d0 * 2) = pk2(kh[0], kh[1]); \
              *(LAS unsigned*)(lds + (ob) + HA_QT + p * 272 + d0 * 2) = pk2(qh[0] * egref[0], qh[1] * egref[1]); *(unsigned*)((char*)qseg + (size_t)((unsigned)dir * T + HG_ROW(c, p)) * (HGW * 2) + colq2) = pk2(qh[0] * egc[0], qh[1] * egc[1]); } \
          _Pragma("unroll") for (int e = 0; e < 2; ++e) { \
              *(LAS u32x2*)(lds + (ob) + HA_KT + (d0 + e) * 80 + w * 8) = (u32x2){pk2(kt[e][0], kt[e][1]), pk2(kt[e][2], kt[e][3])}; \
              *(LAS u32x2*)(lds + (ob) + HA_VT + (d0 + e) * 80 + w * 8) = e ? (u32x2){(vv[0] >> 16) | (vv[1] & 0xffff0000u), (vv[2] >> 16) | (vv[3] & 0xffff0000u)} : (u32x2){(vv[0] & 0xffffu) | (vv[1] << 16), (vv[2] & 0xffffu) | (vv[3] << 16)}; } \
          if (w == 0) *(LAS f32x2*)(lds + (ob) + HA_DEC + d0 * 4) = (f32x2){exp_(glast[0]), exp_(glast[1])}; Gc[0] += glast[0]; Gc[1] += glast[1]; } while (0)
    HG_LOAD(0);
    HG_E1();
    HG_LOAD(1);
    __syncthreads();
    HG_E2(0, 0);
#define HG_XM() do { \
        if (w < 4) { const int tt = w >> 1, st = w & 1; f32x4 sc = (f32x4){0.f, 0.f, 0.f, 0.f}; \
            if (st <= tt) { \
        _Pragma("unroll") \
                for (int ks = 0; ks < 4; ++ks) { const bf16x8 a = *(const LAS bf16x8*)(lds + ob + HA_QH + (tt * 16 + fr) * 272 + ks * 64 + fq * 16), bb = *(const LAS bf16x8*)(lds + ob + HA_KH + (st * 16 + fr) * 272 + ks * 64 + fq * 16); \
                    sc = __builtin_amdgcn_mfma_f32_16x16x32_bf16(a, bb, sc, 0, 0, 0); } } \
        _Pragma("unroll") \
            for (int r = 0; r < 4; ++r) { const int t = tt * 16 + 4 * fq + r, s_ = st * 16 + fr; *(LAS unsigned short*)(lds + HA_P + t * 80 + s_ * 2) = (unsigned short)((s_ <= t) ? f2bf(sc[r]) : 0u); } } \
        _Pragma("unroll") \
        for (int ks = 0; ks < 4; ++ks) { const bf16x8 bs = *(const LAS bf16x8*)(lds + HA_ST + (w * 16 + fr) * 272 + ks * 64 + fq * 16); \
        _Pragma("unroll") \
            for (int tt = 0; tt < 2; ++tt) { const bf16x8 a = *(const LAS bf16x8*)(lds + ob + HA_QT + (tt * 16 + fr) * 272 + ks * 64 + fq * 16); ao[tt] = __builtin_amdgcn_mfma_f32_16x16x32_bf16(bs, a, ao[tt], 0, 0, 0); } } \
    } while (0)
#define HG_YM() do { \
        { const bf16x8 bv = *(const LAS bf16x8*)(lds + ob + HA_VT + (w * 16 + fr) * 80 + fq * 16); unsigned oloff = oloff_; asm volatile("" : "+v"(oloff)); \
        _Pragma("unroll") \
          for (int tt = 0; tt < 2; ++tt) { const bf16x8 a = *(const LAS bf16x8*)(lds + HA_P + (tt * 16 + fr) * 80 + fq * 16); ao[tt] = __builtin_amdgcn_mfma_f32_16x16x32_bf16(bv, a, ao[tt], 0, 0, 0); \
              const unsigned srow = dir ? HG_ROW(c, tt * 16 + 15) : HG_ROW(c, tt * 16); *(u32x2*)((char*)oloc + (size_t)((unsigned)dir * T + srow) * (HGW * 2) + oloff) = (u32x2){pk2(ao[tt][0], ao[tt][1]), pk2(ao[tt][2], ao[tt][3])}; } } \
        { const bf16x8 ak = *(const LAS bf16x8*)(lds + ob + HA_KT + (w * 16 + fr) * 80 + fq * 16); \
          const f32x4 dv = *(const LAS f32x4*)(lds + ob + HA_DEC + (w * 16 + 4 * fq) * 4); \
          bf16x8 bvs[8]; \
        _Pragma("unroll") \
          for (int vt = 0; vt < 8; ++vt) bvs[vt] = *(const LAS bf16x8*)(lds + ob + HA_VT + (vt * 16 + fr) * 80 + fq * 16); \
        _Pragma("unroll") \
          for (int vt = 0; vt < 8; ++vt) accS[vt] = accS[vt] * dv; \
        _Pragma("unroll") \
          for (int vt = 0; vt < 8; ++vt) accS[vt] = __builtin_amdgcn_mfma_f32_16x16x32_bf16(ak, bvs[vt], accS[vt], 0, 0, 0); \
        _Pragma("unroll") \
          for (int vt = 0; vt < 8; ++vt) { u32x2 sw; sw.x = pk2(accS[vt][0], accS[vt][1]); sw.y = pk2(accS[vt][2], accS[vt][3]); \
              *(LAS u32x2*)(lds + HA_ST + (vt * 16 + fr) * 272 + (w * 16 + 4 * fq) * 2) = sw; } } \
    } while (0)
    for (int c = 0; c < 32; ++c) {
        const int ob = (c & 1) * HA_OPB, obn = ((c + 1) & 1) * HA_OPB;
        __syncthreads();
        f32x4 ao[2] = {(f32x4){0.f, 0.f, 0.f, 0.f}, (f32x4){0.f, 0.f, 0.f, 0.f}};
        if (w < 4) { HG_XM(); HG_E1(); } else { HG_E1(); HG_XM(); }
        { const int cn_ = c + 2 < 32 ? c + 2 : 31; HG_LOAD(cn_); }
        __syncthreads();
        if (w < 4) { HG_YM(); if (c + 1 < 32) HG_E2(c + 1, obn); } else { if (c + 1 < 32) HG_E2(c + 1, obn); HG_YM(); }
    }
#undef HG_XM
#undef HG_YM
#undef HG_ROW
#undef HG_LOAD
#undef HG_E1
#undef HG_E2
#pragma unroll
    for (int vt = 0; vt < 8; ++vt) *(f32x4*)(sfin + (size_t)item * 16384 + (size_t)(vt * 16 + fr) * 128 + w * 16 + 4 * fq) = accS[vt];
    if (w == 0) *(f32x2*)(dseg + (size_t)item * 128 + d0) = (f32x2){exp_(Gc[0]), exp_(Gc[1])};
    __syncthreads();
}

__device__ __forceinline__ void hg_phase_c(LAS unsigned char* lds, int cb, int l, const bf16_t* proj, const bf16_t* oloc, const bf16_t* qseg, const float* sfin, const float* dseg, const float* hgn, bf16_t* mix) {
    int tid_l = (int)threadIdx.x; asm volatile("" : "+v"(tid_l));
    const int tid = tid_l, lane = tid & 63, w = __builtin_amdgcn_readfirstlane(tid >> 6), fr = lane & 15, fq = lane >> 4;
    const int half = cb & 1, segtok = (cb >> 1) & 3, h = (cb >> 3) & 3, b = cb >> 5;
    __syncthreads();
#pragma unroll
    for (int dir = 0; dir < 2; ++dir) { const int k = dir ? 3 - segtok : segtok; const int item0 = ((b * 4 + h) * 2 + dir) * 4;
        f32x4 s0[8], s1[8], s2[8], d1[8], d2[8];
#pragma unroll
        for (int i = 0; i < 8; ++i) { const int e4 = tid + NTHR * i; const int v = e4 >> 5, d0 = (e4 & 31) * 4; const size_t so = (size_t)v * 128 + d0;
            s0[i] = k > 0 ? *(const f32x4*)(sfin + (size_t)(item0 + 0) * 16384 + so) : (f32x4){0.f, 0.f, 0.f, 0.f};
            s1[i] = k > 1 ? *(const f32x4*)(sfin + (size_t)(item0 + 1) * 16384 + so) : (f32x4){0.f, 0.f, 0.f, 0.f};
            s2[i] = k > 2 ? *(const f32x4*)(sfin + (size_t)(item0 + 2) * 16384 + so) : (f32x4){0.f, 0.f, 0.f, 0.f};
            d1[i] = k > 1 ? *(const f32x4*)(dseg + (size_t)(item0 + 1) * 128 + d0) : (f32x4){1.f, 1.f, 1.f, 1.f};
            d2[i] = k > 2 ? *(const f32x4*)(dseg + (size_t)(item0 + 2) * 128 + d0) : (f32x4){1.f, 1.f, 1.f, 1.f}; }
#pragma unroll
        for (int i = 0; i < 8; ++i) { const int e4 = tid + NTHR * i; const int v = e4 >> 5, d0 = (e4 & 31) * 4; f32x4 cv = s0[i];
            if (k > 1) cv = cv * d1[i] + s1[i];
            if (k > 2) cv = cv * d2[i] + s2[i];
            u32x2 cw; cw.x = pk2(cv[0], cv[1]); cw.y = pk2(cv[2], cv[3]); *(LAS u32x2*)(lds + dir * 34816 + v * 272 + d0 * 2) = cw; } }
    __syncthreads();
    f32x4 gnv[8];
#pragma unroll
    for (int vt = 0; vt < 8; ++vt) gnv[vt] = *(const f32x4*)(hgn + h * 128 + vt * 16 + 4 * fq);
    const int kf = segtok, kb = 3 - segtok;
#pragma unroll 1
    for (int tile = 0; tile < 4; ++tile) {
        const int t = segtok * 1024 + (half * 4 + tile) * 128 + w * 16 + fr; const size_t row = (size_t)b * SEQ + t;
        bf16x8 bq[2][4]; u32x2 olf[8], olb[8], zgv[8];
#pragma unroll
        for (int dir = 0; dir < 2; ++dir)
#pragma unroll
            for (int ks = 0; ks < 4; ++ks) bq[dir][ks] = *(const bf16x8*)(qseg + ((size_t)dir * T + row) * HGW + h * 128 + ks * 32 + fq * 8);
#pragma unroll
        for (int vt = 0; vt < 8; ++vt) { const int v0 = vt * 16 + 4 * fq; olf[vt] = *(const u32x2*)(oloc + (size_t)row * HGW + h * 128 + v0); olb[vt] = *(const u32x2*)(oloc + ((size_t)T + row) * HGW + h * 128 + v0);
            zgv[vt] = *(const u32x2*)(proj + row * INC + 2048 + h * 128 + v0); }
        f32x4 acc[8];
#pragma unroll
        for (int i = 0; i < 8; ++i) acc[i] = (f32x4){0.f, 0.f, 0.f, 0.f};
#pragma unroll
        for (int dir = 0; dir < 2; ++dir) { const int k = dir ? kb : kf;
            if (k > 0) {
#pragma unroll
                for (int ks = 0; ks < 4; ++ks) {
#pragma unroll
                    for (int vt = 0; vt < 8; ++vt) { const bf16x8 ac = *(const LAS bf16x8*)(lds + dir * 34816 + (vt * 16 + fr) * 272 + ks * 64 + fq * 16); acc[vt] = __builtin_amdgcn_mfma_f32_16x16x32_bf16(ac, bq[dir][ks], acc[vt], 0, 0, 0); } } } }
        float ss = 0.f;
#pragma unroll
        for (int vt = 0; vt < 8; ++vt) { const u32x2 of = olf[vt], ob = olb[vt];
            acc[vt][0] += bf2f(of.x & 0xffffu) + bf2f(ob.x & 0xffffu); acc[vt][1] += bf2f(of.x >> 16) + bf2f(ob.x >> 16); acc[vt][2] += bf2f(of.y & 0xffffu) + bf2f(ob.y & 0xffffu); acc[vt][3] += bf2f(of.y >> 16) + bf2f(ob.y >> 16);
            ss += (acc[vt][0] * acc[vt][0] + acc[vt][1] * acc[vt][1]) + (acc[vt][2] * acc[vt][2] + acc[vt][3] * acc[vt][3]); }
        ss += __shfl_xor(ss, 16); ss += __shfl_xor(ss, 32);
        const float rs = rsqf_(ss * (1.0f / 128.f) + RMS_EPS);
#pragma unroll
        for (int vt = 0; vt < 8; ++vt) { const int v0 = vt * 16 + 4 * fq; const u32x2 zg = zgv[vt]; const f32x4 gn = gnv[vt];
            const float z0 = bf2f(zg.x & 0xffffu), z1 = bf2f(zg.x >> 16), z2 = bf2f(zg.y & 0xffffu), z3 = bf2f(zg.y >> 16);
            u32x2 ow; ow.x = pk2(acc[vt][0] * rs * gn[0] * (z0 * sigmoidf_(z0)), acc[vt][1] * rs * gn[1] * (z1 * sigmoidf_(z1))); ow.y = pk2(acc[vt][2] * rs * gn[2] * (z2 * sigmoidf_(z2)), acc[vt][3] * rs * gn[3] * (z3 * sigmoidf_(z3)));
            *(u32x2*)(mix + row * D + h * 128 + v0) = ow; }
    }
}

constexpr int LR_XC = 0, LR_CAR = 65536, LR_RED = 73728, LR_HS = 75776;
template <int MODE>
__device__ __forceinline__ void lru_pair(LAS unsigned char* lds, int b, int kpair, const bf16_t* proj, const float* cw, const float* cbias, const bf16_t* lruw_l, const float* ba_l, const float* bx_l, const float* lam_l, float* lsum, const float* lrn, bf16_t* mix) {
    int tid_l = (int)threadIdx.x; asm volatile("" : "+v"(tid_l));
    const int tid = tid_l, lane = tid & 63, w = __builtin_amdgcn_readfirstlane(tid >> 6), fr = lane & 15, fq = lane >> 4;
    __syncthreads();
    if (MODE == 1) {
        const int c0 = tid, k0s = 2 * kpair; float cf = 0.f, cbk = 0.f;
        const float* Af = lsum + ((size_t)(0 * 2 + 0) * BATCH + b) * 64 * LRW + c0; const float* Hf = lsum + ((size_t)(0 * 2 + 1) * BATCH + b) * 64 * LRW + c0;
        const float* Ab = lsum + ((size_t)(1 * 2 + 0) * BATCH + b) * 64 * LRW + c0; const float* Hb = lsum + ((size_t)(1 * 2 + 1) * BATCH + b) * 64 * LRW + c0;
        for (int k0 = 0; k0 < k0s; k0 += 16) { float av[16], hv[16];
#pragma unroll
            for (int q = 0; q < 16; ++q) { const int kk = k0 + q; const bool ok = kk < k0s; av[q] = ok ? Af[(size_t)kk * LRW] : 1.0f; hv[q] = ok ? Hf[(size_t)kk * LRW] : 0.0f; }
#pragma unroll
            for (int q = 0; q < 16; ++q) cf = av[q] * cf + hv[q]; }
        for (int k0 = 63; k0 > k0s + 1; k0 -= 16) { float av[16], hv[16];
#pragma unroll
            for (int q = 0; q < 16; ++q) { const int kk = k0 - q; const bool ok = kk > k0s + 1; av[q] = ok ? Ab[(size_t)kk * LRW] : 1.0f; hv[q] = ok ? Hb[(size_t)kk * LRW] : 0.0f; }
#pragma unroll
            for (int q = 0; q < 16; ++q) cbk = av[q] * cbk + hv[q]; }
        LAS float* car = (LAS float*)(lds + LR_CAR);
        car[(0 * 2 + 0) * 512 + c0] = cf; car[(1 * 2 + 0) * 512 + c0] = Af[(size_t)k0s * LRW] * cf + Hf[(size_t)k0s * LRW];
        car[(1 * 2 + 1) * 512 + c0] = cbk; car[(0 * 2 + 1) * 512 + c0] = Ab[(size_t)(k0s + 1) * LRW] * cbk + Hb[(size_t)(k0s + 1) * LRW];
    }
#pragma unroll 1
    for (int sub = 0; sub < 2; ++sub) {
        const int ksub = 2 * kpair + sub; const size_t row0 = (size_t)b * SEQ + (size_t)ksub * 64;
        if (sub) __syncthreads();
        { const int cp = (tid & 255) * 2, th = tid >> 8; const int t0 = ksub * 64 + th * 32;
          const f32x2 w0 = *(const f32x2*)(cw + cp), w1 = *(const f32x2*)(cw + LRW + cp), w2 = *(const f32x2*)(cw + 2 * LRW + cp), w3 = *(const f32x2*)(cw + 3 * LRW + cp), bs = *(const f32x2*)(cbias + cp);
          const bf16_t* zp = proj + ((size_t)b * SEQ + t0) * INC + 2560 + cp;
          unsigned zr[35];
#pragma unroll
          for (int q = 0; q < 35; ++q) { const bool edge = (q < 2) || (q == 34); const bool ok = (q < 2) ? (t0 != 0) : (t0 + 32 < SEQ);
              const long ro = edge ? (ok ? (long)(q - 2) : 0L) : (long)(q - 2); const unsigned zv = *(const unsigned*)(zp + ro * INC); zr[q] = (edge && !ok) ? 0u : zv; }
          const int hd = cp >> 6, ii = cp & 63;
#pragma unroll
          for (int q = 0; q < 32; ++q) { const int tl = th * 32 + q;
              const float x0 = bs[0] + w0[0] * bf2f(zr[q] & 0xffffu) + w1[0] * bf2f(zr[q + 1] & 0xffffu) + w2[0] * bf2f(zr[q + 2] & 0xffffu) + w3[0] * bf2f(zr[q + 3] & 0xffffu);
              const float x1 = bs[1] + w0[1] * bf2f(zr[q] >> 16) + w1[1] * bf2f(zr[q + 1] >> 16) + w2[1] * bf2f(zr[q + 2] >> 16) + w3[1] * bf2f(zr[q + 3] >> 16);
              *(LAS unsigned*)(lds + LR_XC + hd * 8192 + tl * 128 + ((((ii >> 3) ^ (tl & 7))) << 4) + (ii & 7) * 2) = pk2(x0, x1); } }
        __syncthreads();
        float ssq[16];
#pragma unroll
        for (int k = 0; k < 16; ++k) ssq[k] = 0.f;
        bf16x8 bw[2][4]; float cst[2][3];
#pragma unroll
        for (int q_ = 0; q_ < 4; ++q_) bw[1][q_] = (bf16x8){0, 0, 0, 0, 0, 0, 0, 0};
        cst[1][0] = cst[1][1] = cst[1][2] = 0.f;
#define LR_LOADW(it, buf) do { const int jt_ = (it) >> 1, dir_ = (it) & 1, j_ = jt_ * 16 + fr, c_ = w * 64 + j_; \
            _Pragma("unroll") for (int ks_ = 0; ks_ < 2; ++ks_) { bw[buf][ks_ * 2 + 0] = *(const bf16x8*)(lruw_l + ((size_t)((dir_ * 2 + 0) * LRH + w) * 64 + j_) * 64 + ks_ * 32 + fq * 8); \
                                                                  bw[buf][ks_ * 2 + 1] = *(const bf16x8*)(lruw_l + ((size_t)((dir_ * 2 + 1) * LRH + w) * 64 + j_) * 64 + ks_ * 32 + fq * 8); } \
            cst[buf][0] = ba_l[dir_ * LRW + c_]; cst[buf][1] = bx_l[dir_ * LRW + c_]; cst[buf][2] = lam_l[dir_ * LRW + c_]; } while (0)
        LR_LOADW(0, 0);
#pragma unroll 1
        for (int jt = 0; jt < 4; ++jt) {
            const int j = jt * 16 + fr, c = w * 64 + j;
            float xcv[16], hsum[16];
#pragma unroll
            for (int k = 0; k < 16; ++k) { const int tl = 16 * fq + k; xcv[k] = bf2f(*(const LAS unsigned short*)(lds + LR_XC + w * 8192 + tl * 128 + ((((j >> 3) ^ (tl & 7))) << 4) + (j & 7) * 2)); }
#pragma unroll
            for (int dir = 0; dir < 2; ++dir) {
                constexpr int dummy = 0; (void)dummy;
                const int it = jt * 2 + dir; constexpr int dummy2 = 0; (void)dummy2; const int buf = dir;
                { const int itn_ = (it + 1 < 8) ? it + 1 : 7; LR_LOADW(itn_, dir ^ 1); }
                const float bav = cst[buf][0], bxv = cst[buf][1], lamv = cst[buf][2];
                const float sp8 = -8.0f * ((lamv < -20.f) ? -lamv : log_(1.0f + exp_(-lamv)));
                f32x4 aR[4], aI[4];
#pragma unroll
                for (int tt = 0; tt < 4; ++tt) { aR[tt] = (f32x4){0.f, 0.f, 0.f, 0.f}; aI[tt] = (f32x4){0.f, 0.f, 0.f, 0.f}; }
#pragma unroll
                for (int ks = 0; ks < 2; ++ks) {
#pragma unroll
                    for (int tt = 0; tt < 4; ++tt) { const int tla = 16 * (fr >> 2) + 4 * tt + (fr & 3); const bf16x8 av = *(const LAS bf16x8*)(lds + LR_XC + w * 8192 + tla * 128 + ((((ks * 4 + fq) ^ (tla & 7))) << 4));
                        aR[tt] = __builtin_amdgcn_mfma_f32_16x16x32_bf16(av, bw[buf][ks * 2 + 0], aR[tt], 0, 0, 0); aI[tt] = __builtin_amdgcn_mfma_f32_16x16x32_bf16(av, bw[buf][ks * 2 + 1], aI[tt], 0, 0, 0); } }
                float hl[16], pc[16]; float hh = 0.f, pp = 1.0f;
                { constexpr float NL2E = -1.4426950408889634f; const f32x2 nl2 = {NL2E, NL2E}, one2 = {1.0f, 1.0f}, bar2 = {bav * NL2E, bav * NL2E}, bxr2 = {bxv * NL2E, bxv * NL2E}, spl2 = {sp8 * -NL2E, sp8 * -NL2E};
#pragma unroll
                  for (int k = 0; k < 16; k += 2) { const int tt = k >> 2, r = k & 3;
                    const f32x2 er = (f32x2){aR[tt][r], aR[tt][r + 1]} * nl2 + bar2, ei = (f32x2){aI[tt][r], aI[tt][r + 1]} * nl2 + bxr2;
                    const f32x2 dr = (f32x2){__builtin_amdgcn_exp2f(er[0]), __builtin_amdgcn_exp2f(er[1])} + one2, di = (f32x2){__builtin_amdgcn_exp2f(ei[0]), __builtin_amdgcn_exp2f(ei[1])} + one2;
                    const f32x2 rr = {__builtin_amdgcn_rcpf(dr[0]), __builtin_amdgcn_rcpf(dr[1])}, ig = {__builtin_amdgcn_rcpf(di[0]), __builtin_amdgcn_rcpf(di[1])};
                    const f32x2 ea = rr * spl2; const f32x2 a = {__builtin_amdgcn_exp2f(ea[0]), __builtin_amdgcn_exp2f(ea[1])};
                    const f32x2 om = one2 - a * a; const f32x2 sq = {__builtin_amdgcn_sqrtf(__builtin_fabsf(om[0])), __builtin_amdgcn_sqrtf(__builtin_fabsf(om[1]))};
                    const f32x2 u = sq * (ig * (f32x2){xcv[k], xcv[k + 1]});
                    pc[k] = a[0]; pc[k + 1] = a[1]; hl[k] = u[0]; hl[k + 1] = u[1]; } }
#pragma unroll
                for (int kk = 0; kk < 16; ++kk) { const int k = dir ? 15 - kk : kk; hh = pc[k] * hh + hl[k]; pp = pp * pc[k]; hl[k] = hh; pc[k] = pp; }
                const float P0 = __shfl(pp, fr), P1 = __shfl(pp, fr + 16), P2 = __shfl(pp, fr + 32), P3 = __shfl(pp, fr + 48);
                const float H0 = __shfl(hh, fr), H1 = __shfl(hh, fr + 16), H2 = __shfl(hh, fr + 32), H3 = __shfl(hh, fr + 48);
                float cin, pin, Ht, At;
                if (dir == 0) { const float c1 = H0, c2 = P1 * c1 + H1, c3 = P2 * c2 + H2; const float p1 = P0, p2 = P0 * P1, p3 = p2 * P2;
                    cin = fq == 0 ? 0.f : (fq == 1 ? c1 : (fq == 2 ? c2 : c3)); pin = fq == 0 ? 1.0f : (fq == 1 ? p1 : (fq == 2 ? p2 : p3)); Ht = P3 * c3 + H3; At = p3 * P3; }
                else { const float c2 = H3, c1 = P2 * c2 + H2, c0_ = P1 * c1 + H1; const float p2 = P3, p1 = P3 * P2, p0 = p1 * P1;
                    cin = fq == 3 ? 0.f : (fq == 2 ? c2 : (fq == 1 ? c1 : c0_)); pin = fq == 3 ? 1.0f : (fq == 2 ? p2 : (fq == 1 ? p1 : p0)); Ht = P0 * c0_ + H0; At = p0 * P0; }
                if (MODE == 0) { if (fq == 0) { lsum[(((size_t)(dir * 2 + 0) * BATCH + b) * 64 + ksub) * LRW + c] = At; lsum[(((size_t)(dir * 2 + 1) * BATCH + b) * 64 + ksub) * LRW + c] = Ht; } }
                else { const float ein = cin + pin * ((const LAS float*)(lds + LR_CAR))[(sub * 2 + dir) * 512 + c];
#pragma unroll
                    for (int k = 0; k < 16; ++k) { const float hv = hl[k] + pc[k] * ein; hsum[k] = dir ? hsum[k] + hv : hv; } }
            }
            if (MODE == 1) {
#pragma unroll
                for (int k = 0; k < 16; ++k) { ssq[k] += hsum[k] * hsum[k]; *(LAS unsigned short*)(lds + LR_HS + (16 * fq + k) * 1024 + c * 2) = (unsigned short)f2bf(hsum[k]); }
            }
        }
#undef LR_LOADW
        if (MODE == 1) {
            LAS float* red = (LAS float*)(lds + LR_RED);
#pragma unroll
            for (int k = 0; k < 16; ++k) {
#define LR_DPP_ADD(ctrl) ssq[k] += __builtin_bit_cast(float, __builtin_amdgcn_update_dpp(0, __builtin_bit_cast(int, ssq[k]), ctrl, 0xf, 0xf, false))
                LR_DPP_ADD(0xB1); LR_DPP_ADD(0x4E); LR_DPP_ADD(0x141); LR_DPP_ADD(0x140);
#undef LR_DPP_ADD
            }
            if (fr == 0) {
#pragma unroll
                for (int k = 0; k < 16; ++k) red[w * 64 + 16 * fq + k] = ssq[k]; }
            __syncthreads();
#pragma unroll 2
            for (int i = 0; i < 8; ++i) { const int idx = tid + NTHR * i, tk = idx >> 6, c8 = (idx & 63) * 8; float t_ = 0.f;
#pragma unroll
                for (int ww = 0; ww < 8; ++ww) t_ += red[ww * 64 + tk];
                const float rs = rsqf_(t_ * (1.0f / 512.f) + RMS_EPS);
                const u32x4 hw = *(const LAS u32x4*)(lds + LR_HS + tk * 1024 + c8 * 2); const size_t row = row0 + tk; const u32x4 zw = *(const u32x4*)(proj + row * INC + 3072 + c8);
                const f32x4 g0 = *(const f32x4*)(lrn + c8), g1 = *(const f32x4*)(lrn + c8 + 4); unsigned ow[4];
#pragma unroll
                for (int q = 0; q < 4; ++q) { float hv[2] = {bf2f(hw[q] & 0xffffu), bf2f(hw[q] >> 16)}, zz[2] = {bf2f(zw[q] & 0xffffu), bf2f(zw[q] >> 16)}, rr[2];
#pragma unroll
                    for (int e2 = 0; e2 < 2; ++e2) { const int cc = 2 * q + e2; rr[e2] = hv[e2] * rs * (cc < 4 ? g0[cc] : g1[cc - 4]) * gelu_tanh_(zz[e2]); }
                    ow[q] = pk2(rr[0], rr[1]); }
                *(u32x4*)(mix + row * D + 512 + c8) = (u32x4){ow[0], ow[1], ow[2], ow[3]}; }
        }
    }
}

#define XB_TMO      128
#define XB_XCNT(j)  (256  + 64 * (j))
#define XB_XSUB(j)  (1280 + 64 * (j))
#define XB_XGEN(j)  (2304 + 64 * (j))
#define XB_TOP      3328
#define XB_TOPGEN   3392
#define XCD_BAR_WORDS 3456
#define XB_SPIN_CAP (1u << 18)
__device__ __forceinline__ unsigned xb_ld(unsigned* p)              { return __hip_atomic_load(p, __ATOMIC_RELAXED, __HIP_MEMORY_SCOPE_AGENT); }
__device__ __forceinline__ unsigned xb_add(unsigned* p, unsigned v) { return __hip_atomic_fetch_add(p, v, __ATOMIC_RELAXED, __HIP_MEMORY_SCOPE_AGENT); }
__device__ __forceinline__ unsigned xb_xcc_id() { return (unsigned)__builtin_amdgcn_s_getreg((3 << 11) | 20) & 0xFu; }
#define XB_SPIN(cond, bar) do { unsigned _sp = 0; while (cond) { __builtin_amdgcn_s_sleep(1); \
    if ((++_sp & 255u) == 0u) { if (xb_ld(&(bar)[XB_TMO])) break; if (_sp > XB_SPIN_CAP) { atomicAdd(&(bar)[XB_TMO], 1u); break; } } } } while (0)
struct XcdBarrier { unsigned* bar; unsigned x; volatile LAS unsigned* st; };
__device__ __forceinline__ XcdBarrier xcd_barrier_post(unsigned* bar, volatile LAS unsigned* st) {
    XcdBarrier b; b.bar = bar; b.x = xb_xcc_id(); b.st = st;
    if (threadIdx.x == 0) (void)xb_add(&bar[XB_XCNT(b.x)], 1u);
    return b;
}
__device__ __forceinline__ void xcd_barrier_complete(unsigned* bar, unsigned x, unsigned& nloc, unsigned& nx) {
    const unsigned G = gridDim.x * gridDim.y * gridDim.z;
    unsigned sum, cnt, mine, sp = 0u;
    for (;;) {
        sum = 0u; cnt = 0u; mine = 0u;
#pragma unroll
        for (unsigned j = 0; j < 16; ++j) { const unsigned c = xb_ld(&bar[XB_XCNT(j)]); sum += c; cnt += (c > 0u) ? 1u : 0u; mine = (j == x) ? c : mine; }
        if (sum == G) break;
        __builtin_amdgcn_s_sleep(1);
        if ((++sp & 255u) == 0u) { if (xb_ld(&bar[XB_TMO])) break; if (sp > XB_SPIN_CAP) { atomicAdd(&bar[XB_TMO], 1u); break; } }
    }
    nloc = mine > 0u ? mine : 1u; nx = cnt > 0u ? cnt : 1u;
}
__device__ __forceinline__ void xcd_barrier(const XcdBarrier& b_in) {
    XcdBarrier b = b_in; asm volatile("" : "+s"(b.bar), "+s"(b.x));
    asm volatile("s_waitcnt vmcnt(0)" ::: "memory");
    __syncthreads();
    if (threadIdx.x == 0) {
        unsigned* bar = b.bar;
        __builtin_amdgcn_s_waitcnt(0);
        unsigned nloc = b.st[0], nx = b.st[1];
        if (nloc == 0u) { xcd_barrier_complete(bar, b.x, nloc, nx); b.st[0] = nloc; b.st[1] = nx; }
        const unsigned old = xb_add(&bar[XB_XSUB(b.x)], 1u);
        const unsigned gen = old / nloc;
        if (old + 1u == (gen + 1u) * nloc) {
            __builtin_amdgcn_fence(__ATOMIC_RELEASE, "agent");
            asm volatile("s_waitcnt vmcnt(0)" ::: "memory");
            const unsigned og = xb_add(&bar[XB_TOP], 1u);
            const unsigned tg = og / nx;
            if (og + 1u == (tg + 1u) * nx) xb_add(&bar[XB_TOPGEN], 1u);
            else XB_SPIN(xb_ld(&bar[XB_TOPGEN]) == tg, bar);
            __builtin_amdgcn_fence(__ATOMIC_ACQUIRE, "agent");
            xb_add(&bar[XB_XGEN(b.x)], 1u);
            asm volatile("s_waitcnt vmcnt(0)" ::: "memory");
        } else {
            XB_SPIN(xb_ld(&bar[XB_XGEN(b.x)]) == gen, bar);
            __builtin_amdgcn_fence(__ATOMIC_ACQUIRE, "agent");
            asm volatile("s_waitcnt vmcnt(0)" ::: "memory");
        }
    }
    __syncthreads();
}

struct Args { const float* in[23]; float* out; unsigned char* ws; int l_lo, l_hi, ph_lo, ph_hi, pro, pad; };
enum { I_X = 0, I_WIN, I_HGLB, I_HGNORM, I_CONVW, I_CONVB, I_WA, I_BA, I_WX, I_BX, I_LAM, I_LRUNORM, I_WOUT, I_LN1G, I_LN1B, I_RW, I_RB, I_WGU, I_BGU, I_WDN, I_BDN, I_LN2G, I_LN2B };
enum { PH_PROJ = 1, PH_HG = 2, PH_LRUAU = 3, PH_LRUSCAN = 4, PH_COMB = 5, PH_OUTG = 6, PH_LN1R = 7, PH_MOE1 = 8, PH_MOE2 = 9, PH_LN2 = 10, PH_END = 11 };

__device__ __forceinline__ void transpose_item(const float* W, int N, int k0, int n0, bf16_t* WT, size_t dst_row0, int KP, LAS float* scr, int lane) {
#pragma unroll 8
    for (int i = 0; i < 32; ++i) { const int kk = 2 * i + (lane >> 5); scr[kk * 33 + (lane & 31)] = W[(size_t)(k0 + kk) * N + n0 + (lane & 31)]; }
    LDS_WAIT(); asm volatile("" ::: "memory");
    const int c = lane & 7;
#pragma unroll
    for (int j = 0; j < 4; ++j) { const int n = (lane >> 3) + 8 * j; const LAS float* s = scr + (8 * c) * 33 + n;
        u32x4 o; o.x = pk2(s[0 * 33], s[1 * 33]); o.y = pk2(s[2 * 33], s[3 * 33]); o.z = pk2(s[4 * 33], s[5 * 33]); o.w = pk2(s[6 * 33], s[7 * 33]);
        *(u32x4*)(WT + (dst_row0 + n) * KP + k0 + 8 * c) = o; }
    LDS_WAIT(); asm volatile("" ::: "memory");
}

__device__ __forceinline__ void transpose_item_q(const float* W, int N, int k0, int n0, unsigned char* WT, size_t dst_row0, int KP, float mul, LAS float* scr, int lane) {
#pragma unroll 8
    for (int i = 0; i < 32; ++i) { const int kk = 2 * i + (lane >> 5); scr[kk * 33 + (lane & 31)] = W[(size_t)(k0 + kk) * N + n0 + (lane & 31)]; }
    LDS_WAIT(); asm volatile("" ::: "memory");
    const int c = lane & 7;
#pragma unroll
    for (int j = 0; j < 4; ++j) { const int n = (lane >> 3) + 8 * j; const LAS float* s = scr + (8 * c) * 33 + n; int w0 = 0, w1 = 0;
        w0 = __builtin_amdgcn_cvt_pk_fp8_f32(s[0 * 33] * mul, s[1 * 33] * mul, w0, false); w0 = __builtin_amdgcn_cvt_pk_fp8_f32(s[2 * 33] * mul, s[3 * 33] * mul, w0, true);
        w1 = __builtin_amdgcn_cvt_pk_fp8_f32(s[4 * 33] * mul, s[5 * 33] * mul, w1, false); w1 = __builtin_amdgcn_cvt_pk_fp8_f32(s[6 * 33] * mul, s[7 * 33] * mul, w1, true);
        *(u32x2*)(WT + (dst_row0 + n) * KP + k0 + 8 * c) = (u32x2){(unsigned)w0, (unsigned)w1}; }
    LDS_WAIT(); asm volatile("" ::: "memory");
}
__device__ __forceinline__ void transpose_item_q2(const float* W, int N, int k0, int n0, unsigned char* WT, size_t dst_row0, int KP, float mul, LAS float* scr, int lane) {
#pragma unroll 8
    for (int i = 0; i < 32; ++i) { const int kk = 4 * i + (lane >> 4), n = lane & 15; scr[n * 132 + kk] = W[(size_t)(k0 + kk) * N + n0 + n]; }
    LDS_WAIT(); asm volatile("" ::: "memory");
    const int c = lane & 15;
#pragma unroll
    for (int j = 0; j < 4; ++j) { const int n = (lane >> 4) + 4 * j; const f32x4 a = *(const LAS f32x4*)(scr + n * 132 + 8 * c), b = *(const LAS f32x4*)(scr + n * 132 + 8 * c + 4); int w0 = 0, w1 = 0;
        w0 = __builtin_amdgcn_cvt_pk_fp8_f32(a[0] * mul, a[1] * mul, w0, false); w0 = __builtin_amdgcn_cvt_pk_fp8_f32(a[2] * mul, a[3] * mul, w0, true);
        w1 = __builtin_amdgcn_cvt_pk_fp8_f32(b[0] * mul, b[1] * mul, w1, false); w1 = __builtin_amdgcn_cvt_pk_fp8_f32(b[2] * mul, b[3] * mul, w1, true);
        *(u32x2*)(WT + (dst_row0 + n) * KP + k0 + 8 * c) = (u32x2){(unsigned)w0, (unsigned)w1}; }
    LDS_WAIT(); asm volatile("" ::: "memory");
}
__device__ __forceinline__ int fp8_scale_exp(const float* W, int stride, int lane) {
    float a = 0.f;
#pragma unroll
    for (int q = 0; q < 8; ++q) a += fabsf(W[(size_t)(lane * 8 + q) * stride]);
    a = wave_sum(a) * (1.0f / 512.f);
    int s = (a > 0.f) ? (int)rintf(-log2f(a)) : 0; return s < -24 ? -24 : (s > 24 ? 24 : s);
}

typedef const __attribute__((address_space(4))) Args* CArgs;
#define PHASE_ENV() \
    CArgs A = (CArgs)__builtin_amdgcn_kernarg_segment_ptr(); asm volatile("" : "+s"(A)); \
    int tid_l_ = (int)threadIdx.x, bid_l_ = (int)blockIdx.x, G_l_ = (int)gridDim.x; asm volatile("" : "+v"(tid_l_), "+s"(bid_l_), "+s"(G_l_)); \
    const int tid = tid_l_, lane = tid & 63, wave = __builtin_amdgcn_readfirstlane(tid >> 6), G = G_l_, bid = bid_l_, gw = bid * NWAVES + wave, NGW = G * NWAVES; (void)lane; (void)gw; (void)NGW; \
    unsigned char* ws = A->ws; \
    unsigned* ctl = (unsigned*)(ws + WS_CTL); (void)ctl; \
    float* lbt = (float*)(ws + WS_LBT); (void)lbt; \
    bf16_t* rwh = (bf16_t*)(ws + WS_RWH); bf16_t* rwl = (bf16_t*)(ws + WS_RWL); (void)rwh; (void)rwl; \
    bf16_t* win_t = (bf16_t*)(ws + WS_WIN); bf16_t* wout_t = (bf16_t*)(ws + WS_WOUT); bf16_t* wgu_t = (bf16_t*)(ws + WS_WGU); bf16_t* wdn_t = (bf16_t*)(ws + WS_WDN); (void)win_t; (void)wout_t; (void)wgu_t; (void)wdn_t; \
    bf16_t* xb = (bf16_t*)(ws + WS_XB); float* xres = (float*)(ws + WS_XRES); bf16_t* proj = (bf16_t*)(ws + WS_PROJ); bf16_t* mix = (bf16_t*)(ws + WS_MIX); (void)xb; (void)xres; (void)proj; (void)mix; \
    float* ybuf = (float*)(ws + WS_Y); bf16_t* ybf = (bf16_t*)(ws + WS_Y); (void)ybf; float* x1 = (float*)(ws + WS_X1); bf16_t* x1b = (bf16_t*)(ws + WS_X1B); unsigned char* hid = ws + WS_HID; unsigned char* wguq = ws + WS_WGU; unsigned char* wdnq = ws + WS_WDN; unsigned char* x1q = ws + WS_X1Q; unsigned char* xq = ws + WS_XQ; unsigned char* winq = ws + WS_WINQ; (void)xq; (void)winq; (void)wguq; (void)wdnq; (void)x1q; unsigned char* ysl = ws + WS_YS; (void)ybuf; (void)x1; (void)x1b; (void)hid; (void)ysl; \
    int* rtok = (int*)(ws + WS_RTOK); float* rgate = (float*)(ws + WS_RGATE); int* tslot = (int*)(ws + WS_TSLOT); (void)rtok; (void)rgate; (void)tslot; \
    float* odir = (float*)(ws + WS_ODIR); float* hdir = (float*)(ws + WS_HDIR); float* aub = (float*)(ws + WS_AU); (void)odir; (void)hdir; (void)aub; \
    bf16_t* oloc = (bf16_t*)(ws + WS_OLOC); bf16_t* qseg = (bf16_t*)(ws + WS_QSEG); float* sfin = (float*)(ws + WS_SFIN); float* dseg = (float*)(ws + WS_DSEG); float* lsum = (float*)(ws + WS_LSUM); bf16_t* lruw = (bf16_t*)(ws + WS_LRUW); (void)oloc; (void)qseg; (void)sfin; (void)dseg; (void)lsum; (void)lruw; \
    const float* xin = (l == 0) ? A->in[I_X] : (const float*)xres; float* xout = (l == NL - 1) ? A->out : xres; unsigned* cntg = ctl + CW_CNT + 1024 * l; (void)xin; (void)xout; (void)cntg

#define MOE_TABLES(sclp) do { __syncthreads(); \
    if (tid < 32) { tabcnt[tid] = (int)__hip_atomic_load(cntg + 32 * tid, __ATOMIC_RELAXED, __HIP_MEMORY_SCOPE_AGENT); tabscl[tid] = (sclp) ? ((const int*)(sclp))[tid] : 0; } \
    __syncthreads(); \
    if (tid == 0) { int s_ = 0; for (int e_ = 0; e_ < 32; ++e_) { tabpblk[e_] = s_; s_ += (tabcnt[e_] + 255) >> 8; } tabpblk[32] = s_; } \
    __syncthreads(); \
    for (int i_ = tid; i_ < tabpblk[32] && i_ < 1024; i_ += NTHR) { int e_ = 0; for (int q2_ = 1; q2_ < 32; ++q2_) e_ += (tabpblk[q2_] <= i_) ? 1 : 0; tabeb[i_] = (unsigned short)e_; }     \
    __syncthreads(); } while (0)

template <int PH> __global__ void __launch_bounds__(NTHR, 2) mk_fwd(Args args) {
    extern __shared__ __attribute__((aligned(16))) unsigned char lds_raw[];
    LAS unsigned char* lds = (LAS unsigned char*)lds_raw;
    const int tid = threadIdx.x, lane = tid & 63, wave = __builtin_amdgcn_readfirstlane(tid >> 6);
    const int G = gridDim.x, bid = blockIdx.x;
    const int gw = bid * NWAVES + wave, NGW = G * NWAVES;
    LAS int* tabcnt = (LAS int*)(lds + 131072 + 1024); LAS int* tabpblk = (LAS int*)(lds + 131072 + 1024 + 256); LAS int* tabscl = (LAS int*)(lds + 131072 + 1024 + 512); LAS unsigned short* tabeb = (LAS unsigned short*)(lds + 131072 + 6144);
    XcdBarrier bar; bar.bar = nullptr; bar.x = 0; bar.st = nullptr;
    if (PH == 0) {
        volatile LAS unsigned* bst = (volatile LAS unsigned*)(lds + LDS_BYTES - 16);
        if (tid == 0) { bst[0] = 0u; bst[1] = 0u; }
        __syncthreads();
        bar = xcd_barrier_post((unsigned*)(args.ws + WS_CTL) + CW_BAR, bst);
    }
#define GRID_BAR() do { if (PH == 0) xcd_barrier(bar); } while (0)
#ifndef PROBE_REP
#define PROBE_REP 0
#endif
#define REPS(k) (((PROBE_REP >> (k)) & 1) ? 2 : 1)

    for (int rep_ = 0; rep_ < REPS(0); ++rep_) if (PH == -1 || PH == 0) {
        const int l = 0; PHASE_ENV();
        LAS float* scr = (LAS float*)(lds + wave * 16384);
        { constexpr int per = 16 * 112; for (int it = gw; it < NL * per; it += NGW) { const int ll = it / per, r = it % per, kb = r / 112, nb = r % 112; const float* src = A->in[I_WIN] + (size_t)ll * D * INC;
            const int sx = fp8_scale_exp(src, 7177, lane); if (r == 0 && lane == 0) ((int*)ctl)[CW_SIN + ll] = sx;
            transpose_item_q(src, INC, kb * 64, nb * 32, winq + (size_t)ll * INC * D, (size_t)nb * 32, D, exp2f((float)sx), scr, lane); } }
        { constexpr int per = 16 * 32; for (int it = gw; it < NL * per; it += NGW) { const int ll = it / per, r = it % per, kb = r / 32, nb = r % 32;
            transpose_item(A->in[I_WOUT] + (size_t)ll * D * D, D, kb * 64, nb * 32, wout_t + (size_t)ll * D * D, (size_t)nb * 32, D, scr, lane); } }
        for (int pe = gw >> 4; pe < NL * NE; pe += NGW >> 4) { const float* src = A->in[I_WGU] + (size_t)pe * D * 2048; const int sx = fp8_scale_exp(src, 4099, lane); const float mul = exp2f((float)sx);
            if ((gw & 15) == 0 && lane == 0) ((int*)ctl)[CW_SGU + pe] = sx;
            for (int r = gw & 15; r < 8 * 128; r += 16) { const int kb = r / 128, nb = r % 128; const int n0 = nb * 16, cc = n0 & 1023, isup = n0 >> 10; const size_t drow = (size_t)(cc >> 7) * 256 + (size_t)isup * 128 + (cc & 127);
                transpose_item_q2(src, 2048, kb * 128, n0, wguq + (size_t)pe * 2048 * D, drow, D, mul, scr, lane); } }
        for (int pe = gw >> 4; pe < NL * NE; pe += NGW >> 4) { const float* src = A->in[I_WDN] + (size_t)pe * DE * D; const int sx = fp8_scale_exp(src, 2051, lane); const float mul = exp2f((float)sx);
            if ((gw & 15) == 0 && lane == 0) ((int*)ctl)[CW_SDN + pe] = sx;
            for (int r = gw & 15; r < 8 * 64; r += 16) { const int kb = r / 64, nb = r % 64;
                transpose_item_q2(src, D, kb * 128, nb * 16, wdnq + (size_t)pe * D * DE, (size_t)nb * 16, DE, mul, scr, lane); } }
        for (int i = bid * NTHR + tid; i < NL * NE * D; i += G * NTHR) { const int ll = i / (NE * D), r = i % (NE * D), e = r / D, d = r % D; const float w = A->in[I_RW][(size_t)ll * D * NE + (size_t)d * NE + e];
            const unsigned h = f2bf(w); rwh[i] = (bf16_t)h; rwl[i] = (bf16_t)f2bf(w - bf2f(h)); }
        for (int i = bid * NTHR + tid; i < NL * 2 * 2 * LRH * LHD * LHD; i += G * NTHR) { const int ii = i & 63, jj = (i >> 6) & 63, hh = (i >> 12) & 7, wh = (i >> 15) & 1, dl = i >> 16;
            const float* src = wh ? A->in[I_WX] : A->in[I_WA]; lruw[i] = (bf16_t)f2bf(src[((size_t)dl * LRH + hh) * LHD * LHD + (size_t)ii * LHD + jj]); }
        for (size_t i = (size_t)bid * NTHR + tid; i < (size_t)T * D / 4; i += (size_t)G * NTHR) { const f32x4 v = ((const f32x4*)A->in[I_X])[i]; u32x2 o; o.x = pk2(v[0], v[1]); o.y = pk2(v[2], v[3]); ((u32x2*)xb)[i] = o; int q_ = 0; q_ = __builtin_amdgcn_cvt_pk_fp8_f32(v[0], v[1], q_, false); q_ = __builtin_amdgcn_cvt_pk_fp8_f32(v[2], v[3], q_, true); ((int*)xq)[i] = q_; }
        for (int i = bid * NTHR + tid; i < 2 * HGW; i += G * NTHR) { const float* p = A->in[I_HGLB] + i; float v[NL], mx = -3.0e38f;
#pragma unroll
            for (int q = 0; q < NL; ++q) { v[q] = p[(size_t)q * 2 * HGW]; mx = fmaxf(mx, v[q]); }
            float s = 0.f;
#pragma unroll
            for (int q = 0; q < NL; ++q) { v[q] = expf(v[q] - mx); s += v[q]; }
            float cum = 0.f;
#pragma unroll
            for (int q = 0; q < NL; ++q) { if (q > 0) cum += v[q] / s; lbt[(size_t)q * 2 * HGW + i] = fminf(fmaxf(cum, 0.f), 1.0f - 1e-6f); } }
    }
    GRID_BAR();

    const int l_lo = (PH == 0) ? 0 : args.l_lo, l_hi = (PH == 0) ? NL : args.l_hi;
    for (int l = l_lo; l < l_hi; ++l) {
#define IN(k) (PH == 0 || PH == (k))

        for (int rep_ = 0; rep_ < REPS(PH_PROJ); ++rep_) if (IN(PH_PROJ)) {
            if (rep_) GRID_BAR();
            PHASE_ENV();
            ProbProjT<true> p; p.A = xq; p.Bt = winq + (size_t)l * INC * D; p.sw = ((const int*)ctl)[CW_SIN + l]; p.C = proj; p.ldc = INC; p.S.init(T, INC, G, bid);
            pg8::gemm_phase(lds, p);
        }
        GRID_BAR();
        for (int rep_ = 0; rep_ < REPS(PH_HG); ++rep_) if (IN(PH_HG)) {
            if (rep_) GRID_BAR();
            PHASE_ENV();
            for (int item = bid; item < 256; item += G) hg_phase_a(lds, item, l, proj, lbt, oloc, qseg, sfin, dseg);
        }
        for (int rep_ = 0; rep_ < REPS(PH_LRUAU); ++rep_) if (IN(PH_LRUAU)) {
            if (rep_) GRID_BAR();
            PHASE_ENV();
            for (int it = bid; it < BATCH * 32; it += G)
                lru_pair<0>(lds, it >> 5, it & 31, proj, A->in[I_CONVW] + (size_t)l * 4 * LRW, A->in[I_CONVB] + (size_t)l * LRW, lruw + (size_t)l * 2 * 2 * LRH * LHD * LHD,
                               A->in[I_BA] + (size_t)l * 2 * LRW, A->in[I_BX] + (size_t)l * 2 * LRW, A->in[I_LAM] + (size_t)l * 2 * LRW, lsum, nullptr, nullptr);
        }
        GRID_BAR();
        for (int rep_ = 0; rep_ < REPS(PH_COMB); ++rep_) if (IN(PH_COMB)) {
            if (rep_) GRID_BAR();
            PHASE_ENV();
            const float* hgn = A->in[I_HGNORM] + (size_t)l * HGW;
            for (int cb = bid; cb < 256; cb += G) hg_phase_c(lds, cb, l, proj, oloc, qseg, sfin, dseg, hgn, mix);
            for (int it = bid; it < BATCH * 32; it += G)
                lru_pair<1>(lds, it >> 5, it & 31, proj, A->in[I_CONVW] + (size_t)l * 4 * LRW, A->in[I_CONVB] + (size_t)l * LRW, lruw + (size_t)l * 2 * 2 * LRH * LHD * LHD,
                               A->in[I_BA] + (size_t)l * 2 * LRW, A->in[I_BX] + (size_t)l * 2 * LRW, A->in[I_LAM] + (size_t)l * 2 * LRW, lsum, A->in[I_LRUNORM] + (size_t)l * LRW, mix);
        }
        GRID_BAR();
        for (int rep_ = 0; rep_ < REPS(PH_OUTG); ++rep_) if (IN(PH_OUTG)) {
            if (rep_) GRID_BAR();
            PHASE_ENV();
            ProbProjT<false> p; p.A = mix; p.Bt = wout_t + (size_t)l * D * D; p.sw = 0; p.C = ybf; p.ldc = D; p.S.init(T, D, G, bid);
            pg8::gemm_phase(lds, p);
        }
        GRID_BAR();
        if (IN(PH_LN1R)) {
            PHASE_ENV();
            LAS float* S1 = (LAS float*)lds;
            LAS float* S2 = S1 + 256;
            LAS float* PART = S2 + 256;
            constexpr int LN1_MAXT = 16;
            LAS int* hist = (LAS int*)(PART + 8 * 32 * 36); LAS int* basee = hist + 32; LAS int* sel = basee + 32; LAS float* gsel = (LAS float*)(sel + LN1_MAXT * 128);
            LAS float* G1L = gsel + LN1_MAXT * 128; LAS float* B1L = G1L + D;
            const float* rb = A->in[I_RB] + (size_t)l * NE;
            const int tk = lane & 15, kq = lane >> 4, colb = wave * 128 + kq * 8;
            bf16x8 wfh[2][4], wfl[2][4];
#pragma unroll
            for (int et = 0; et < 2; ++et)
#pragma unroll
                for (int ks = 0; ks < 4; ++ks) { const size_t off = (size_t)l * NE * D + (size_t)(et * 16 + tk) * D + colb + 32 * ks; wfh[et][ks] = *(const bf16x8*)(rwh + off); wfl[et][ks] = *(const bf16x8*)(rwl + off); }
            if (tid < 32) hist[tid] = 0;
            { const float* src_ = (tid < 256) ? (A->in[I_LN1G] + (size_t)l * D + 4 * tid) : (A->in[I_LN1B] + (size_t)l * D + 4 * (tid - 256)); *(LAS f32x4*)(G1L + 4 * tid) = *(const f32x4*)src_; }
            int tix = 0;
            for (int tile = bid; tile < T / 32; tile += G, ++tix) {
                float tv[2][4][8];
#pragma unroll
                for (int tt = 0; tt < 2; ++tt) { const size_t row = (size_t)tile * 32 + tt * 16 + tk;
#pragma unroll
                    for (int ks = 0; ks < 4; ++ks) { const u32x4 xw = *(const u32x4*)(xb + row * D + colb + 32 * ks), yw = *(const u32x4*)(ybf + row * D + colb + 32 * ks);
#pragma unroll
                        for (int q = 0; q < 4; ++q) { tv[tt][ks][2 * q] = bf2f(xw[q] & 0xffffu) * ALPHA + bf2f(yw[q] & 0xffffu); tv[tt][ks][2 * q + 1] = bf2f(xw[q] >> 16) * ALPHA + bf2f(yw[q] >> 16); } } }
                float mean[2], rstd[2];
#pragma unroll
                for (int tt = 0; tt < 2; ++tt) { float s_ = 0.f;
#pragma unroll
                    for (int ks = 0; ks < 4; ++ks)
#pragma unroll
                        for (int q = 0; q < 8; ++q) s_ += tv[tt][ks][q];
                    s_ += __shfl_xor(s_, 16); s_ += __shfl_xor(s_, 32); if (kq == 0) S1[wave * 32 + tt * 16 + tk] = s_; }
                __syncthreads();
#pragma unroll
                for (int tt = 0; tt < 2; ++tt) { float m_ = 0.f;
#pragma unroll
                    for (int ww = 0; ww < 8; ++ww) m_ += S1[ww * 32 + tt * 16 + tk];
                    mean[tt] = m_ * (1.f / D); float s_ = 0.f;
#pragma unroll
                    for (int ks = 0; ks < 4; ++ks)
#pragma unroll
                        for (int q = 0; q < 8; ++q) { tv[tt][ks][q] -= mean[tt]; s_ += tv[tt][ks][q] * tv[tt][ks][q]; }
                    s_ += __shfl_xor(s_, 16); s_ += __shfl_xor(s_, 32); if (kq == 0) S2[wave * 32 + tt * 16 + tk] = s_; }
                __syncthreads();
                f32x4 acc[2][2];
#pragma unroll
                for (int et = 0; et < 2; ++et)
#pragma unroll
                    for (int tt = 0; tt < 2; ++tt) acc[et][tt] = (f32x4){0.f, 0.f, 0.f, 0.f};
#pragma unroll
                for (int tt = 0; tt < 2; ++tt) { float v_ = 0.f;
#pragma unroll
                    for (int ww = 0; ww < 8; ++ww) v_ += S2[ww * 32 + tt * 16 + tk];
                    rstd[tt] = rsqf_(v_ * (1.f / D) + LN_EPS); const size_t row = (size_t)tile * 32 + tt * 16 + tk;
#pragma unroll
                    for (int ks = 0; ks < 4; ++ks) { const f32x4 ga = *(const LAS f32x4*)(G1L + colb + 32 * ks), gb = *(const LAS f32x4*)(G1L + colb + 32 * ks + 4), ba_ = *(const LAS f32x4*)(B1L + colb + 32 * ks), bb_ = *(const LAS f32x4*)(B1L + colb + 32 * ks + 4);
                        float o[8]; unsigned hw[4], lw[4];
#pragma unroll
                        for (int q = 0; q < 8; ++q) o[q] = tv[tt][ks][q] * rstd[tt] * (q < 4 ? ga[q] : gb[q - 4]) + (q < 4 ? ba_[q] : bb_[q - 4]);
#pragma unroll
                        for (int q = 0; q < 4; ++q) { hw[q] = pk2(o[2 * q], o[2 * q + 1]); lw[q] = pk2(o[2 * q] - bf2f(hw[q] & 0xffffu), o[2 * q + 1] - bf2f(hw[q] >> 16)); }
                        *(u32x4*)(x1b + row * D + colb + 32 * ks) = (u32x4){hw[0], hw[1], hw[2], hw[3]};
                        { int q0 = 0, q1 = 0; q0 = __builtin_amdgcn_cvt_pk_fp8_f32(o[0], o[1], q0, false); q0 = __builtin_amdgcn_cvt_pk_fp8_f32(o[2], o[3], q0, true); q1 = __builtin_amdgcn_cvt_pk_fp8_f32(o[4], o[5], q1, false); q1 = __builtin_amdgcn_cvt_pk_fp8_f32(o[6], o[7], q1, true);
                          *(u32x2*)(x1q + row * D + colb + 32 * ks) = (u32x2){(unsigned)q0, (unsigned)q1}; }
                        const bf16x8 xh = __builtin_bit_cast(bf16x8, (u32x4){hw[0], hw[1], hw[2], hw[3]}), xl = __builtin_bit_cast(bf16x8, (u32x4){lw[0], lw[1], lw[2], lw[3]});
#pragma unroll
                        for (int et = 0; et < 2; ++et) { acc[et][tt] = __builtin_amdgcn_mfma_f32_16x16x32_bf16(wfh[et][ks], xh, acc[et][tt], 0, 0, 0); acc[et][tt] = __builtin_amdgcn_mfma_f32_16x16x32_bf16(wfl[et][ks], xh, acc[et][tt], 0, 0, 0); acc[et][tt] = __builtin_amdgcn_mfma_f32_16x16x32_bf16(wfh[et][ks], xl, acc[et][tt], 0, 0, 0); } } }
#pragma unroll
                for (int et = 0; et < 2; ++et)
#pragma unroll
                    for (int tt = 0; tt < 2; ++tt) *(LAS f32x4*)(PART + (wave * 32 + tt * 16 + tk) * 36 + et * 16 + 4 * kq) = acc[et][tt];
                __syncthreads();
                {
                    const int tok = tid >> 4, sub = tid & 15; float l0 = rb[2 * sub], l1 = rb[2 * sub + 1];
#pragma unroll
                    for (int ww = 0; ww < 8; ++ww) { const f32x2 pv = *(const LAS f32x2*)(PART + (ww * 32 + tok) * 36 + 2 * sub); l0 += pv[0]; l1 += pv[1]; }
                    float tvv[4]; int tee[4];
#pragma unroll
                    for (int k = 0; k < 4; ++k) { const bool hi_ = l1 > l0; float bv = hi_ ? l1 : l0; int bi = hi_ ? 2 * sub + 1 : 2 * sub;
#define TOPK_STEP(ctrl) { const float ov = __builtin_bit_cast(float, __builtin_amdgcn_update_dpp(0, __builtin_bit_cast(int, bv), ctrl, 0xf, 0xf, false)); const int oi = __builtin_amdgcn_update_dpp(0, bi, ctrl, 0xf, 0xf, false); \
                            const bool take = (ov > bv) | ((ov == bv) & (oi < bi)); bv = take ? ov : bv; bi = take ? oi : bi; }
                        TOPK_STEP(0xB1) TOPK_STEP(0x4E) TOPK_STEP(0x141) TOPK_STEP(0x140)
#undef TOPK_STEP
                        tvv[k] = bv; tee[k] = bi; l0 = (bi == 2 * sub) ? -3.3e38f : l0; l1 = (bi == 2 * sub + 1) ? -3.3e38f : l1; }
                    if (sub < 4) { float wsum = 0.f, wk = 0.f; int ek = 0;
#pragma unroll
                        for (int k = 0; k < 4; ++k) { const float wv_ = exp_(tvv[k] - tvv[0]); wsum += wv_; if (k == sub) { wk = wv_; ek = tee[k]; } }
                        const int lr = atomicAdd((int*)(hist + ek), 1); sel[tix * 128 + tok * 4 + sub] = ek * 65536 + lr; gsel[tix * 128 + tok * 4 + sub] = wk / wsum; } }
            }
            __syncthreads();
            if (tid < 32) { const int hh = hist[tid]; basee[tid] = hh ? (int)atomicAdd(cntg + 32 * tid, (unsigned)hh) : 0; }
            __syncthreads();
            for (int i = tid; i < tix * 128; i += NTHR) { const int sv = sel[i], e = sv >> 16, rank = basee[e] + (sv & 65535); const int tok = (bid + (i >> 7) * G) * 32 + ((i & 127) >> 2); const int idx = e * ECAP + rank;
                rtok[idx] = tok; rgate[idx] = gsel[i]; tslot[tok * 4 + (i & 3)] = idx; }
            __syncthreads();
        }
        GRID_BAR();
        for (int rep_ = 0; rep_ < REPS(PH_MOE1); ++rep_) if (IN(PH_MOE1)) {
            if (rep_) GRID_BAR();
            PHASE_ENV();
            MOE_TABLES((const int*)ctl + CW_SGU + l * NE);
            ProbMoe1 p; p.X = x1q; p.Wgu = wguq + (size_t)l * NE * 2048 * D; p.bgu = A->in[I_BGU] + (size_t)l * NE * 2048; p.hid = hid; p.rtok = rtok; p.tb.cnt = tabcnt; p.tb.pblk = tabpblk; p.tb.scl = tabscl; p.tb.eb = tabeb; p.G = G; p.c = bid;
            pg8::gemm_phase(lds, p);
        }
        GRID_BAR();
        for (int rep_ = 0; rep_ < REPS(PH_MOE2); ++rep_) if (IN(PH_MOE2)) {
            if (rep_) GRID_BAR();
            PHASE_ENV();
            MOE_TABLES((const int*)ctl + CW_SDN + l * NE);
            ProbMoe2 p; p.hid = hid; p.Wdn = wdnq + (size_t)l * NE * D * DE; p.bdn = A->in[I_BDN] + (size_t)l * NE * D; p.ys = ysl; p.rgate = rgate; p.tb.cnt = tabcnt; p.tb.pblk = tabpblk; p.tb.scl = tabscl; p.tb.eb = tabeb; p.G = G; p.c = bid;
            pg8::gemm_phase(lds, p);
        }
        GRID_BAR();
        for (int rep_ = 0; rep_ < REPS(PH_LN2); ++rep_) if (IN(PH_LN2)) {
            if (rep_) GRID_BAR();
            PHASE_ENV();
            MOE_TABLES((const int*)nullptr);
            const float* g2 = A->in[I_LN2G] + (size_t)l * D; const float* b2 = A->in[I_LN2B] + (size_t)l * D;
            typedef int i32x4 __attribute__((ext_vector_type(4)));
            const int c0 = lane * 16; const int rstep = NGW;
#define LN2_CL(rp) ((rp) < T ? (rp) : T - 1)
#define LN2_TS(rp, TS) do { TS = *(const i32x4*)(tslot + (size_t)LN2_CL(rp) * 4); } while (0)
#define LN2_LOAD(rp, TS, YV, XV, GK) do { _Pragma("unroll") for (int k = 0; k < 4; ++k) { const int idx = TS[k]; GK[k] = rgate[idx]; const int e = idx >> 15, rank = idx & (ECAP - 1); \
                        YV[k] = *(const u32x4*)(ysl + (size_t)(tabpblk[e] * 256 + rank) * D + lane * 16); } \
                    XV[0] = *(const u32x4*)(x1b + (size_t)LN2_CL(rp) * D + lane * 16); XV[1] = *(const u32x4*)(x1b + (size_t)LN2_CL(rp) * D + lane * 16 + 8); } while (0)
#define LN2_COMPUTE(rp, YV, XV, GK_) do { const int row = (rp); float v[16]; float s_ = 0.f; const float GK[4] = {GK_[0] * (1.0f / YS_SCALE), GK_[1] * (1.0f / YS_SCALE), GK_[2] * (1.0f / YS_SCALE), GK_[3] * (1.0f / YS_SCALE)}; \
                    _Pragma("unroll") for (int q = 0; q < 4; ++q) { float m0 = 0.f, m1 = 0.f, m2 = 0.f, m3 = 0.f; \
                        _Pragma("unroll") for (int k = 0; k < 4; ++k) { const f32x2 lo2 = __builtin_amdgcn_cvt_pk_f32_fp8((int)YV[k][q], false), hi2 = __builtin_amdgcn_cvt_pk_f32_fp8((int)YV[k][q], true); \
                            m0 += GK[k] * lo2[0]; m1 += GK[k] * lo2[1]; m2 += GK[k] * hi2[0]; m3 += GK[k] * hi2[1]; } \
                        const unsigned xa = XV[q >> 1][(q & 1) * 2], xb_ = XV[q >> 1][(q & 1) * 2 + 1]; \
                        v[4 * q] = bf2f(xa & 0xffffu) * ALPHA + m0; v[4 * q + 1] = bf2f(xa >> 16) * ALPHA + m1; v[4 * q + 2] = bf2f(xb_ & 0xffffu) * ALPHA + m2; v[4 * q + 3] = bf2f(xb_ >> 16) * ALPHA + m3; \
                        s_ += (v[4 * q] + v[4 * q + 1]) + (v[4 * q + 2] + v[4 * q + 3]); } \
                    const float mean = wave_sum(s_) * (1.f / D); float s2 = 0.f; \
                    _Pragma("unroll") for (int q = 0; q < 16; ++q) { v[q] -= mean; s2 += v[q] * v[q]; } \
                    const float rstd = rsqf_(wave_sum(s2) * (1.f / D) + LN_EPS); float o[16]; \
                    _Pragma("unroll") for (int q4 = 0; q4 < 4; ++q4) { const f32x4 gg = g2r[q4], bb = b2r[q4]; _Pragma("unroll") for (int i = 0; i < 4; ++i) o[4 * q4 + i] = v[4 * q4 + i] * rstd * gg[i] + bb[i]; } \
                    if (l == NL - 1) { _Pragma("unroll") for (int q4 = 0; q4 < 4; ++q4) *(f32x4*)(A->out + (size_t)row * D + c0 + 4 * q4) = (f32x4){o[4 * q4], o[4 * q4 + 1], o[4 * q4 + 2], o[4 * q4 + 3]}; } \
                    else { *(u32x4*)(xb + (size_t)row * D + c0) = (u32x4){pk2(o[0], o[1]), pk2(o[2], o[3]), pk2(o[4], o[5]), pk2(o[6], o[7])}; *(u32x4*)(xb + (size_t)row * D + c0 + 8) = (u32x4){pk2(o[8], o[9]), pk2(o[10], o[11]), pk2(o[12], o[13]), pk2(o[14], o[15])}; \
                        int q4_[4]; _Pragma("unroll") for (int qq = 0; qq < 4; ++qq) { int t_ = 0; t_ = __builtin_amdgcn_cvt_pk_fp8_f32(o[4 * qq], o[4 * qq + 1], t_, false); t_ = __builtin_amdgcn_cvt_pk_fp8_f32(o[4 * qq + 2], o[4 * qq + 3], t_, true); q4_[qq] = t_; } \
                        *(u32x4*)(xq + (size_t)row * D + c0) = (u32x4){(unsigned)q4_[0], (unsigned)q4_[1], (unsigned)q4_[2], (unsigned)q4_[3]}; } } while (0)
            f32x4 g2r[4], b2r[4];
#pragma unroll
            for (int q4 = 0; q4 < 4; ++q4) { g2r[q4] = *(const f32x4*)(g2 + c0 + 4 * q4); b2r[q4] = *(const f32x4*)(b2 + c0 + 4 * q4); }
            int rowp = gw;
            i32x4 tsA0, tsA1, tsB0, tsB1;
            u32x4 yvA0[4], xvA0[2], yvA1[4], xvA1[2], yvB0[4], xvB0[2], yvB1[4], xvB1[2]; float gkA0[4], gkA1[4], gkB0[4], gkB1[4];
            LN2_TS(rowp, tsA0); LN2_TS(rowp + rstep, tsA1); LN2_TS(rowp + 2 * rstep, tsB0); LN2_TS(rowp + 3 * rstep, tsB1);
            LN2_LOAD(rowp, tsA0, yvA0, xvA0, gkA0);
            LN2_LOAD(rowp + rstep, tsA1, yvA1, xvA1, gkA1);
            for (; rowp < T; rowp += 4 * rstep) {
                LN2_LOAD(rowp + 2 * rstep, tsB0, yvB0, xvB0, gkB0);
                LN2_LOAD(rowp + 3 * rstep, tsB1, yvB1, xvB1, gkB1);
                LN2_TS(rowp + 4 * rstep, tsA0); LN2_TS(rowp + 5 * rstep, tsA1);
                LN2_COMPUTE(rowp, yvA0, xvA0, gkA0);
                if (rowp + rstep < T) LN2_COMPUTE(rowp + rstep, yvA1, xvA1, gkA1);
                LN2_LOAD(rowp + 4 * rstep, tsA0, yvA0, xvA0, gkA0);
                LN2_LOAD(rowp + 5 * rstep, tsA1, yvA1, xvA1, gkA1);
                LN2_TS(rowp + 6 * rstep, tsB0); LN2_TS(rowp + 7 * rstep, tsB1);
                if (rowp + 2 * rstep < T) LN2_COMPUTE(rowp + 2 * rstep, yvB0, xvB0, gkB0);
                if (rowp + 3 * rstep < T) LN2_COMPUTE(rowp + 3 * rstep, yvB1, xvB1, gkB1);
            }
#undef LN2_TS
#undef LN2_CL
#undef LN2_LOAD
#undef LN2_COMPUTE
        }
        if (l + 1 < l_hi) GRID_BAR();
#undef IN
    }
}

extern "C" void kernel_launch(void* const* d_in, const int* in_sizes, int n_in, void* d_out, int out_size, void* d_ws, size_t ws_size, hipStream_t stream) {
    static int grid = 0;
    if (grid == 0) {
        if (n_in != 23 || out_size != T * D || ws_size < WS_END) { fprintf(stderr, "kernel_launch: unexpected shapes (n_in %d, out %d, ws %zu)\n", n_in, out_size, ws_size); grid = -1; return; }
        int dev = 0, cus = 0;
        if (hipGetDevice(&dev) != hipSuccess || hipDeviceGetAttribute(&cus, hipDeviceAttributeMultiprocessorCount, dev) != hipSuccess) { grid = -1; return; }
        bool ok = true;
#define SETA(k) ok = ok && (hipFuncSetAttribute((const void*)mk_fwd<k>, hipFuncAttributeMaxDynamicSharedMemorySize, LDS_BYTES) == hipSuccess)
        SETA(0); SETA(-1); SETA(PH_PROJ); SETA(PH_HG); SETA(PH_LRUAU); SETA(PH_COMB); SETA(PH_OUTG); SETA(PH_LN1R); SETA(PH_MOE1); SETA(PH_MOE2); SETA(PH_LN2);
#undef SETA
        if (!ok) { fprintf(stderr, "kernel_launch: hipFuncSetAttribute failed\n"); grid = -1; return; }
        (void)hipGetLastError();
        grid = cus;
    }
    if (grid < 0) return;
    (void)hipMemsetAsync((char*)d_ws + WS_CTL, 0, CTL_BYTES, stream);
    Args a{};
    for (int i = 0; i < 23; ++i) a.in[i] = (const float*)d_in[i];
    a.out = (float*)d_out; a.ws = (unsigned char*)d_ws;
    a.l_lo = 0; a.l_hi = NL; a.ph_lo = 0; a.ph_hi = PH_END; a.pro = 1; a.pad = 0;
#ifdef MULTI_LAUNCH
    hipLaunchKernelGGL(mk_fwd<-1>, dim3(grid), dim3(NTHR), LDS_BYTES, stream, a);
    for (int l = 0; l < NL; ++l) {
        a.l_lo = l; a.l_hi = l + 1;
        hipLaunchKernelGGL(mk_fwd<PH_PROJ>, dim3(grid), dim3(NTHR), LDS_BYTES, stream, a);
        hipLaunchKernelGGL(mk_fwd<PH_HG>, dim3(grid), dim3(NTHR), LDS_BYTES, stream, a);
        hipLaunchKernelGGL(mk_fwd<PH_LRUAU>, dim3(grid), dim3(NTHR), LDS_BYTES, stream, a);
        hipLaunchKernelGGL(mk_fwd<PH_COMB>, dim3(grid), dim3(NTHR), LDS_BYTES, stream, a);
        hipLaunchKernelGGL(mk_fwd<PH_OUTG>, dim3(grid), dim3(NTHR), LDS_BYTES, stream, a);
        hipLaunchKernelGGL(mk_fwd<PH_LN1R>, dim3(grid), dim3(NTHR), LDS_BYTES, stream, a);
        hipLaunchKernelGGL(mk_fwd<PH_MOE1>, dim3(grid), dim3(NTHR), LDS_BYTES, stream, a);
        hipLaunchKernelGGL(mk_fwd<PH_MOE2>, dim3(grid), dim3(NTHR), LDS_BYTES, stream, a);
        hipLaunchKernelGGL(mk_fwd<PH_LN2>, dim3(grid), dim3(NTHR), LDS_BYTES, stream, a);
    }
#else
    hipLaunchKernelGGL(mk_fwd<0>, dim3(grid), dim3(NTHR), LDS_BYTES, stream, a);
#endif
}
```

```cpp
#include <hip/hip_runtime.h>
#include <cstdio>
#include <cstdint>

#define GAS __attribute__((address_space(1)))
#define LAS __attribute__((address_space(3)))
typedef unsigned short bf16_t;
typedef short bf16x8 __attribute__((ext_vector_type(8)));
typedef float f32x4 __attribute__((ext_vector_type(4)));
typedef float f32x2 __attribute__((ext_vector_type(2)));
typedef unsigned u32x4 __attribute__((ext_vector_type(4)));
typedef unsigned u32x2 __attribute__((ext_vector_type(2)));

constexpr int BATCH = 8, SEQ = 4096, D = 1024, T = BATCH * SEQ, NL = 4;
constexpr int HGW = 512, LRW = 512, HGH = 4, HD = 128, LRH = 8, LHD = 64;
constexpr int INC = 3584, NE = 32, TOPK = 4, DE = 1024;
constexpr int ECAP = 32768;
constexpr int NSLOT = T * TOPK + NE * 256;
constexpr float ALPHA = 1.6817928305074290f;
constexpr float LN_EPS = 1e-5f, RMS_EPS = 1e-6f;
constexpr int NWAVES = 8, NTHR = 512;
constexpr int LDS_BYTES = 147456;

constexpr size_t MiB = 1u << 20;
constexpr size_t WS_CTL = 0, CTL_BYTES = 1 * MiB;
constexpr size_t WS_LBT = 1 * MiB;
constexpr size_t WS_RWH = 2 * MiB, WS_RWL = 3 * MiB;
constexpr size_t WS_WIN = 4 * MiB;
constexpr size_t WS_WOUT = 32 * MiB;
constexpr size_t WS_WGU = 40 * MiB;
constexpr size_t WS_WDN = 552 * MiB;
constexpr size_t WS_XB = 808 * MiB;
constexpr size_t WS_XRES = 872 * MiB;
constexpr size_t WS_PROJ = 1000 * MiB;
constexpr size_t WS_MIX = 1224 * MiB;
constexpr size_t WS_Y = 1288 * MiB;
constexpr size_t WS_X1 = 1416 * MiB;
constexpr size_t WS_X1B = 1544 * MiB;
constexpr size_t WS_HID = 1608 * MiB;
constexpr size_t WS_YS = 1880 * MiB;
constexpr size_t WS_RTOK = 2152 * MiB;
constexpr size_t WS_RGATE = 2156 * MiB;
constexpr size_t WS_TSLOT = 2160 * MiB;
constexpr size_t WS_ODIR = 2162 * MiB;
constexpr size_t WS_HDIR = 2290 * MiB;
constexpr size_t WS_AU = 2418 * MiB;
constexpr size_t WS_SFIN = 2674 * MiB;
constexpr size_t WS_DSEG = 2690 * MiB;
constexpr size_t WS_LSUM = 2691 * MiB;
constexpr size_t WS_LRUW = 2696 * MiB;
constexpr size_t WS_END = 2700 * MiB;
constexpr size_t WS_OLOC = WS_ODIR, WS_QSEG = WS_ODIR + 64 * MiB;
constexpr size_t WS_XQ = WS_XRES, WS_WINQ = WS_XRES + 64 * MiB;
constexpr size_t WS_X1Q = WS_X1;
constexpr int CW_CNT = 16384, CW_SGU = 2048, CW_SDN = 2304, CW_SIN = 2560, CW_BAR = 8192;

#define LDS_WAIT() asm volatile("s_waitcnt lgkmcnt(0)" ::: "memory")
typedef __bf16 bf16x2_t __attribute__((ext_vector_type(2)));
__device__ __forceinline__ unsigned pk2(float lo, float hi) { bf16x2_t v; v[0] = (__bf16)lo; v[1] = (__bf16)hi; return __builtin_bit_cast(unsigned, v); }
__device__ __forceinline__ unsigned f2bf(float f) { return pk2(f, 0.f) & 0xffffu; }
__device__ __forceinline__ float bf2f(unsigned b) { return __builtin_bit_cast(float, b << 16); }
__device__ __forceinline__ float wave_sum(float v) {
#pragma unroll
    for (int o = 1; o < 64; o <<= 1) v += __shfl_xor(v, o);
    return v;
}
__device__ __forceinline__ float rcpf_(float x) { return __builtin_amdgcn_rcpf(x); }
__device__ __forceinline__ float rsqf_(float x) { return __builtin_amdgcn_rsqf(x); }
__device__ __forceinline__ float exp_(float x) { return __builtin_amdgcn_exp2f(x * 1.4426950408889634f); }
__device__ __forceinline__ float log_(float x) { return __builtin_amdgcn_logf(x) * 0.6931471805599453f; }
__device__ __forceinline__ float sigmoidf_(float z) { return rcpf_(1.0f + __builtin_amdgcn_exp2f(z * -1.4426950408889634f)); }
__device__ __forceinline__ float gelu_tanh_(float z) { return z * sigmoidf_(1.5957691216057308f * (z + 0.044715f * z * z * z)); }

namespace pg8 {
constexpr int BM = 256, BK = 64, HALF = 128, HTB = HALF * BK * 2, STAGE_BYTES = 8 * HTB, NXCD = 8, WGM = 8;
constexpr int KD = 1024;
__host__ __device__ __forceinline__ int lds_byte(int r, int c) { const int st = (r >> 4) * 2 + (c >> 5), rr = r & 15, cc = c & 31, ob = rr * 64 + cc * 2; return st * 1024 + (ob ^ (((ob >> 9) & 1) << 5)); }
__host__ __device__ __forceinline__ void stage_rc(int b, int& R, int& C) { const int st = b / 1024, sb = b % 1024, swz = sb ^ (((sb >> 9) & 1) << 5); R = (st >> 1) * 16 + swz / 64; C = (st & 1) * 32 + (swz % 64) / 2; }
__host__ __device__ __forceinline__ int perm32(int rho) { const int n = rho >> 4, i = rho & 15; return 8 * (i >> 2) + 4 * n + (i & 3); }
struct Unit { int pm, pn, e, j; };
typedef int i32x8 __attribute__((ext_vector_type(8)));
__device__ __forceinline__ i32x8 cat8(bf16x8 a, bf16x8 b) { const u32x4 x = __builtin_bit_cast(u32x4, a), y = __builtin_bit_cast(u32x4, b); return (i32x8){(int)x[0], (int)x[1], (int)x[2], (int)x[3], (int)y[0], (int)y[1], (int)y[2], (int)y[3]}; }
__device__ __forceinline__ unsigned cvt_pk_bf16(float lo, float hi) { return pk2(lo, hi); }

struct StaticOrder {
    int nM, nN, nwg, G, c;
    __device__ void init(int M, int N, int G_, int c_) { nM = M / BM; nN = N / BM; nwg = nM * nN; G = G_; c = c_; }
    __device__ bool next(int i, Unit& u) const {
        const long L = (long)i * G + c; if (L >= nwg) return false;
        int wgid = (int)L; { const int q = nwg / NXCD, r = nwg % NXCD, xcd = wgid % NXCD, off = wgid / NXCD; wgid = (xcd < r ? xcd * (q + 1) : r * (q + 1) + (xcd - r) * q) + off; }
        const int nig = WGM * nN, gid = wgid / nig, fm = gid * WGM, gsz = (nM - fm) < WGM ? (nM - fm) : WGM;
        u.pm = fm + ((wgid % nig) % gsz); u.pn = (wgid % nig) / gsz; u.e = 0; u.j = 0; return true;
    }
};

template <class P>
__device__ __forceinline__ void gemm_phase(LAS unsigned char* lds, const P& p) {
    int tid_l = (int)threadIdx.x; asm volatile("" : "+v"(tid_l));
    const int tid = tid_l, wid = __builtin_amdgcn_readfirstlane(tid >> 6), lane = tid & 63, wr = wid >> 2, wc = wid & 3, fr = lane & 15, fq = lane >> 4;
    constexpr int RB = P::FP8 ? KD : 2 * KD;
    constexpr int nt = RB / 128;
    unsigned voffB[2];
#pragma unroll
    for (int i = 0; i < 2; ++i) { int R, C; stage_rc(tid * 16 + i * 8192, R, C); const int r32_ = R & 31;
        const int Rb = P::WIDE ? (64 * (R >> 5) + 16 * ((r32_ & 15) >> 2) + 4 * (r32_ >> 4) + (r32_ & 3))
                             : (P::PERM ? ((R & ~31) + perm32(r32_)) : R);
        voffB[i] = (unsigned)(Rb * RB + C * 2); }
    constexpr unsigned hstepB = (unsigned)(P::WIDE ? 8 : HALF) * RB;
    const unsigned ldsw = (unsigned)wid * 1024u;
    const int aoff = lds_byte(wr * 64 + fr, fq * 8), boff = lds_byte(wc * 32 + fr, fq * 8);
    const char* const abase = p.a_base();
#define PG8_SA(b, h) (((b) * 2 + (h)) * HTB)
#define PG8_SB(b, h) ((4 + (b) * 2 + (h)) * HTB)
#define PG8_STAGE_A(bufoff, o, koff) do { _Pragma("unroll") for (int _i = 0; _i < 2; ++_i) \
        __builtin_amdgcn_global_load_lds((const unsigned*)(abase + (size_t)(o)[_i] + (koff)), (LAS unsigned*)(lds + (bufoff) + ldsw + _i * 8192), 16, 0, 0); } while (0)
#define PG8_STAGE_B(bufoff, gbase, koff) do { _Pragma("unroll") for (int _i = 0; _i < 2; ++_i) \
        __builtin_amdgcn_global_load_lds((const unsigned*)((gbase) + (size_t)(voffB[_i] + (koff))), (LAS unsigned*)(lds + (bufoff) + ldsw + _i * 8192), 16, 0, 0); } while (0)
#define PG8_LDA(dst, b, h) do { _Pragma("unroll") for (int m = 0; m < 4; ++m) _Pragma("unroll") for (int k = 0; k < 2; ++k) dst[m][k] = *(const LAS bf16x8*)(lds + PG8_SA(b, h) + aoff + m * 2048 + k * 1024); } while (0)
#define PG8_LDB(dst, b, h) do { _Pragma("unroll") for (int n = 0; n < 2; ++n) _Pragma("unroll") for (int k = 0; k < 2; ++k) dst[n][k] = *(const LAS bf16x8*)(lds + PG8_SB(b, h) + boff + n * 2048 + k * 1024); } while (0)
#define PG8_MMA(ai, bj, At, Bt) do { __builtin_amdgcn_s_setprio(1); _Pragma("unroll") for (int m = 0; m < 4; ++m) _Pragma("unroll") for (int n = 0; n < 2; ++n) { \
        if constexpr (P::FP8) { const i32x8 b8_ = cat8(Bt[n][0], Bt[n][1]), a8_ = cat8(At[m][0], At[m][1]); \
            asm volatile("v_mfma_scale_f32_16x16x128_f8f6f4 %0, %1, %2, %0, %3, %4 op_sel_hi:[0,0,0]" : "+v"(acc[ai][bj][m][n]) : "v"(b8_), "v"(a8_), "v"(sclW), "v"(sclX)); } \
        else { _Pragma("unroll") for (int k = 0; k < 2; ++k) acc[ai][bj][m][n] = __builtin_amdgcn_mfma_f32_16x16x32_bf16(Bt[n][k], At[m][k], acc[ai][bj][m][n], 0, 0, 0); } } __builtin_amdgcn_s_setprio(0); } while (0)
#define PG8_WAIT_V(n) asm volatile("s_waitcnt vmcnt(" #n ")" ::: "memory")
#define PG8_WAIT_L(n) asm volatile("s_waitcnt lgkmcnt(" #n ")" ::: "memory")
#define PG8_BAR __builtin_amdgcn_s_barrier()
#define PG8_SCHED __builtin_amdgcn_sched_barrier(0)
    Unit cur, nxt; int ui = 0; nxt.pm = nxt.pn = nxt.e = nxt.j = 0;
    if (!p.next(0, cur)) return;
    f32x4 acc[2][2][4][2];
#pragma unroll
    for (int a = 0; a < 2; ++a)
#pragma unroll
        for (int b = 0; b < 2; ++b)
#pragma unroll
            for (int m = 0; m < 4; ++m)
#pragma unroll
                for (int n = 0; n < 2; ++n) acc[a][b][m][n] = (f32x4){0.f, 0.f, 0.f, 0.f};
    bf16x8 At[4][2], B0[2][2], B1[2][2];
    unsigned oC[2][2];
    int kN[2][2];
#define PG8_RC(i, R_, C_) int R_, C_; { int t2_ = tid; asm volatile("" : "+v"(t2_)); stage_rc(t2_ * 16 + (i) * 8192, R_, C_); }
    { PG8_RC(0, R0, C0); PG8_RC(1, R1, C1); const int RR[2] = {R0, R1}; p.a_key(cur, RR, kN);
#pragma unroll
      for (int h = 0; h < 2; ++h) { oC[h][0] = (unsigned)(kN[h][0] * RB + C0 * 2); oC[h][1] = (unsigned)(kN[h][1] * RB + C1 * 2); } }
    const char* cB = p.b_base(cur);
    constexpr int BIAS_OFF = STAGE_BYTES + 2048;
    if (P::HAS_BIAS && wid == 0) p.dma_bias(cur, (LAS unsigned*)(lds + BIAS_OFF), lane);
    int sclW = p.scale_w(cur); const int sclX = p.scale_x();
    PG8_STAGE_B(PG8_SB(0, 0), cB, 0u); PG8_STAGE_B(PG8_SB(0, 1), cB + hstepB, 0u); PG8_STAGE_A(PG8_SA(0, 0), oC[0], 0u); PG8_STAGE_A(PG8_SA(0, 1), oC[1], 0u);
    if (wr == 1) PG8_BAR;
    PG8_WAIT_V(2); PG8_BAR;
    PG8_STAGE_B(PG8_SB(1, 0), cB, 128u); PG8_STAGE_A(PG8_SA(1, 0), oC[0], 128u); PG8_STAGE_B(PG8_SB(1, 1), cB + hstepB, 128u);
    PG8_WAIT_V(6); PG8_BAR;
    for (;;) {
        const bool has_next = p.next(ui + 1, nxt);
        const char* nB = cB;
        if (has_next) { PG8_RC(0, R0, C0); PG8_RC(1, R1, C1); (void)C0; (void)C1; const int RR[2] = {R0, R1}; p.a_key(nxt, RR, kN); nB = p.b_base(nxt);
            if (P::HAS_BIAS && wid == 0) p.dma_bias(nxt, (LAS unsigned*)(lds + BIAS_OFF + ((ui + 1) & 1) * 1024), lane); }
#pragma unroll 1
        for (int t = 0; t < nt; t += 2) {
            const bool last = (t == nt - 2);
            const unsigned k1 = (unsigned)(t + 1) * 128u, k2 = last ? 0u : (unsigned)(t + 2) * 128u, k3 = k2 + 128u;
            unsigned o2[2][2];
            if (last) { asm volatile("" : "+v"(kN[0][0]), "+v"(kN[0][1]), "+v"(kN[1][0]), "+v"(kN[1][1])); PG8_RC(0, R0, C0); PG8_RC(1, R1, C1); (void)R0; (void)R1;
#pragma unroll
                for (int h = 0; h < 2; ++h) { o2[h][0] = (unsigned)(kN[h][0] * RB + C0 * 2); o2[h][1] = (unsigned)(kN[h][1] * RB + C1 * 2); } }
            else {
#pragma unroll
                for (int h = 0; h < 2; ++h)
#pragma unroll
                    for (int i = 0; i < 2; ++i) o2[h][i] = oC[h][i]; }
            const char* b2 = last ? nB : cB;
            PG8_LDB(B0, 0, 0); PG8_LDB(B1, 0, 1); PG8_SCHED; PG8_LDA(At, 0, 0); PG8_STAGE_A(PG8_SA(1, 1), oC[1], k1);
            PG8_WAIT_V(8); PG8_WAIT_L(0); PG8_BAR; PG8_MMA(0, 0, At, B0); PG8_MMA(0, 1, At, B1); PG8_BAR; PG8_SCHED;
            PG8_LDA(At, 0, 1); PG8_STAGE_B(PG8_SB(0, 0), b2, k2); PG8_STAGE_B(PG8_SB(0, 1), b2 + hstepB, k2); PG8_STAGE_A(PG8_SA(0, 0), o2[0], k2);
            PG8_WAIT_V(8); PG8_WAIT_L(0); PG8_BAR; PG8_MMA(1, 0, At, B0); PG8_MMA(1, 1, At, B1); PG8_BAR; PG8_SCHED;
            PG8_LDB(B0, 1, 0); PG8_LDB(B1, 1, 1); PG8_SCHED; PG8_LDA(At, 1, 0); PG8_STAGE_A(PG8_SA(0, 1), o2[1], k2);
            PG8_WAIT_V(8); PG8_WAIT_L(0); PG8_BAR; PG8_MMA(0, 0, At, B0); PG8_MMA(0, 1, At, B1); PG8_BAR; PG8_SCHED;
            PG8_LDA(At, 1, 1); PG8_STAGE_B(PG8_SB(1, 0), b2, k3); PG8_STAGE_B(PG8_SB(1, 1), b2 + hstepB, k3); PG8_STAGE_A(PG8_SA(1, 0), o2[0], k3);
            PG8_WAIT_V(8); PG8_WAIT_L(0); PG8_BAR; PG8_MMA(1, 0, At, B0); PG8_MMA(1, 1, At, B1); PG8_BAR; PG8_SCHED;
        }
        if (wr == 0) PG8_BAR;
        if constexpr (P::FP8) asm volatile("s_nop 15\n\ts_nop 7" ::: "memory");
        p.epi(acc, cur, (const LAS float*)(lds + BIAS_OFF + (ui & 1) * 1024), wr, wc, fr, fq);
        if (!has_next) break;
#pragma unroll
        for (int a = 0; a < 2; ++a)
#pragma unroll
            for (int b = 0; b < 2; ++b)
#pragma unroll
                for (int m = 0; m < 4; ++m)
#pragma unroll
                    for (int n = 0; n < 2; ++n) acc[a][b][m][n] = (f32x4){0.f, 0.f, 0.f, 0.f};
        cur = nxt; cB = nB; ++ui; sclW = p.scale_w(cur);
        { PG8_RC(0, R0, C0); PG8_RC(1, R1, C1); (void)R0; (void)R1;
#pragma unroll
          for (int h = 0; h < 2; ++h) { oC[h][0] = (unsigned)(kN[h][0] * RB + C0 * 2); oC[h][1] = (unsigned)(kN[h][1] * RB + C1 * 2); } }
        if (wr == 1) PG8_BAR;
    }
    PG8_WAIT_V(0);
    PG8_BAR;
#undef PG8_RC
#undef PG8_SA
#undef PG8_SB
#undef PG8_STAGE_A
#undef PG8_STAGE_B
#undef PG8_LDA
#undef PG8_LDB
#undef PG8_MMA
#undef PG8_WAIT_V
#undef PG8_WAIT_L
#undef PG8_BAR
#undef PG8_SCHED
}
}

template <bool Q> struct ProbProjT {
    static constexpr bool WIDE = false;
    static constexpr bool HAS_BIAS = false; __device__ __forceinline__ void dma_bias(const pg8::Unit&, LAS unsigned*, int) const {}
    static constexpr bool PERM = true, FP8 = Q;
    __device__ __forceinline__ int scale_w(const pg8::Unit&) const { return (127 - sw) * 0x01010101; }
    __device__ __forceinline__ int scale_x() const { return 0x7f7f7f7f; }
    const void* A; const void* Bt; bf16_t* C; int ldc; int sw; pg8::StaticOrder S;
    __device__ __forceinline__ bool next(int i, pg8::Unit& u) const { return S.next(i, u); }
    __device__ __forceinline__ const char* a_base() const { return (const char*)A; }
    __device__ __forceinline__ void a_key(const pg8::Unit& u, const int (&R)[2], int (&k)[2][2]) const {
#pragma unroll
        for (int h = 0; h < 2; ++h)
#pragma unroll
            for (int i = 0; i < 2; ++i) k[h][i] = u.pm * 256 + h * 128 + R[i];
    }
    __device__ __forceinline__ const char* b_base(const pg8::Unit& u) const { return (const char*)Bt + (size_t)u.pn * 256 * pg8::KD * (Q ? 1 : 2); }
    __device__ __forceinline__ void epi(const f32x4 (&acc)[2][2][4][2], const pg8::Unit& u, const LAS float*, int wr, int wc, int fr, int fq) const {
        const int row0 = u.pm * 256 + wr * 64 + fr, col0 = u.pn * 256 + wc * 32 + 8 * fq;
#pragma unroll
        for (int ai = 0; ai < 2; ++ai)
#pragma unroll
            for (int m = 0; m < 4; ++m) { bf16_t* rowp = C + (size_t)(row0 + ai * 128 + m * 16) * ldc + col0;
#pragma unroll
                for (int bj = 0; bj < 2; ++bj) { const f32x4 v0 = acc[ai][bj][m][0], v1 = acc[ai][bj][m][1];
                    u32x4 w; w.x = pg8::cvt_pk_bf16(v0[0], v0[1]); w.y = pg8::cvt_pk_bf16(v0[2], v0[3]); w.z = pg8::cvt_pk_bf16(v1[0], v1[1]); w.w = pg8::cvt_pk_bf16(v1[2], v1[3]);
                    *(u32x4*)(rowp + bj * 128) = w; } }
    }
};
struct ProbOut {
    static constexpr bool WIDE = false;
    static constexpr bool HAS_BIAS = false; __device__ __forceinline__ void dma_bias(const pg8::Unit&, LAS unsigned*, int) const {}
    static constexpr bool PERM = false, FP8 = false;
    __device__ __forceinline__ int scale_w(const pg8::Unit&) const { return 0; }
    __device__ __forceinline__ int scale_x() const { return 0; }
    const bf16_t* A; const bf16_t* Bt; float* C; pg8::StaticOrder S;
    __device__ __forceinline__ bool next(int i, pg8::Unit& u) const { return S.next(i, u); }
    __device__ __forceinline__ const char* a_base() const { return (const char*)A; }
    __device__ __forceinline__ void a_key(const pg8::Unit& u, const int (&R)[2], int (&k)[2][2]) const {
#pragma unroll
        for (int h = 0; h < 2; ++h)
#pragma unroll
            for (int i = 0; i < 2; ++i) k[h][i] = u.pm * 256 + h * 128 + R[i];
    }
    __device__ __forceinline__ const char* b_base(const pg8::Unit& u) const { return (const char*)Bt + (size_t)u.pn * 256 * pg8::KD * 2; }
    __device__ __forceinline__ void epi(const f32x4 (&acc)[2][2][4][2], const pg8::Unit& u, const LAS float*, int wr, int wc, int fr, int fq) const {
        const int row0 = u.pm * 256 + wr * 64 + fr, col0 = u.pn * 256 + wc * 32 + 4 * fq;
#pragma unroll
        for (int ai = 0; ai < 2; ++ai)
#pragma unroll
            for (int m = 0; m < 4; ++m) { float* rowp = C + (size_t)(row0 + ai * 128 + m * 16) * D + col0;
#pragma unroll
                for (int bj = 0; bj < 2; ++bj)
#pragma unroll
                    for (int n = 0; n < 2; ++n) *(f32x4*)(rowp + bj * 128 + n * 16) = acc[ai][bj][m][n]; }
    }
};
struct MoeTab { const LAS int* cnt; const LAS int* pblk; const LAS int* scl; const LAS unsigned short* eb; };
__device__ __forceinline__ bool moe_next(const MoeTab& tb, int npn, int G, int c, int i, pg8::Unit& u) {
    const int nb = tb.pblk[32]; int blk, pn;
    if (G == 256) {
        const int x = c & 7, q = c >> 3, npnh = npn >> 2, tau = 8 * i + x, sr = tau / npnh, pnh = tau - sr * npnh;
        blk = sr * 8 + (q & 7); pn = pnh * 4 + (q >> 3); if (blk >= nb) return false;
    } else { const long L = (long)i * G + c; if (L >= (long)nb * npn) return false; blk = (int)(L / npn); pn = (int)(L % npn); }
    const int e = tb.eb[blk];
    u.e = __builtin_amdgcn_readfirstlane(e); u.pm = __builtin_amdgcn_readfirstlane(blk); u.pn = __builtin_amdgcn_readfirstlane(pn); u.j = u.pm - tb.pblk[u.e]; u.j = __builtin_amdgcn_readfirstlane(u.j);
    return true;
}
constexpr float YS_SCALE = 8.0f;
constexpr float HID_SCALE = 4.0f; constexpr int HID_SCALE_LOG2 = 2;
struct ProbMoe1 {
    static constexpr bool WIDE = false;
    static constexpr bool HAS_BIAS = true;
    __device__ __forceinline__ void dma_bias(const pg8::Unit& u, LAS unsigned* slot, int lane) const {
        const float* src = bgu + (size_t)u.e * 2048 + u.pn * 128 + (lane < 32 ? 4 * lane : 1024 + 4 * (lane - 32)); __builtin_amdgcn_global_load_lds((const unsigned*)src, slot, 16, 0, 0); }
    static constexpr bool PERM = true, FP8 = true;
    const unsigned char* X; const unsigned char* Wgu; const float* bgu; unsigned char* hid; const int* rtok; MoeTab tb; int G, c;
    __device__ __forceinline__ int scale_w(const pg8::Unit& u) const { return (127 - tb.scl[u.e]) * 0x01010101; }
    __device__ __forceinline__ int scale_x() const { return 0x7f7f7f7f; }
    __device__ __forceinline__ bool next(int i, pg8::Unit& u) const { return moe_next(tb, 8, G, c, i, u); }
    __device__ __forceinline__ const char* a_base() const { return (const char*)X; }
    __device__ __forceinline__ void a_key(const pg8::Unit& u, const int (&R)[2], int (&k)[2][2]) const {
        const int n1 = tb.cnt[u.e] - 1;
#pragma unroll
        for (int h = 0; h < 2; ++h)
#pragma unroll
            for (int i = 0; i < 2; ++i) { const int rank = u.j * 256 + h * 128 + R[i]; k[h][i] = rtok[u.e * ECAP + (rank < n1 ? rank : n1)]; }
    }
    __device__ __forceinline__ const char* b_base(const pg8::Unit& u) const { return (const char*)Wgu + ((size_t)u.e * 2048 + (size_t)u.pn * 256) * pg8::KD; }
    __device__ __forceinline__ void epi(const f32x4 (&acc)[2][2][4][2], const pg8::Unit& u, const LAS float* bs, int wr, int wc, int fr, int fq) const {
        const int row0 = u.pm * 256 + wr * 64 + fr, col0 = u.pn * 128 + wc * 32 + 8 * fq; const int cl = wc * 32 + 8 * fq;
        const f32x4 bg0 = *(const LAS f32x4*)(bs + cl), bg1 = *(const LAS f32x4*)(bs + cl + 4), bu0 = *(const LAS f32x4*)(bs + 128 + cl), bu1 = *(const LAS f32x4*)(bs + 128 + cl + 4);
#pragma unroll
        for (int ai = 0; ai < 2; ++ai)
#pragma unroll
            for (int m = 0; m < 4; ++m) {
                float hv[8];
#pragma unroll
                for (int n = 0; n < 2; ++n) { const f32x4 g4 = acc[ai][0][m][n] + (n ? bg1 : bg0), u4 = acc[ai][1][m][n] + (n ? bu1 : bu0);
#pragma unroll
                    for (int q = 0; q < 4; q += 2) {
                        f32x2 g = {fminf(g4[q], 7.0f), fminf(g4[q + 1], 7.0f)}, up = {__builtin_amdgcn_fmed3f(u4[q], -7.0f, 7.0f), __builtin_amdgcn_fmed3f(u4[q + 1], -7.0f, 7.0f)};
                        const f32x2 ar = g * (f32x2){-1.702f * 1.4426950408889634f, -1.702f * 1.4426950408889634f};
                        f32x2 den = {__builtin_amdgcn_exp2f(ar[0]), __builtin_amdgcn_exp2f(ar[1])}; den = den + (f32x2){1.0f, 1.0f};
                        const f32x2 sg = {__builtin_amdgcn_rcpf(den[0]), __builtin_amdgcn_rcpf(den[1])};
                        const f32x2 r = (up * (f32x2){HID_SCALE, HID_SCALE} + (f32x2){HID_SCALE, HID_SCALE}) * (g * sg);
                        hv[n * 4 + q] = r[0]; hv[n * 4 + q + 1] = r[1]; } }
                int w0 = 0, w1 = 0;
                w0 = __builtin_amdgcn_cvt_pk_fp8_f32(hv[0], hv[1], w0, false); w0 = __builtin_amdgcn_cvt_pk_fp8_f32(hv[2], hv[3], w0, true);
                w1 = __builtin_amdgcn_cvt_pk_fp8_f32(hv[4], hv[5], w1, false); w1 = __builtin_amdgcn_cvt_pk_fp8_f32(hv[6], hv[7], w1, true);
                *(u32x2*)(hid + (size_t)(row0 + ai * 128 + m * 16) * DE + col0) = (u32x2){(unsigned)w0, (unsigned)w1}; }
    }
};
struct ProbMoe2 {
    static constexpr bool WIDE = true;
    static constexpr bool HAS_BIAS = true;
    __device__ __forceinline__ void dma_bias(const pg8::Unit& u, LAS unsigned* slot, int lane) const { __builtin_amdgcn_global_load_lds((const unsigned*)(bdn + (size_t)u.e * 1024 + u.pn * 256 + 4 * lane), slot, 16, 0, 0); }
    static constexpr bool PERM = true, FP8 = true;
    const unsigned char* hid; const unsigned char* Wdn; const float* bdn; unsigned char* ys; const float* rgate; MoeTab tb; int G, c;
    __device__ __forceinline__ int scale_w(const pg8::Unit& u) const { return (127 - tb.scl[u.e]) * 0x01010101; }
    __device__ __forceinline__ int scale_x() const { return (127 - HID_SCALE_LOG2) * 0x01010101; }
    __device__ __forceinline__ bool next(int i, pg8::Unit& u) const { return moe_next(tb, 4, G, c, i, u); }
    __device__ __forceinline__ const char* a_base() const { return (const char*)hid; }
    __device__ __forceinline__ void a_key(const pg8::Unit& u, const int (&R)[2], int (&k)[2][2]) const {
#pragma unroll
        for (int h = 0; h < 2; ++h)
#pragma unroll
            for (int i = 0; i < 2; ++i) k[h][i] = u.pm * 256 + h * 128 + R[i];
    }
    __device__ __forceinline__ const char* b_base(const pg8::Unit& u) const { return (const char*)Wdn + ((size_t)u.e * 1024 + (size_t)u.pn * 256) * pg8::KD; }
    __device__ __forceinline__ void epi(const f32x4 (&acc)[2][2][4][2], const pg8::Unit& u, const LAS float* bs, int wr, int wc, int fr, int fq) const {
        const int row0 = u.pm * 256 + wr * 64 + fr, col0 = u.pn * 256 + wc * 64 + 16 * fq; const int cl = wc * 64 + 16 * fq;
        f32x4 bv[2][2];
#pragma unroll
        for (int bj = 0; bj < 2; ++bj)
#pragma unroll
            for (int n = 0; n < 2; ++n) bv[bj][n] = *(const LAS f32x4*)(bs + cl + 8 * bj + 4 * n) * YS_SCALE;
#pragma unroll
        for (int ai = 0; ai < 2; ++ai)
#pragma unroll
            for (int m = 0; m < 4; ++m) { int w4[4];
#pragma unroll
                for (int bj = 0; bj < 2; ++bj)
#pragma unroll
                    for (int n = 0; n < 2; ++n) { const f32x4 v = acc[ai][bj][m][n] * YS_SCALE + bv[bj][n]; int t_ = 0; t_ = __builtin_amdgcn_cvt_pk_fp8_f32(v[0], v[1], t_, false); t_ = __builtin_amdgcn_cvt_pk_fp8_f32(v[2], v[3], t_, true); w4[bj * 2 + n] = t_; }
                *(u32x4*)(ys + (size_t)(row0 + ai * 128 + m * 16) * D + col0) = (u32x4){(unsigned)w4[0], (unsigned)w4[1], (unsigned)w4[2], (unsigned)w4[3]}; }
    }
};

constexpr int HA_QH = 0, HA_KH = 8704, HA_QT = 17408, HA_KT = 26112, HA_VT = 36352, HA_DEC = 46592, HA_OPB = 47104;
constexpr int HA_ST = 2 * HA_OPB, HA_P = HA_ST + 34816, HA_TOT = HA_P + 2560;
__device__ __forceinline__ void hg_phase_a(LAS unsigned char* lds, int item, int l, const bf16_t* proj, const float* lbt, bf16_t* oloc, bf16_t* qseg, float* sfin, float* dseg) {
    int tid_l = (int)threadIdx.x; asm volatile("" : "+v"(tid_l));
    const int tid = tid_l, lane = tid & 63, w = __builtin_amdgcn_readfirstlane(tid >> 6), fr = lane & 15, fq = lane >> 4;
    const int seg = item & 3, dir = (item >> 2) & 1, h = (item >> 3) & 3, b = item >> 5;
    const int d0 = 2 * lane;
    const f32x2 lb2 = *(const f32x2*)(lbt + (size_t)l * 2 * HGW + dir * HGW + h * 128 + d0); const f32x2 omlb2 = (f32x2){1.0f, 1.0f} - lb2;
    LAS float* tot = (LAS float*)(lds + HA_TOT);
    __syncthreads();
    { unsigned z_ = 0u; asm volatile("" : "+v"(z_));
      for (int i = tid; i < 34816 / 16; i += NTHR) *(LAS u32x4*)(lds + HA_ST + i * 16) = (u32x4){z_, z_, z_, z_}; }
    f32x4 accS[8];
#pragma unroll
    for (int i = 0; i < 8; ++i) accS[i] = (f32x4){0.f, 0.f, 0.f, 0.f};
    float Gc[2] = {0.f, 0.f};
    unsigned rq[4], ri[4], rf[4];
    float cs[2][4], kk[2][4], qq[2][4]; unsigned vv[4];
    const unsigned colq2_ = (unsigned)(h * 128 + d0) * 2u;
    const unsigned oloff_ = ((unsigned)(dir ? 15 - fr : fr) * (unsigned)HGW + (unsigned)(h * 128 + w * 16 + 4 * fq)) * 2u;
#define HG_ROW(c, p) ((unsigned)(b * SEQ + (dir ? (SEQ - 1 - (seg * 1024 + (c) * 32 + (p))) : (seg * 1024 + (c) * 32 + (p)))))
#define HG_LOAD(c) do { unsigned colq2 = colq2_; asm volatile("" : "+v"(colq2)); _Pragma("unroll") for (int i = 0; i < 4; ++i) { const char* rp_ = (const char*)proj + (size_t)HG_ROW(c, 4 * w + i) * (INC * 2); const char* rpf_ = rp_ + (size_t)dir * 1024; \
            rq[i] = *(const unsigned*)(rp_ + colq2); ri[i] = *(const unsigned*)(rp_ + (colq2 + 1024u)); rf[i] = *(const unsigned*)(rpf_ + (colq2 + 2048u)); } } while (0)
#define HG_E1() do { f32x2 run2; _Pragma("unroll") for (int e = 0; e < 2; ++e) { float run = 0.f; const float lb = lb2[e], omlb = omlb2[e]; \
            _Pragma("unroll") for (int i = 0; i < 4; ++i) { const float z = e ? bf2f(rf[i] >> 16) : bf2f(rf[i] & 0xffffu), sg = sigmoidf_(z); const float f = lb + omlb * sg; run += log_(f); cs[e][i] = run; kk[e][i] = omlb * (1.0f - sg); \
                const float zq = e ? bf2f(rq[i] >> 16) : bf2f(rq[i] & 0xffffu); qq[e][i] = zq * sigmoidf_(zq); } run2[e] = run; } \
            _Pragma("unroll") for (int i = 0; i < 4; ++i) vv[i] = ri[i]; *(LAS f32x2*)(tot + w * 128 + d0) = run2; } while (0)
#define HG_E2(c, ob) do { unsigned colq2 = colq2_; asm volatile("" : "+v"(colq2)); f32x2 off = {0.f, 0.f}, gref = {0.f, 0.f}, glast = {0.f, 0.f}; \
          _Pragma("unroll") for (int g_ = 0; g_ < 8; ++g_) { const f32x2 t_ = *(const LAS f32x2*)(tot + g_ * 128 + d0); if (g_ < w) off += t_; if (g_ < 4) gref += t_; glast += t_; } \
          float egref[2], eglr[2], egc[2]; _Pragma("unroll") for (int e = 0; e < 2; ++e) { egref[e] = exp_(gref[e]); eglr[e] = exp_(glast[e] - gref[e]); egc[e] = exp_(gref[e] + Gc[e]); } \
          float kt[2][4]; \
          _Pragma("unroll") for (int i = 0; i < 4; ++i) { const int p = 4 * w + i; float qh[2], kh[2]; \
              _Pragma("unroll") for (int e = 0; e < 2; ++e) { const float g = off[e] + cs[e][i]; const float e1 = exp_(g - gref[e]), e2 = rcpf_(e1); qh[e] = qq[e][i] * e1; kh[e] = kk[e][i] * e2; kt[e][i] = kh[e] * eglr[e]; } \
              *(LAS unsigned*)(lds + (ob) + HA_QH + p * 272 + d0 * 2) = pk2(qh[0], qh[1]); *(LAS unsigned*)(lds + (ob) + HA_KH + p * 272 + d0 * 2) = pk2(kh[0], kh[1]); \
              *(LAS unsigned*)(lds + (ob) + HA_QT + p * 272 + d0 * 2) = pk2(qh[0] * egref[0], qh[1] * egref[1]); *(unsigned*)((char*)qseg + (size_t)((unsigned)dir * T + HG_ROW(c, p)) * (HGW * 2) + colq2) = pk2(qh[0] * egc[0], qh[1] * egc[1]); } \
          _Pragma("unroll") for (int e = 0; e < 2; ++e) { \
              *(LAS u32x2*)(lds + (ob) + HA_KT + (d0 + e) * 80 + w * 8) = (u32x2){pk2(kt[e][0], kt[e][1]), pk2(kt[e][2], kt[e][3])}; \
              *(LAS u32x2*)(lds + (ob) + HA_VT + (d0 + e) * 80 + w * 8) = e ? (u32x2){(vv[0] >> 16) | (vv[1] & 0xffff0000u), (vv[2] >> 16) | (vv[3] & 0xffff0000u)} : (u32x2){(vv[0] & 0xffffu) | (vv[1] << 16), (vv[2] & 0xffffu) | (vv[3] << 16)}; } \
          if (w == 0) *(LAS f32x2*)(lds + (ob) + HA_DEC + d0 * 4) = (f32x2){exp_(glast[0]), exp_(glast[1])}; Gc[0] += glast[0]; Gc[1] += glast[1]; } while (0)
    HG_LOAD(0);
    HG_E1();
    HG_LOAD(1);
    __syncthreads();
    HG_E2(0, 0);
#define HG_XM() do { \
        if (w < 4) { const int tt = w >> 1, st = w & 1; f32x4 sc = (f32x4){0.f, 0.f, 0.f, 0.f}; \
            if (st <= tt) { \
        _Pragma("unroll") \
                for (int ks = 0; ks < 4; ++ks) { const bf16x8 a = *(const LAS bf16x8*)(lds + ob + HA_QH + (tt * 16 + fr) * 272 + ks * 64 + fq * 16), bb = *(const LAS bf16x8*)(lds + ob + HA_KH + (st * 16 + fr) * 272 + ks * 64 + fq * 16); \
                    sc = __builtin_amdgcn_mfma_f32_16x16x32_bf16(a, bb, sc, 0, 0, 0); } } \
        _Pragma("unroll") \
            for (int r = 0; r < 4; ++r) { const int t = tt * 16 + 4 * fq + r, s_ = st * 16 + fr; *(LAS unsigned short*)(lds + HA_P + t * 80 + s_ * 2) = (unsigned short)((s_ <= t) ? f2bf(sc[r]) : 0u); } } \
        _Pragma("unroll") \
        for (int ks = 0; ks < 4; ++ks) { const bf16x8 bs = *(const LAS bf16x8*)(lds + HA_ST + (w * 16 + fr) * 272 + ks * 64 + fq * 16); \
        _Pragma("unroll") \
            for (int tt = 0; tt < 2; ++tt) { const bf16x8 a = *(const LAS bf16x8*)(lds + ob + HA_QT + (tt * 16 + fr) * 272 + ks * 64 + fq * 16); ao[tt] = __builtin_amdgcn_mfma_f32_16x16x32_bf16(bs, a, ao[tt], 0, 0, 0); } } \
    } while (0)
#define HG_YM() do { \
        { const bf16x8 bv = *(const LAS bf16x8*)(lds + ob + HA_VT + (w * 16 + fr) * 80 + fq * 16); unsigned oloff = oloff_; asm volatile("" : "+v"(oloff)); \
        _Pragma("unroll") \
          for (int tt = 0; tt < 2; ++tt) { const bf16x8 a = *(const LAS bf16x8*)(lds + HA_P + (tt * 16 + fr) * 80 + fq * 16); ao[tt] = __builtin_amdgcn_mfma_f32_16x16x32_bf16(bv, a, ao[tt], 0, 0, 0); \
              const unsigned srow = dir ? HG_ROW(c, tt * 16 + 15) : HG_ROW(c, tt * 16); *(u32x2*)((char*)oloc + (size_t)((unsigned)dir * T + srow) * (HGW * 2) + oloff) = (u32x2){pk2(ao[tt][0], ao[tt][1]), pk2(ao[tt][2], ao[tt][3])}; } } \
        { const bf16x8 ak = *(const LAS bf16x8*)(lds + ob + HA_KT + (w * 16 + fr) * 80 + fq * 16); \
          const f32x4 dv = *(const LAS f32x4*)(lds + ob + HA_DEC + (w * 16 + 4 * fq) * 4); \
          bf16x8 bvs[8]; \
        _Pragma("unroll") \
          for (int vt = 0; vt < 8; ++vt) bvs[vt] = *(const LAS bf16x8*)(lds + ob + HA_VT + (vt * 16 + fr) * 80 + fq * 16); \
        _Pragma("unroll") \
          for (int vt = 0; vt < 8; ++vt) accS[vt] = accS[vt] * dv; \
        _Pragma("unroll") \
          for (int vt = 0; vt < 8; ++vt) accS[vt] = __builtin_amdgcn_mfma_f32_16x16x32_bf16(ak, bvs[vt], accS[vt], 0, 0, 0); \
        _Pragma("unroll") \
          for (int vt = 0; vt < 8; ++vt) { u32x2 sw; sw.x = pk2(accS[vt][0], accS[vt][1]); sw.y = pk2(accS[vt][2], accS[vt][3]); \
              *(LAS u32x2*)(lds + HA_ST + (vt * 16 + fr) * 272 + (w * 16 + 4 * fq) * 2) = sw; } } \
    } while (0)
    for (int c = 0; c < 32; ++c) {
        const int ob = (c & 1) * HA_OPB, obn = ((c + 1) & 1) * HA_OPB;
        __syncthreads();
        f32x4 ao[2] = {(f32x4){0.f, 0.f, 0.f, 0.f}, (f32x4){0.f, 0.f, 0.f, 0.f}};
        if (w < 4) { HG_XM(); HG_E1(); } else { HG_E1(); HG_XM(); }
        { const int cn_ = c + 2 < 32 ? c + 2 : 31; HG_LOAD(cn_); }
        __syncthreads();
        if (w < 4) { HG_YM(); if (c + 1 < 32) HG_E2(c + 1, obn); } else { if (c + 1 < 32) HG_E2(c + 1, obn); HG_YM(); }
    }
#undef HG_XM
#undef HG_YM
#undef HG_ROW
#undef HG_LOAD
#undef HG_E1
#undef HG_E2
#pragma unroll
    for (int vt = 0; vt < 8; ++vt) *(f32x4*)(sfin + (size_t)item * 16384 + (size_t)(vt * 16 + fr) * 128 + w * 16 + 4 * fq) = accS[vt];
    if (w == 0) *(f32x2*)(dseg + (size_t)item * 128 + d0) = (f32x2){exp_(Gc[0]), exp_(Gc[1])};
    __syncthreads();
}

__device__ __forceinline__ void hg_phase_c(LAS unsigned char* lds, int cb, int l, const bf16_t* proj, const bf16_t* oloc, const bf16_t* qseg, const float* sfin, const float* dseg, const float* hgn, bf16_t* mix) {
    int tid_l = (int)threadIdx.x; asm volatile("" : "+v"(tid_l));
    const int tid = tid_l, lane = tid & 63, w = __builtin_amdgcn_readfirstlane(tid >> 6), fr = lane & 15, fq = lane >> 4;
    const int half = cb & 1, segtok = (cb >> 1) & 3, h = (cb >> 3) & 3, b = cb >> 5;
    __syncthreads();
#pragma unroll
    for (int dir = 0; dir < 2; ++dir) { const int k = dir ? 3 - segtok : segtok; const int item0 = ((b * 4 + h) * 2 + dir) * 4;
        f32x4 s0[8], s1[8], s2[8], d1[8], d2[8];
#pragma unroll
        for (int i = 0; i < 8; ++i) { const int e4 = tid + NTHR * i; const int v = e4 >> 5, d0 = (e4 & 31) * 4; const size_t so = (size_t)v * 128 + d0;
            s0[i] = k > 0 ? *(const f32x4*)(sfin + (size_t)(item0 + 0) * 16384 + so) : (f32x4){0.f, 0.f, 0.f, 0.f};
            s1[i] = k > 1 ? *(const f32x4*)(sfin + (size_t)(item0 + 1) * 16384 + so) : (f32x4){0.f, 0.f, 0.f, 0.f};
            s2[i] = k > 2 ? *(const f32x4*)(sfin + (size_t)(item0 + 2) * 16384 + so) : (f32x4){0.f, 0.f, 0.f, 0.f};
            d1[i] = k > 1 ? *(const f32x4*)(dseg + (size_t)(item0 + 1) * 128 + d0) : (f32x4){1.f, 1.f, 1.f, 1.f};
            d2[i] = k > 2 ? *(const f32x4*)(dseg + (size_t)(item0 + 2) * 128 + d0) : (f32x4){1.f, 1.f, 1.f, 1.f}; }
#pragma unroll
        for (int i = 0; i < 8; ++i) { const int e4 = tid + NTHR * i; const int v = e4 >> 5, d0 = (e4 & 31) * 4; f32x4 cv = s0[i];
            if (k > 1) cv = cv * d1[i] + s1[i];
            if (k > 2) cv = cv * d2[i] + s2[i];
            u32x2 cw; cw.x = pk2(cv[0], cv[1]); cw.y = pk2(cv[2], cv[3]); *(LAS u32x2*)(lds + dir * 34816 + v * 272 + d0 * 2) = cw; } }
    __syncthreads();
    f32x4 gnv[8];
#pragma unroll
    for (int vt = 0; vt < 8; ++vt) gnv[vt] = *(const f32x4*)(hgn + h * 128 + vt * 16 + 4 * fq);
    const int kf = segtok, kb = 3 - segtok;
#pragma unroll 1
    for (int tile = 0; tile < 4; ++tile) {
        const int t = segtok * 1024 + (half * 4 + tile) * 128 + w * 16 + fr; const size_t row = (size_t)b * SEQ + t;
        bf16x8 bq[2][4]; u32x2 olf[8], olb[8], zgv[8];
#pragma unroll
        for (int dir = 0; dir < 2; ++dir)
#pragma unroll
            for (int ks = 0; ks < 4; ++ks) bq[dir][ks] = *(const bf16x8*)(qseg + ((size_t)dir * T + row) * HGW + h * 128 + ks * 32 + fq * 8);
#pragma unroll
        for (int vt = 0; vt < 8; ++vt) { const int v0 = vt * 16 + 4 * fq; olf[vt] = *(const u32x2*)(oloc + (size_t)row * HGW + h * 128 + v0); olb[vt] = *(const u32x2*)(oloc + ((size_t)T + row) * HGW + h * 128 + v0);
            zgv[vt] = *(const u32x2*)(proj + row * INC + 2048 + h * 128 + v0); }
        f32x4 acc[8];
#pragma unroll
        for (int i = 0; i < 8; ++i) acc[i] = (f32x4){0.f, 0.f, 0.f, 0.f};
#pragma unroll
        for (int dir = 0; dir < 2; ++dir) { const int k = dir ? kb : kf;
            if (k > 0) {
#pragma unroll
                for (int ks = 0; ks < 4; ++ks) {
#pragma unroll
                    for (int vt = 0; vt < 8; ++vt) { const bf16x8 ac = *(const LAS bf16x8*)(lds + dir * 34816 + (vt * 16 + fr) * 272 + ks * 64 + fq * 16); acc[vt] = __builtin_amdgcn_mfma_f32_16x16x32_bf16(ac, bq[dir][ks], acc[vt], 0, 0, 0); } } } }
        float ss = 0.f;
#pragma unroll
        for (int vt = 0; vt < 8; ++vt) { const u32x2 of = olf[vt], ob = olb[vt];
            acc[vt][0] += bf2f(of.x & 0xffffu) + bf2f(ob.x & 0xffffu); acc[vt][1] += bf2f(of.x >> 16) + bf2f(ob.x >> 16); acc[vt][2] += bf2f(of.y & 0xffffu) + bf2f(ob.y & 0xffffu); acc[vt][3] += bf2f(of.y >> 16) + bf2f(ob.y >> 16);
            ss += (acc[vt][0] * acc[vt][0] + acc[vt][1] * acc[vt][1]) + (acc[vt][2] * acc[vt][2] + acc[vt][3] * acc[vt][3]); }
        ss += __shfl_xor(ss, 16); ss += __shfl_xor(ss, 32);
        const float rs = rsqf_(ss * (1.0f / 128.f) + RMS_EPS);
#pragma unroll
        for (int vt = 0; vt < 8; ++vt) { const int v0 = vt * 16 + 4 * fq; const u32x2 zg = zgv[vt]; const f32x4 gn = gnv[vt];
            const float z0 = bf2f(zg.x & 0xffffu), z1 = bf2f(zg.x >> 16), z2 = bf2f(zg.y & 0xffffu), z3 = bf2f(zg.y >> 16);
            u32x2 ow; ow.x = pk2(acc[vt][0] * rs * gn[0] * (z0 * sigmoidf_(z0)), acc[vt][1] * rs * gn[1] * (z1 * sigmoidf_(z1))); ow.y = pk2(acc[vt][2] * rs * gn[2] * (z2 * sigmoidf_(z2)), acc[vt][3] * rs * gn[3] * (z3 * sigmoidf_(z3)));
            *(u32x2*)(mix + row * D + h * 128 + v0) = ow; }
    }
}

constexpr int LR_XC = 0, LR_CAR = 65536, LR_RED = 73728, LR_HS = 75776;
template <int MODE>
__device__ __forceinline__ void lru_pair(LAS unsigned char* lds, int b, int kpair, const bf16_t* proj, const float* cw, const float* cbias, const bf16_t* lruw_l, const float* ba_l, const float* bx_l, const float* lam_l, float* lsum, const float* lrn, bf16_t* mix) {
    int tid_l = (int)threadIdx.x; asm volatile("" : "+v"(tid_l));
    const int tid = tid_l, lane = tid & 63, w = __builtin_amdgcn_readfirstlane(tid >> 6), fr = lane & 15, fq = lane >> 4;
    __syncthreads();
    if (MODE == 1) {
        const int c0 = tid, k0s = 2 * kpair; float cf = 0.f, cbk = 0.f;
        const float* Af = lsum + ((size_t)(0 * 2 + 0) * BATCH + b) * 64 * LRW + c0; const float* Hf = lsum + ((size_t)(0 * 2 + 1) * BATCH + b) * 64 * LRW + c0;
        const float* Ab = lsum + ((size_t)(1 * 2 + 0) * BATCH + b) * 64 * LRW + c0; const float* Hb = lsum + ((size_t)(1 * 2 + 1) * BATCH + b) * 64 * LRW + c0;
        for (int k0 = 0; k0 < k0s; k0 += 16) { float av[16], hv[16];
#pragma unroll
            for (int q = 0; q < 16; ++q) { const int kk = k0 + q; const bool ok = kk < k0s; av[q] = ok ? Af[(size_t)kk * LRW] : 1.0f; hv[q] = ok ? Hf[(size_t)kk * LRW] : 0.0f; }
#pragma unroll
            for (int q = 0; q < 16; ++q) cf = av[q] * cf + hv[q]; }
        for (int k0 = 63; k0 > k0s + 1; k0 -= 16) { float av[16], hv[16];
#pragma unroll
            for (int q = 0; q < 16; ++q) { const int kk = k0 - q; const bool ok = kk > k0s + 1; av[q] = ok ? Ab[(size_t)kk * LRW] : 1.0f; hv[q] = ok ? Hb[(size_t)kk * LRW] : 0.0f; }
#pragma unroll
            for (int q = 0; q < 16; ++q) cbk = av[q] * cbk + hv[q]; }
        LAS float* car = (LAS float*)(lds + LR_CAR);
        car[(0 * 2 + 0) * 512 + c0] = cf; car[(1 * 2 + 0) * 512 + c0] = Af[(size_t)k0s * LRW] * cf + Hf[(size_t)k0s * LRW];
        car[(1 * 2 + 1) * 512 + c0] = cbk; car[(0 * 2 + 1) * 512 + c0] = Ab[(size_t)(k0s + 1) * LRW] * cbk + Hb[(size_t)(k0s + 1) * LRW];
    }
#pragma unroll 1
    for (int sub = 0; sub < 2; ++sub) {
        const int ksub = 2 * kpair + sub; const size_t row0 = (size_t)b * SEQ + (size_t)ksub * 64;
        if (sub) __syncthreads();
        { const int cp = (tid & 255) * 2, th = tid >> 8; const int t0 = ksub * 64 + th * 32;
          const f32x2 w0 = *(const f32x2*)(cw + cp), w1 = *(const f32x2*)(cw + LRW + cp), w2 = *(const f32x2*)(cw + 2 * LRW + cp), w3 = *(const f32x2*)(cw + 3 * LRW + cp), bs = *(const f32x2*)(cbias + cp);
          const bf16_t* zp = proj + ((size_t)b * SEQ + t0) * INC + 2560 + cp;
          unsigned zr[35];
#pragma unroll
          for (int q = 0; q < 35; ++q) { const bool edge = (q < 2) || (q == 34); const bool ok = (q < 2) ? (t0 != 0) : (t0 + 32 < SEQ);
              const long ro = edge ? (ok ? (long)(q - 2) : 0L) : (long)(q - 2); const unsigned zv = *(const unsigned*)(zp + ro * INC); zr[q] = (edge && !ok) ? 0u : zv; }
          const int hd = cp >> 6, ii = cp & 63;
#pragma unroll
          for (int q = 0; q < 32; ++q) { const int tl = th * 32 + q;
              const float x0 = bs[0] + w0[0] * bf2f(zr[q] & 0xffffu) + w1[0] * bf2f(zr[q + 1] & 0xffffu) + w2[0] * bf2f(zr[q + 2] & 0xffffu) + w3[0] * bf2f(zr[q + 3] & 0xffffu);
              const float x1 = bs[1] + w0[1] * bf2f(zr[q] >> 16) + w1[1] * bf2f(zr[q + 1] >> 16) + w2[1] * bf2f(zr[q + 2] >> 16) + w3[1] * bf2f(zr[q + 3] >> 16);
              *(LAS unsigned*)(lds + LR_XC + hd * 8192 + tl * 128 + ((((ii >> 3) ^ (tl & 7))) << 4) + (ii & 7) * 2) = pk2(x0, x1); } }
        __syncthreads();
        float ssq[16];
#pragma unroll
        for (int k = 0; k < 16; ++k) ssq[k] = 0.f;
        bf16x8 bw[2][4]; float cst[2][3];
#pragma unroll
        for (int q_ = 0; q_ < 4; ++q_) bw[1][q_] = (bf16x8){0, 0, 0, 0, 0, 0, 0, 0};
        cst[1][0] = cst[1][1] = cst[1][2] = 0.f;
#define LR_LOADW(it, buf) do { const int jt_ = (it) >> 1, dir_ = (it) & 1, j_ = jt_ * 16 + fr, c_ = w * 64 + j_; \
            _Pragma("unroll") for (int ks_ = 0; ks_ < 2; ++ks_) { bw[buf][ks_ * 2 + 0] = *(const bf16x8*)(lruw_l + ((size_t)((dir_ * 2 + 0) * LRH + w) * 64 + j_) * 64 + ks_ * 32 + fq * 8); \
                                                                  bw[buf][ks_ * 2 + 1] = *(const bf16x8*)(lruw_l + ((size_t)((dir_ * 2 + 1) * LRH + w) * 64 + j_) * 64 + ks_ * 32 + fq * 8); } \
            cst[buf][0] = ba_l[dir_ * LRW + c_]; cst[buf][1] = bx_l[dir_ * LRW + c_]; cst[buf][2] = lam_l[dir_ * LRW + c_]; } while (0)
        LR_LOADW(0, 0);
#pragma unroll 1
        for (int jt = 0; jt < 4; ++jt) {
            const int j = jt * 16 + fr, c = w * 64 + j;
            float xcv[16], hsum[16];
#pragma unroll
            for (int k = 0; k < 16; ++k) { const int tl = 16 * fq + k; xcv[k] = bf2f(*(const LAS unsigned short*)(lds + LR_XC + w * 8192 + tl * 128 + ((((j >> 3) ^ (tl & 7))) << 4) + (j & 7) * 2)); }
#pragma unroll
            for (int dir = 0; dir < 2; ++dir) {
                constexpr int dummy = 0; (void)dummy;
                const int it = jt * 2 + dir; constexpr int dummy2 = 0; (void)dummy2; const int buf = dir;
                { const int itn_ = (it + 1 < 8) ? it + 1 : 7; LR_LOADW(itn_, dir ^ 1); }
                const float bav = cst[buf][0], bxv = cst[buf][1], lamv = cst[buf][2];
                const float sp8 = -8.0f * ((lamv < -20.f) ? -lamv : log_(1.0f + exp_(-lamv)));
                f32x4 aR[4], aI[4];
#pragma unroll
                for (int tt = 0; tt < 4; ++tt) { aR[tt] = (f32x4){0.f, 0.f, 0.f, 0.f}; aI[tt] = (f32x4){0.f, 0.f, 0.f, 0.f}; }
#pragma unroll
                for (int ks = 0; ks < 2; ++ks) {
#pragma unroll
                    for (int tt = 0; tt < 4; ++tt) { const int tla = 16 * (fr >> 2) + 4 * tt + (fr & 3); const bf16x8 av = *(const LAS bf16x8*)(lds + LR_XC + w * 8192 + tla * 128 + ((((ks * 4 + fq) ^ (tla & 7))) << 4));
                        aR[tt] = __builtin_amdgcn_mfma_f32_16x16x32_bf16(av, bw[buf][ks * 2 + 0], aR[tt], 0, 0, 0); aI[tt] = __builtin_amdgcn_mfma_f32_16x16x32_bf16(av, bw[buf][ks * 2 + 1], aI[tt], 0, 0, 0); } }
                float hl[16], pc[16]; float hh = 0.f, pp = 1.0f;
                { constexpr float NL2E = -1.4426950408889634f; const f32x2 nl2 = {NL2E, NL2E}, one2 = {1.0f, 1.0f}, bar2 = {bav * NL2E, bav * NL2E}, bxr2 = {bxv * NL2E, bxv * NL2E}, spl2 = {sp8 * -NL2E, sp8 * -NL2E};
#pragma unroll
                  for (int k = 0; k < 16; k += 2) { const int tt = k >> 2, r = k & 3;
                    const f32x2 er = (f32x2){aR[tt][r], aR[tt][r + 1]} * nl2 + bar2, ei = (f32x2){aI[tt][r], aI[tt][r + 1]} * nl2 + bxr2;
                    const f32x2 dr = (f32x2){__builtin_amdgcn_exp2f(er[0]), __builtin_amdgcn_exp2f(er[1])} + one2, di = (f32x2){__builtin_amdgcn_exp2f(ei[0]), __builtin_amdgcn_exp2f(ei[1])} + one2;
                    const f32x2 rr = {__builtin_amdgcn_rcpf(dr[0]), __builtin_amdgcn_rcpf(dr[1])}, ig = {__builtin_amdgcn_rcpf(di[0]), __builtin_amdgcn_rcpf(di[1])};
                    const f32x2 ea = rr * spl2; const f32x2 a = {__builtin_amdgcn_exp2f(ea[0]), __builtin_amdgcn_exp2f(ea[1])};
                    const f32x2 om = one2 - a * a; const f32x2 sq = {__builtin_amdgcn_sqrtf(__builtin_fabsf(om[0])), __builtin_amdgcn_sqrtf(__builtin_fabsf(om[1]))};
                    const f32x2 u = sq * (ig * (f32x2){xcv[k], xcv[k + 1]});
                    pc[k] = a[0]; pc[k + 1] = a[1]; hl[k] = u[0]; hl[k + 1] = u[1]; } }
#pragma unroll
                for (int kk = 0; kk < 16; ++kk) { const int k = dir ? 15 - kk : kk; hh = pc[k] * hh + hl[k]; pp = pp * pc[k]; hl[k] = hh; pc[k] = pp; }
                const float P0 = __shfl(pp, fr), P1 = __shfl(pp, fr + 16), P2 = __shfl(pp, fr + 32), P3 = __shfl(pp, fr + 48);
                const float H0 = __shfl(hh, fr), H1 = __shfl(hh, fr + 16), H2 = __shfl(hh, fr + 32), H3 = __shfl(hh, fr + 48);
                float cin, pin, Ht, At;
                if (dir == 0) { const float c1 = H0, c2 = P1 * c1 + H1, c3 = P2 * c2 + H2; const float p1 = P0, p2 = P0 * P1, p3 = p2 * P2;
                    cin = fq == 0 ? 0.f : (fq == 1 ? c1 : (fq == 2 ? c2 : c3)); pin = fq == 0 ? 1.0f : (fq == 1 ? p1 : (fq == 2 ? p2 : p3)); Ht = P3 * c3 + H3; At = p3 * P3; }
                else { const float c2 = H3, c1 = P2 * c2 + H2, c0_ = P1 * c1 + H1; const float p2 = P3, p1 = P3 * P2, p0 = p1 * P1;
                    cin = fq == 3 ? 0.f : (fq == 2 ? c2 : (fq == 1 ? c1 : c0_)); pin = fq == 3 ? 1.0f : (fq == 2 ? p2 : (fq == 1 ? p1 : p0)); Ht = P0 * c0_ + H0; At = p0 * P0; }
                if (MODE == 0) { if (fq == 0) { lsum[(((size_t)(dir * 2 + 0) * BATCH + b) * 64 + ksub) * LRW + c] = At; lsum[(((size_t)(dir * 2 + 1) * BATCH + b) * 64 + ksub) * LRW + c] = Ht; } }
                else { const float ein = cin + pin * ((const LAS float*)(lds + LR_CAR))[(sub * 2 + dir) * 512 + c];
#pragma unroll
                    for (int k = 0; k < 16; ++k) { const float hv = hl[k] + pc[k] * ein; hsum[k] = dir ? hsum[k] + hv : hv; } }
            }
            if (MODE == 1) {
#pragma unroll
                for (int k = 0; k < 16; ++k) { ssq[k] += hsum[k] * hsum[k]; *(LAS unsigned short*)(lds + LR_HS + (16 * fq + k) * 1024 + c * 2) = (unsigned short)f2bf(hsum[k]); }
            }
        }
#undef LR_LOADW
        if (MODE == 1) {
            LAS float* red = (LAS float*)(lds + LR_RED);
#pragma unroll
            for (int k = 0; k < 16; ++k) {
#define LR_DPP_ADD(ctrl) ssq[k] += __builtin_bit_cast(float, __builtin_amdgcn_update_dpp(0, __builtin_bit_cast(int, ssq[k]), ctrl, 0xf, 0xf, false))
                LR_DPP_ADD(0xB1); LR_DPP_ADD(0x4E); LR_DPP_ADD(0x141); LR_DPP_ADD(0x140);
#undef LR_DPP_ADD
            }
            if (fr == 0) {
#pragma unroll
                for (int k = 0; k < 16; ++k) red[w * 64 + 16 * fq + k] = ssq[k]; }
            __syncthreads();
#pragma unroll 2
            for (int i = 0; i < 8; ++i) { const int idx = tid + NTHR * i, tk = idx >> 6, c8 = (idx & 63) * 8; float t_ = 0.f;
#pragma unroll
                for (int ww = 0; ww < 8; ++ww) t_ += red[ww * 64 + tk];
                const float rs = rsqf_(t_ * (1.0f / 512.f) + RMS_EPS);
                const u32x4 hw = *(const LAS u32x4*)(lds + LR_HS + tk * 1024 + c8 * 2); const size_t row = row0 + tk; const u32x4 zw = *(const u32x4*)(proj + row * INC + 3072 + c8);
                const f32x4 g0 = *(const f32x4*)(lrn + c8), g1 = *(const f32x4*)(lrn + c8 + 4); unsigned ow[4];
#pragma unroll
                for (int q = 0; q < 4; ++q) { float hv[2] = {bf2f(hw[q] & 0xffffu), bf2f(hw[q] >> 16)}, zz[2] = {bf2f(zw[q] & 0xffffu), bf2f(zw[q] >> 16)}, rr[2];
#pragma unroll
                    for (int e2 = 0; e2 < 2; ++e2) { const int cc = 2 * q + e2; rr[e2] = hv[e2] * rs * (cc < 4 ? g0[cc] : g1[cc - 4]) * gelu_tanh_(zz[e2]); }
                    ow[q] = pk2(rr[0], rr[1]); }
                *(u32x4*)(mix + row * D + 512 + c8) = (u32x4){ow[0], ow[1], ow[2], ow[3]}; }
        }
    }
}

#define XB_TMO      128
#define XB_XCNT(j)  (256  + 64 * (j))
#define XB_XSUB(j)  (1280 + 64 * (j))
#define XB_XGEN(j)  (2304 + 64 * (j))
#define XB_TOP      3328
#define XB_TOPGEN   3392
#define XCD_BAR_WORDS 3456
#define XB_SPIN_CAP (1u << 18)
__device__ __forceinline__ unsigned xb_ld(unsigned* p)              { return __hip_atomic_load(p, __ATOMIC_RELAXED, __HIP_MEMORY_SCOPE_AGENT); }
__device__ __forceinline__ unsigned xb_add(unsigned* p, unsigned v) { return __hip_atomic_fetch_add(p, v, __ATOMIC_RELAXED, __HIP_MEMORY_SCOPE_AGENT); }
__device__ __forceinline__ unsigned xb_xcc_id() { return (unsigned)__builtin_amdgcn_s_getreg((3 << 11) | 20) & 0xFu; }
#define XB_SPIN(cond, bar) do { unsigned _sp = 0; while (cond) { __builtin_amdgcn_s_sleep(1); \
    if ((++_sp & 255u) == 0u) { if (xb_ld(&(bar)[XB_TMO])) break; if (_sp > XB_SPIN_CAP) { atomicAdd(&(bar)[XB_TMO], 1u); break; } } } } while (0)
struct XcdBarrier { unsigned* bar; unsigned x; volatile LAS unsigned* st; };
__device__ __forceinline__ XcdBarrier xcd_barrier_post(unsigned* bar, volatile LAS unsigned* st) {
    XcdBarrier b; b.bar = bar; b.x = xb_xcc_id(); b.st = st;
    if (threadIdx.x == 0) (void)xb_add(&bar[XB_XCNT(b.x)], 1u);
    return b;
}
__device__ __forceinline__ void xcd_barrier_complete(unsigned* bar, unsigned x, unsigned& nloc, unsigned& nx) {
    const unsigned G = gridDim.x * gridDim.y * gridDim.z;
    unsigned sum, cnt, mine, sp = 0u;
    for (;;) {
        sum = 0u; cnt = 0u; mine = 0u;
#pragma unroll
        for (unsigned j = 0; j < 16; ++j) { const unsigned c = xb_ld(&bar[XB_XCNT(j)]); sum += c; cnt += (c > 0u) ? 1u : 0u; mine = (j == x) ? c : mine; }
        if (sum == G) break;
        __builtin_amdgcn_s_sleep(1);
        if ((++sp & 255u) == 0u) { if (xb_ld(&bar[XB_TMO])) break; if (sp > XB_SPIN_CAP) { atomicAdd(&bar[XB_TMO], 1u); break; } }
    }
    nloc = mine > 0u ? mine : 1u; nx = cnt > 0u ? cnt : 1u;
}
__device__ __forceinline__ void xcd_barrier(const XcdBarrier& b_in) {
    XcdBarrier b = b_in; asm volatile("" : "+s"(b.bar), "+s"(b.x));
    asm volatile("s_waitcnt vmcnt(0)" ::: "memory");
    __syncthreads();
    if (threadIdx.x == 0) {
        unsigned* bar = b.bar;
        __builtin_amdgcn_s_waitcnt(0);
        unsigned nloc = b.st[0], nx = b.st[1];
        if (nloc == 0u) { xcd_barrier_complete(bar, b.x, nloc, nx); b.st[0] = nloc; b.st[1] = nx; }
        const unsigned old = xb_add(&bar[XB_XSUB(b.x)], 1u);
        const unsigned gen = old / nloc;
        if (old + 1u == (gen + 1u) * nloc) {
            __builtin_amdgcn_fence(__ATOMIC_RELEASE, "agent");
            asm volatile("s_waitcnt vmcnt(0)" ::: "memory");
            const unsigned og = xb_add(&bar[XB_TOP], 1u);
            const unsigned tg = og / nx;
            if (og + 1u == (tg + 1u) * nx) xb_add(&bar[XB_TOPGEN], 1u);
            else XB_SPIN(xb_ld(&bar[XB_TOPGEN]) == tg, bar);
            __builtin_amdgcn_fence(__ATOMIC_ACQUIRE, "agent");
            xb_add(&bar[XB_XGEN(b.x)], 1u);
            asm volatile("s_waitcnt vmcnt(0)" ::: "memory");
        } else {
            XB_SPIN(xb_ld(&bar[XB_XGEN(b.x)]) == gen, bar);
            __builtin_amdgcn_fence(__ATOMIC_ACQUIRE, "agent");
            asm volatile("s_waitcnt vmcnt(0)" ::: "memory");
        }
    }
    __syncthreads();
}

struct Args { const float* in[23]; float* out; unsigned char* ws; int l_lo, l_hi, ph_lo, ph_hi, pro, pad; };
enum { I_X = 0, I_WIN, I_HGLB, I_HGNORM, I_CONVW, I_CONVB, I_WA, I_BA, I_WX, I_BX, I_LAM, I_LRUNORM, I_WOUT, I_LN1G, I_LN1B, I_RW, I_RB, I_WGU, I_BGU, I_WDN, I_BDN, I_LN2G, I_LN2B };
enum { PH_PROJ = 1, PH_HG = 2, PH_LRUAU = 3, PH_LRUSCAN = 4, PH_COMB = 5, PH_OUTG = 6, PH_LN1R = 7, PH_MOE1 = 8, PH_MOE2 = 9, PH_LN2 = 10, PH_END = 11 };

__device__ __forceinline__ void transpose_item(const float* W, int N, int k0, int n0, bf16_t* WT, size_t dst_row0, int KP, LAS float* scr, int lane) {
#pragma unroll 8
    for (int i = 0; i < 32; ++i) { const int kk = 2 * i + (lane >> 5); scr[kk * 33 + (lane & 31)] = W[(size_t)(k0 + kk) * N + n0 + (lane & 31)]; }
    LDS_WAIT(); asm volatile("" ::: "memory");
    const int c = lane & 7;
#pragma unroll
    for (int j = 0; j < 4; ++j) { const int n = (lane >> 3) + 8 * j; const LAS float* s = scr + (8 * c) * 33 + n;
        u32x4 o; o.x = pk2(s[0 * 33], s[1 * 33]); o.y = pk2(s[2 * 33], s[3 * 33]); o.z = pk2(s[4 * 33], s[5 * 33]); o.w = pk2(s[6 * 33], s[7 * 33]);
        *(u32x4*)(WT + (dst_row0 + n) * KP + k0 + 8 * c) = o; }
    LDS_WAIT(); asm volatile("" ::: "memory");
}

__device__ __forceinline__ void transpose_item_q(const float* W, int N, int k0, int n0, unsigned char* WT, size_t dst_row0, int KP, float mul, LAS float* scr, int lane) {
#pragma unroll 8
    for (int i = 0; i < 32; ++i) { const int kk = 2 * i + (lane >> 5); scr[kk * 33 + (lane & 31)] = W[(size_t)(k0 + kk) * N + n0 + (lane & 31)]; }
    LDS_WAIT(); asm volatile("" ::: "memory");
    const int c = lane & 7;
#pragma unroll
    for (int j = 0; j < 4; ++j) { const int n = (lane >> 3) + 8 * j; const LAS float* s = scr + (8 * c) * 33 + n; int w0 = 0, w1 = 0;
        w0 = __builtin_amdgcn_cvt_pk_fp8_f32(s[0 * 33] * mul, s[1 * 33] * mul, w0, false); w0 = __builtin_amdgcn_cvt_pk_fp8_f32(s[2 * 33] * mul, s[3 * 33] * mul, w0, true);
        w1 = __builtin_amdgcn_cvt_pk_fp8_f32(s[4 * 33] * mul, s[5 * 33] * mul, w1, false); w1 = __builtin_amdgcn_cvt_pk_fp8_f32(s[6 * 33] * mul, s[7 * 33] * mul, w1, true);
        *(u32x2*)(WT + (dst_row0 + n) * KP + k0 + 8 * c) = (u32x2){(unsigned)w0, (unsigned)w1}; }
    LDS_WAIT(); asm volatile("" ::: "memory");
}
__device__ __forceinline__ void transpose_item_q2(const float* W, int N, int k0, int n0, unsigned char* WT, size_t dst_row0, int KP, float mul, LAS float* scr, int lane) {
#pragma unroll 8
    for (int i = 0; i < 32; ++i) { const int kk = 4 * i + (lane >> 4), n = lane & 15; scr[n * 132 + kk] = W[(size_t)(k0 + kk) * N + n0 + n]; }
    LDS_WAIT(); asm volatile("" ::: "memory");
    const int c = lane & 15;
#pragma unroll
    for (int j = 0; j < 4; ++j) { const int n = (lane >> 4) + 4 * j; const f32x4 a = *(const LAS f32x4*)(scr + n * 132 + 8 * c), b = *(const LAS f32x4*)(scr + n * 132 + 8 * c + 4); int w0 = 0, w1 = 0;
        w0 = __builtin_amdgcn_cvt_pk_fp8_f32(a[0] * mul, a[1] * mul, w0, false); w0 = __builtin_amdgcn_cvt_pk_fp8_f32(a[2] * mul, a[3] * mul, w0, true);
        w1 = __builtin_amdgcn_cvt_pk_fp8_f32(b[0] * mul, b[1] * mul, w1, false); w1 = __builtin_amdgcn_cvt_pk_fp8_f32(b[2] * mul, b[3] * mul, w1, true);
        *(u32x2*)(WT + (dst_row0 + n) * KP + k0 + 8 * c) = (u32x2){(unsigned)w0, (unsigned)w1}; }
    LDS_WAIT(); asm volatile("" ::: "memory");
}
__device__ __forceinline__ int fp8_scale_exp(const float* W, int stride, int lane) {
    float a = 0.f;
#pragma unroll
    for (int q = 0; q < 8; ++q) a += fabsf(W[(size_t)(lane * 8 + q) * stride]);
    a = wave_sum(a) * (1.0f / 512.f);
    int s = (a > 0.f) ? (int)rintf(-log2f(a)) : 0; return s < -24 ? -24 : (s > 24 ? 24 : s);
}

typedef const __attribute__((address_space(4))) Args* CArgs;
#define PHASE_ENV() \
    CArgs A = (CArgs)__builtin_amdgcn_kernarg_segment_ptr(); asm volatile("" : "+s"(A)); \
    int tid_l_ = (int)threadIdx.x, bid_l_ = (int)blockIdx.x, G_l_ = (int)gridDim.x; asm volatile("" : "+v"(tid_l_), "+s"(bid_l_), "+s"(G_l_)); \
    const int tid = tid_l_, lane = tid & 63, wave = __builtin_amdgcn_readfirstlane(tid >> 6), G = G_l_, bid = bid_l_, gw = bid * NWAVES + wave, NGW = G * NWAVES; (void)lane; (void)gw; (void)NGW; \
    unsigned char* ws = A->ws; \
    unsigned* ctl = (unsigned*)(ws + WS_CTL); (void)ctl; \
    float* lbt = (float*)(ws + WS_LBT); (void)lbt; \
    bf16_t* rwh = (bf16_t*)(ws + WS_RWH); bf16_t* rwl = (bf16_t*)(ws + WS_RWL); (void)rwh; (void)rwl; \
    bf16_t* win_t = (bf16_t*)(ws + WS_WIN); bf16_t* wout_t = (bf16_t*)(ws + WS_WOUT); bf16_t* wgu_t = (bf16_t*)(ws + WS_WGU); bf16_t* wdn_t = (bf16_t*)(ws + WS_WDN); (void)win_t; (void)wout_t; (void)wgu_t; (void)wdn_t; \
    bf16_t* xb = (bf16_t*)(ws + WS_XB); float* xres = (float*)(ws + WS_XRES); bf16_t* proj = (bf16_t*)(ws + WS_PROJ); bf16_t* mix = (bf16_t*)(ws + WS_MIX); (void)xb; (void)xres; (void)proj; (void)mix; \
    float* ybuf = (float*)(ws + WS_Y); bf16_t* ybf = (bf16_t*)(ws + WS_Y); (void)ybf; float* x1 = (float*)(ws + WS_X1); bf16_t* x1b = (bf16_t*)(ws + WS_X1B); unsigned char* hid = ws + WS_HID; unsigned char* wguq = ws + WS_WGU; unsigned char* wdnq = ws + WS_WDN; unsigned char* x1q = ws + WS_X1Q; unsigned char* xq = ws + WS_XQ; unsigned char* winq = ws + WS_WINQ; (void)xq; (void)winq; (void)wguq; (void)wdnq; (void)x1q; unsigned char* ysl = ws + WS_YS; (void)ybuf; (void)x1; (void)x1b; (void)hid; (void)ysl; \
    int* rtok = (int*)(ws + WS_RTOK); float* rgate = (float*)(ws + WS_RGATE); int* tslot = (int*)(ws + WS_TSLOT); (void)rtok; (void)rgate; (void)tslot; \
    float* odir = (float*)(ws + WS_ODIR); float* hdir = (float*)(ws + WS_HDIR); float* aub = (float*)(ws + WS_AU); (void)odir; (void)hdir; (void)aub; \
    bf16_t* oloc = (bf16_t*)(ws + WS_OLOC); bf16_t* qseg = (bf16_t*)(ws + WS_QSEG); float* sfin = (float*)(ws + WS_SFIN); float* dseg = (float*)(ws + WS_DSEG); float* lsum = (float*)(ws + WS_LSUM); bf16_t* lruw = (bf16_t*)(ws + WS_LRUW); (void)oloc; (void)qseg; (void)sfin; (void)dseg; (void)lsum; (void)lruw; \
    const float* xin = (l == 0) ? A->in[I_X] : (const float*)xres; float* xout = (l == NL - 1) ? A->out : xres; unsigned* cntg = ctl + CW_CNT + 1024 * l; (void)xin; (void)xout; (void)cntg

#define MOE_TABLES(sclp) do { __syncthreads(); \
    if (tid < 32) { tabcnt[tid] = (int)__hip_atomic_load(cntg + 32 * tid, __ATOMIC_RELAXED, __HIP_MEMORY_SCOPE_AGENT); tabscl[tid] = (sclp) ? ((const int*)(sclp))[tid] : 0; } \
    __syncthreads(); \
    if (tid == 0) { int s_ = 0; for (int e_ = 0; e_ < 32; ++e_) { tabpblk[e_] = s_; s_ += (tabcnt[e_] + 255) >> 8; } tabpblk[32] = s_; } \
    __syncthreads(); \
    for (int i_ = tid; i_ < tabpblk[32] && i_ < 1024; i_ += NTHR) { int e_ = 0; for (int q2_ = 1; q2_ < 32; ++q2_) e_ += (tabpblk[q2_] <= i_) ? 1 : 0; tabeb[i_] = (unsigned short)e_; }     \
    __syncthreads(); } while (0)

template <int PH> __global__ void __launch_bounds__(NTHR, 2) mk_fwd(Args args) {
    extern __shared__ __attribute__((aligned(16))) unsigned char lds_raw[];
    LAS unsigned char* lds = (LAS unsigned char*)lds_raw;
    const int tid = threadIdx.x, lane = tid & 63, wave = __builtin_amdgcn_readfirstlane(tid >> 6);
    const int G = gridDim.x, bid = blockIdx.x;
    const int gw = bid * NWAVES + wave, NGW = G * NWAVES;
    LAS int* tabcnt = (LAS int*)(lds + 131072 + 1024); LAS int* tabpblk = (LAS int*)(lds + 131072 + 1024 + 256); LAS int* tabscl = (LAS int*)(lds + 131072 + 1024 + 512); LAS unsigned short* tabeb = (LAS unsigned short*)(lds + 131072 + 6144);
    XcdBarrier bar; bar.bar = nullptr; bar.x = 0; bar.st = nullptr;
    if (PH == 0) {
        volatile LAS unsigned* bst = (volatile LAS unsigned*)(lds + LDS_BYTES - 16);
        if (tid == 0) { bst[0] = 0u; bst[1] = 0u; }
        __syncthreads();
        bar = xcd_barrier_post((unsigned*)(args.ws + WS_CTL) + CW_BAR, bst);
    }
#define GRID_BAR() do { if (PH == 0) xcd_barrier(bar); } while (0)
#ifndef PROBE_REP
#define PROBE_REP 0
#endif
#define REPS(k) (((PROBE_REP >> (k)) & 1) ? 2 : 1)

    for (int rep_ = 0; rep_ < REPS(0); ++rep_) if (PH == -1 || PH == 0) {
        const int l = 0; PHASE_ENV();
        LAS float* scr = (LAS float*)(lds + wave * 16384);
        { constexpr int per = 8 * 224; for (int it = gw; it < NL * per; it += NGW) { const int ll = it / per, r = it % per, kb = r / 224, nb = r % 224; const float* src = A->in[I_WIN] + (size_t)ll * D * INC;
            const int sx = fp8_scale_exp(src, 7177, lane); if (r == 0 && lane == 0) ((int*)ctl)[CW_SIN + ll] = sx;
            transpose_item_q2(src, INC, kb * 128, nb * 16, winq + (size_t)ll * INC * D, (size_t)nb * 16, D, exp2f((float)sx), scr, lane); } }
        { constexpr int per = 16 * 32; for (int it = gw; it < NL * per; it += NGW) { const int ll = it / per, r = it % per, kb = r / 32, nb = r % 32;
            transpose_item(A->in[I_WOUT] + (size_t)ll * D * D, D, kb * 64, nb * 32, wout_t + (size_t)ll * D * D, (size_t)nb * 32, D, scr, lane); } }
        for (int pe = gw >> 4; pe < NL * NE; pe += NGW >> 4) { const float* src = A->in[I_WGU] + (size_t)pe * D * 2048; const int sx = fp8_scale_exp(src, 4099, lane); const float mul = exp2f((float)sx);
            if ((gw & 15) == 0 && lane == 0) ((int*)ctl)[CW_SGU + pe] = sx;
            for (int r = gw & 15; r < 8 * 128; r += 16) { const int kb = r / 128, nb = r % 128; const int n0 = nb * 16, cc = n0 & 1023, isup = n0 >> 10; const size_t drow = (size_t)(cc >> 7) * 256 + (size_t)isup * 128 + (cc & 127);
                transpose_item_q2(src, 2048, kb * 128, n0, wguq + (size_t)pe * 2048 * D, drow, D, mul, scr, lane); } }
        for (int pe = gw >> 4; pe < NL * NE; pe += NGW >> 4) { const float* src = A->in[I_WDN] + (size_t)pe * DE * D; const int sx = fp8_scale_exp(src, 2051, lane); const float mul = exp2f((float)sx);
            if ((gw & 15) == 0 && lane == 0) ((int*)ctl)[CW_SDN + pe] = sx;
            for (int r = gw & 15; r < 8 * 64; r += 16) { const int kb = r / 64, nb = r % 64;
                transpose_item_q2(src, D, kb * 128, nb * 16, wdnq + (size_t)pe * D * DE, (size_t)nb * 16, DE, mul, scr, lane); } }
        for (int i = bid * NTHR + tid; i < NL * NE * D; i += G * NTHR) { const int ll = i / (NE * D), r = i % (NE * D), e = r / D, d = r % D; const float w = A->in[I_RW][(size_t)ll * D * NE + (size_t)d * NE + e];
            const unsigned h = f2bf(w); rwh[i] = (bf16_t)h; rwl[i] = (bf16_t)f2bf(w - bf2f(h)); }
        for (int i = bid * NTHR + tid; i < NL * 2 * 2 * LRH * LHD * LHD; i += G * NTHR) { const int ii = i & 63, jj = (i >> 6) & 63, hh = (i >> 12) & 7, wh = (i >> 15) & 1, dl = i >> 16;
            const float* src = wh ? A->in[I_WX] : A->in[I_WA]; lruw[i] = (bf16_t)f2bf(src[((size_t)dl * LRH + hh) * LHD * LHD + (size_t)ii * LHD + jj]); }
        for (size_t i = (size_t)bid * NTHR + tid; i < (size_t)T * D / 4; i += (size_t)G * NTHR) { const f32x4 v = ((const f32x4*)A->in[I_X])[i]; u32x2 o; o.x = pk2(v[0], v[1]); o.y = pk2(v[2], v[3]); ((u32x2*)xb)[i] = o; int q_ = 0; q_ = __builtin_amdgcn_cvt_pk_fp8_f32(v[0], v[1], q_, false); q_ = __builtin_amdgcn_cvt_pk_fp8_f32(v[2], v[3], q_, true); ((int*)xq)[i] = q_; }
        for (int i = bid * NTHR + tid; i < 2 * HGW; i += G * NTHR) { const float* p = A->in[I_HGLB] + i; float v[NL], mx = -3.0e38f;
#pragma unroll
            for (int q = 0; q < NL; ++q) { v[q] = p[(size_t)q * 2 * HGW]; mx = fmaxf(mx, v[q]); }
            float s = 0.f;
#pragma unroll
            for (int q = 0; q < NL; ++q) { v[q] = expf(v[q] - mx); s += v[q]; }
            float cum = 0.f;
#pragma unroll
            for (int q = 0; q < NL; ++q) { if (q > 0) cum += v[q] / s; lbt[(size_t)q * 2 * HGW + i] = fminf(fmaxf(cum, 0.f), 1.0f - 1e-6f); } }
    }
    GRID_BAR();

    const int l_lo = (PH == 0) ? 0 : args.l_lo, l_hi = (PH == 0) ? NL : args.l_hi;
    for (int l = l_lo; l < l_hi; ++l) {
#define IN(k) (PH == 0 || PH == (k))

        for (int rep_ = 0; rep_ < REPS(PH_PROJ); ++rep_) if (IN(PH_PROJ)) {
            if (rep_) GRID_BAR();
            PHASE_ENV();
            ProbProjT<true> p; p.A = xq; p.Bt = winq + (size_t)l * INC * D; p.sw = ((const int*)ctl)[CW_SIN + l]; p.C = proj; p.ldc = INC; p.S.init(T, INC, G, bid);
            pg8::gemm_phase(lds, p);
        }
        GRID_BAR();
        for (int rep_ = 0; rep_ < REPS(PH_HG); ++rep_) if (IN(PH_HG)) {
            if (rep_) GRID_BAR();
            PHASE_ENV();
            for (int item = bid; item < 256; item += G) hg_phase_a(lds, item, l, proj, lbt, oloc, qseg, sfin, dseg);
        }
        for (int rep_ = 0; rep_ < REPS(PH_LRUAU); ++rep_) if (IN(PH_LRUAU)) {
            if (rep_) GRID_BAR();
            PHASE_ENV();
            for (int it = bid; it < BATCH * 32; it += G)
                lru_pair<0>(lds, it >> 5, it & 31, proj, A->in[I_CONVW] + (size_t)l * 4 * LRW, A->in[I_CONVB] + (size_t)l * LRW, lruw + (size_t)l * 2 * 2 * LRH * LHD * LHD,
                               A->in[I_BA] + (size_t)l * 2 * LRW, A->in[I_BX] + (size_t)l * 2 * LRW, A->in[I_LAM] + (size_t)l * 2 * LRW, lsum, nullptr, nullptr);
        }
        GRID_BAR();
        for (int rep_ = 0; rep_ < REPS(PH_COMB); ++rep_) if (IN(PH_COMB)) {
            if (rep_) GRID_BAR();
            PHASE_ENV();
            const float* hgn = A->in[I_HGNORM] + (size_t)l * HGW;
            for (int cb = bid; cb < 256; cb += G) hg_phase_c(lds, cb, l, proj, oloc, qseg, sfin, dseg, hgn, mix);
            for (int it = bid; it < BATCH * 32; it += G)
                lru_pair<1>(lds, it >> 5, it & 31, proj, A->in[I_CONVW] + (size_t)l * 4 * LRW, A->in[I_CONVB] + (size_t)l * LRW, lruw + (size_t)l * 2 * 2 * LRH * LHD * LHD,
                               A->in[I_BA] + (size_t)l * 2 * LRW, A->in[I_BX] + (size_t)l * 2 * LRW, A->in[I_LAM] + (size_t)l * 2 * LRW, lsum, A->in[I_LRUNORM] + (size_t)l * LRW, mix);
        }
        GRID_BAR();
        for (int rep_ = 0; rep_ < REPS(PH_OUTG); ++rep_) if (IN(PH_OUTG)) {
            if (rep_) GRID_BAR();
            PHASE_ENV();
            ProbProjT<false> p; p.A = mix; p.Bt = wout_t + (size_t)l * D * D; p.sw = 0; p.C = ybf; p.ldc = D; p.S.init(T, D, G, bid);
            pg8::gemm_phase(lds, p);
        }
        GRID_BAR();
        if (IN(PH_LN1R)) {
            PHASE_ENV();
            LAS float* S1 = (LAS float*)lds;
            LAS float* S2 = S1 + 256;
            LAS float* PART = S2 + 256;
            constexpr int LN1_MAXT = 16;
            LAS int* hist = (LAS int*)(PART + 8 * 32 * 36); LAS int* basee = hist + 32; LAS int* sel = basee + 32; LAS float* gsel = (LAS float*)(sel + LN1_MAXT * 128);
            LAS float* G1L = gsel + LN1_MAXT * 128; LAS float* B1L = G1L + D;
            const float* rb = A->in[I_RB] + (size_t)l * NE;
            const int tk = lane & 15, kq = lane >> 4, colb = wave * 128 + kq * 8;
            bf16x8 wfh[2][4], wfl[2][4];
#pragma unroll
            for (int et = 0; et < 2; ++et)
#pragma unroll
                for (int ks = 0; ks < 4; ++ks) { const size_t off = (size_t)l * NE * D + (size_t)(et * 16 + tk) * D + colb + 32 * ks; wfh[et][ks] = *(const bf16x8*)(rwh + off); wfl[et][ks] = *(const bf16x8*)(rwl + off); }
            if (tid < 32) hist[tid] = 0;
            { const float* src_ = (tid < 256) ? (A->in[I_LN1G] + (size_t)l * D + 4 * tid) : (A->in[I_LN1B] + (size_t)l * D + 4 * (tid - 256)); *(LAS f32x4*)(G1L + 4 * tid) = *(const f32x4*)src_; }
            int tix = 0;
            for (int tile = bid; tile < T / 32; tile += G, ++tix) {
                float tv[2][4][8];
#pragma unroll
                for (int tt = 0; tt < 2; ++tt) { const size_t row = (size_t)tile * 32 + tt * 16 + tk;
#pragma unroll
                    for (int ks = 0; ks < 4; ++ks) { const u32x4 xw = *(const u32x4*)(xb + row * D + colb + 32 * ks), yw = *(const u32x4*)(ybf + row * D + colb + 32 * ks);
#pragma unroll
                        for (int q = 0; q < 4; ++q) { tv[tt][ks][2 * q] = bf2f(xw[q] & 0xffffu) * ALPHA + bf2f(yw[q] & 0xffffu); tv[tt][ks][2 * q + 1] = bf2f(xw[q] >> 16) * ALPHA + bf2f(yw[q] >> 16); } } }
                float mean[2], rstd[2];
#pragma unroll
                for (int tt = 0; tt < 2; ++tt) { float s_ = 0.f;
#pragma unroll
                    for (int ks = 0; ks < 4; ++ks)
#pragma unroll
                        for (int q = 0; q < 8; ++q) s_ += tv[tt][ks][q];
                    s_ += __shfl_xor(s_, 16); s_ += __shfl_xor(s_, 32); if (kq == 0) S1[wave * 32 + tt * 16 + tk] = s_; }
                __syncthreads();
#pragma unroll
                for (int tt = 0; tt < 2; ++tt) { float m_ = 0.f;
#pragma unroll
                    for (int ww = 0; ww < 8; ++ww) m_ += S1[ww * 32 + tt * 16 + tk];
                    mean[tt] = m_ * (1.f / D); float s_ = 0.f;
#pragma unroll
                    for (int ks = 0; ks < 4; ++ks)
#pragma unroll
                        for (int q = 0; q < 8; ++q) { tv[tt][ks][q] -= mean[tt]; s_ += tv[tt][ks][q] * tv[tt][ks][q]; }
                    s_ += __shfl_xor(s_, 16); s_ += __shfl_xor(s_, 32); if (kq == 0) S2[wave * 32 + tt * 16 + tk] = s_; }
                __syncthreads();
                f32x4 acc[2][2];
#pragma unroll
                for (int et = 0; et < 2; ++et)
#pragma unroll
                    for (int tt = 0; tt < 2; ++tt) acc[et][tt] = (f32x4){0.f, 0.f, 0.f, 0.f};
#pragma unroll
                for (int tt = 0; tt < 2; ++tt) { float v_ = 0.f;
#pragma unroll
                    for (int ww = 0; ww < 8; ++ww) v_ += S2[ww * 32 + tt * 16 + tk];
                    rstd[tt] = rsqf_(v_ * (1.f / D) + LN_EPS); const size_t row = (size_t)tile * 32 + tt * 16 + tk;
#pragma unroll
                    for (int ks = 0; ks < 4; ++ks) { const f32x4 ga = *(const LAS f32x4*)(G1L + colb + 32 * ks), gb = *(const LAS f32x4*)(G1L + colb + 32 * ks + 4), ba_ = *(const LAS f32x4*)(B1L + colb + 32 * ks), bb_ = *(const LAS f32x4*)(B1L + colb + 32 * ks + 4);
                        float o[8]; unsigned hw[4], lw[4];
#pragma unroll
                        for (int q = 0; q < 8; ++q) o[q] = tv[tt][ks][q] * rstd[tt] * (q < 4 ? ga[q] : gb[q - 4]) + (q < 4 ? ba_[q] : bb_[q - 4]);
#pragma unroll
                        for (int q = 0; q < 4; ++q) { hw[q] = pk2(o[2 * q], o[2 * q + 1]); lw[q] = pk2(o[2 * q] - bf2f(hw[q] & 0xffffu), o[2 * q + 1] - bf2f(hw[q] >> 16)); }
                        *(u32x4*)(x1b + row * D + colb + 32 * ks) = (u32x4){hw[0], hw[1], hw[2], hw[3]};
                        { int q0 = 0, q1 = 0; q0 = __builtin_amdgcn_cvt_pk_fp8_f32(o[0], o[1], q0, false); q0 = __builtin_amdgcn_cvt_pk_fp8_f32(o[2], o[3], q0, true); q1 = __builtin_amdgcn_cvt_pk_fp8_f32(o[4], o[5], q1, false); q1 = __builtin_amdgcn_cvt_pk_fp8_f32(o[6], o[7], q1, true);
                          *(u32x2*)(x1q + row * D + colb + 32 * ks) = (u32x2){(unsigned)q0, (unsigned)q1}; }
                        const bf16x8 xh = __builtin_bit_cast(bf16x8, (u32x4){hw[0], hw[1], hw[2], hw[3]}), xl = __builtin_bit_cast(bf16x8, (u32x4){lw[0], lw[1], lw[2], lw[3]});
#pragma unroll
                        for (int et = 0; et < 2; ++et) { acc[et][tt] = __builtin_amdgcn_mfma_f32_16x16x32_bf16(wfh[et][ks], xh, acc[et][tt], 0, 0, 0); acc[et][tt] = __builtin_amdgcn_mfma_f32_16x16x32_bf16(wfl[et][ks], xh, acc[et][tt], 0, 0, 0); acc[et][tt] = __builtin_amdgcn_mfma_f32_16x16x32_bf16(wfh[et][ks], xl, acc[et][tt], 0, 0, 0); } } }
#pragma unroll
                for (int et = 0; et < 2; ++et)
#pragma unroll
                    for (int tt = 0; tt < 2; ++tt) *(LAS f32x4*)(PART + (wave * 32 + tt * 16 + tk) * 36 + et * 16 + 4 * kq) = acc[et][tt];
                __syncthreads();
                {
                    const int tok = tid >> 4, sub = tid & 15; float l0 = rb[2 * sub], l1 = rb[2 * sub + 1];
#pragma unroll
                    for (int ww = 0; ww < 8; ++ww) { const f32x2 pv = *(const LAS f32x2*)(PART + (ww * 32 + tok) * 36 + 2 * sub); l0 += pv[0]; l1 += pv[1]; }
                    float tvv[4]; int tee[4];
#pragma unroll
                    for (int k = 0; k < 4; ++k) { const bool hi_ = l1 > l0; float bv = hi_ ? l1 : l0; int bi = hi_ ? 2 * sub + 1 : 2 * sub;
#define TOPK_STEP(ctrl) { const float ov = __builtin_bit_cast(float, __builtin_amdgcn_update_dpp(0, __builtin_bit_cast(int, bv), ctrl, 0xf, 0xf, false)); const int oi = __builtin_amdgcn_update_dpp(0, bi, ctrl, 0xf, 0xf, false); \
                            const bool take = (ov > bv) | ((ov == bv) & (oi < bi)); bv = take ? ov : bv; bi = take ? oi : bi; }
                        TOPK_STEP(0xB1) TOPK_STEP(0x4E) TOPK_STEP(0x141) TOPK_STEP(0x140)
#undef TOPK_STEP
                        tvv[k] = bv; tee[k] = bi; l0 = (bi == 2 * sub) ? -3.3e38f : l0; l1 = (bi == 2 * sub + 1) ? -3.3e38f : l1; }
                    if (sub < 4) { float wsum = 0.f, wk = 0.f; int ek = 0;
#pragma unroll
                        for (int k = 0; k < 4; ++k) { const float wv_ = exp_(tvv[k] - tvv[0]); wsum += wv_; if (k == sub) { wk = wv_; ek = tee[k]; } }
                        const int lr = atomicAdd((int*)(hist + ek), 1); sel[tix * 128 + tok * 4 + sub] = ek * 65536 + lr; gsel[tix * 128 + tok * 4 + sub] = wk / wsum; } }
            }
            __syncthreads();
            if (tid < 32) { const int hh = hist[tid]; basee[tid] = hh ? (int)atomicAdd(cntg + 32 * tid, (unsigned)hh) : 0; }
            __syncthreads();
            for (int i = tid; i < tix * 128; i += NTHR) { const int sv = sel[i], e = sv >> 16, rank = basee[e] + (sv & 65535); const int tok = (bid + (i >> 7) * G) * 32 + ((i & 127) >> 2); const int idx = e * ECAP + rank;
                rtok[idx] = tok; rgate[idx] = gsel[i]; tslot[tok * 4 + (i & 3)] = idx; }
            __syncthreads();
        }
        GRID_BAR();
        for (int rep_ = 0; rep_ < REPS(PH_MOE1); ++rep_) if (IN(PH_MOE1)) {
            if (rep_) GRID_BAR();
            PHASE_ENV();
            MOE_TABLES((const int*)ctl + CW_SGU + l * NE);
            ProbMoe1 p; p.X = x1q; p.Wgu = wguq + (size_t)l * NE * 2048 * D; p.bgu = A->in[I_BGU] + (size_t)l * NE * 2048; p.hid = hid; p.rtok = rtok; p.tb.cnt = tabcnt; p.tb.pblk = tabpblk; p.tb.scl = tabscl; p.tb.eb = tabeb; p.G = G; p.c = bid;
            pg8::gemm_phase(lds, p);
        }
        GRID_BAR();
        for (int rep_ = 0; rep_ < REPS(PH_MOE2); ++rep_) if (IN(PH_MOE2)) {
            if (rep_) GRID_BAR();
            PHASE_ENV();
            MOE_TABLES((const int*)ctl + CW_SDN + l * NE);
            ProbMoe2 p; p.hid = hid; p.Wdn = wdnq + (size_t)l * NE * D * DE; p.bdn = A->in[I_BDN] + (size_t)l * NE * D; p.ys = ysl; p.rgate = rgate; p.tb.cnt = tabcnt; p.tb.pblk = tabpblk; p.tb.scl = tabscl; p.tb.eb = tabeb; p.G = G; p.c = bid;
            pg8::gemm_phase(lds, p);
        }
        GRID_BAR();
        for (int rep_ = 0; rep_ < REPS(PH_LN2); ++rep_) if (IN(PH_LN2)) {
            if (rep_) GRID_BAR();
            PHASE_ENV();
            MOE_TABLES((const int*)nullptr);
            const float* g2 = A->in[I_LN2G] + (size_t)l * D; const float* b2 = A->in[I_LN2B] + (size_t)l * D;
            typedef int i32x4 __attribute__((ext_vector_type(4)));
            const int c0 = lane * 16; const int rstep = NGW;
#define LN2_CL(rp) ((rp) < T ? (rp) : T - 1)
#define LN2_TS(rp, TS) do { TS = *(const i32x4*)(tslot + (size_t)LN2_CL(rp) * 4); } while (0)
#define LN2_LOAD(rp, TS, YV, XV, GK) do { _Pragma("unroll") for (int k = 0; k < 4; ++k) { const int idx = TS[k]; GK[k] = rgate[idx]; const int e = idx >> 15, rank = idx & (ECAP - 1); \
                        YV[k] = *(const u32x4*)(ysl + (size_t)(tabpblk[e] * 256 + rank) * D + lane * 16); } \
                    XV[0] = *(const u32x4*)(x1b + (size_t)LN2_CL(rp) * D + lane * 16); XV[1] = *(const u32x4*)(x1b + (size_t)LN2_CL(rp) * D + lane * 16 + 8); } while (0)
#define LN2_COMPUTE(rp, YV, XV, GK_) do { const int row = (rp); float v[16]; float s_ = 0.f; const float GK[4] = {GK_[0] * (1.0f / YS_SCALE), GK_[1] * (1.0f / YS_SCALE), GK_[2] * (1.0f / YS_SCALE), GK_[3] * (1.0f / YS_SCALE)}; \
                    _Pragma("unroll") for (int q = 0; q < 4; ++q) { float m0 = 0.f, m1 = 0.f, m2 = 0.f, m3 = 0.f; \
                        _Pragma("unroll") for (int k = 0; k < 4; ++k) { const f32x2 lo2 = __builtin_amdgcn_cvt_pk_f32_fp8((int)YV[k][q], false), hi2 = __builtin_amdgcn_cvt_pk_f32_fp8((int)YV[k][q], true); \
                            m0 += GK[k] * lo2[0]; m1 += GK[k] * lo2[1]; m2 += GK[k] * hi2[0]; m3 += GK[k] * hi2[1]; } \
                        const unsigned xa = XV[q >> 1][(q & 1) * 2], xb_ = XV[q >> 1][(q & 1) * 2 + 1]; \
                        v[4 * q] = bf2f(xa & 0xffffu) * ALPHA + m0; v[4 * q + 1] = bf2f(xa >> 16) * ALPHA + m1; v[4 * q + 2] = bf2f(xb_ & 0xffffu) * ALPHA + m2; v[4 * q + 3] = bf2f(xb_ >> 16) * ALPHA + m3; \
                        s_ += (v[4 * q] + v[4 * q + 1]) + (v[4 * q + 2] + v[4 * q + 3]); } \
                    const float mean = wave_sum(s_) * (1.f / D); float s2 = 0.f; \
                    _Pragma("unroll") for (int q = 0; q < 16; ++q) { v[q] -= mean; s2 += v[q] * v[q]; } \
                    const float rstd = rsqf_(wave_sum(s2) * (1.f / D) + LN_EPS); float o[16]; \
                    _Pragma("unroll") for (int q4 = 0; q4 < 4; ++q4) { const f32x4 gg = g2r[q4], bb = b2r[q4]; _Pragma("unroll") for (int i = 0; i < 4; ++i) o[4 * q4 + i] = v[4 * q4 + i] * rstd * gg[i] + bb[i]; } \
                    if (l == NL - 1) { _Pragma("unroll") for (int q4 = 0; q4 < 4; ++q4) *(f32x4*)(A->out + (size_t)row * D + c0 + 4 * q4) = (f32x4){o[4 * q4], o[4 * q4 + 1], o[4 * q4 + 2], o[4 * q4 + 3]}; } \
                    else { *(u32x4*)(xb + (size_t)row * D + c0) = (u32x4){pk2(o[0], o[1]), pk2(o[2], o[3]), pk2(o[4], o[5]), pk2(o[6], o[7])}; *(u32x4*)(xb + (size_t)row * D + c0 + 8) = (u32x4){pk2(o[8], o[9]), pk2(o[10], o[11]), pk2(o[12], o[13]), pk2(o[14], o[15])}; \
                        int q4_[4]; _Pragma("unroll") for (int qq = 0; qq < 4; ++qq) { int t_ = 0; t_ = __builtin_amdgcn_cvt_pk_fp8_f32(o[4 * qq], o[4 * qq + 1], t_, false); t_ = __builtin_amdgcn_cvt_pk_fp8_f32(o[4 * qq + 2], o[4 * qq + 3], t_, true); q4_[qq] = t_; } \
                        *(u32x4*)(xq + (size_t)row * D + c0) = (u32x4){(unsigned)q4_[0], (unsigned)q4_[1], (unsigned)q4_[2], (unsigned)q4_[3]}; } } while (0)
            f32x4 g2r[4], b2r[4];
#pragma unroll
            for (int q4 = 0; q4 < 4; ++q4) { g2r[q4] = *(const f32x4*)(g2 + c0 + 4 * q4); b2r[q4] = *(const f32x4*)(b2 + c0 + 4 * q4); }
            int rowp = gw;
            i32x4 tsA0, tsA1, tsB0, tsB1;
            u32x4 yvA0[4], xvA0[2], yvA1[4], xvA1[2], yvB0[4], xvB0[2], yvB1[4], xvB1[2]; float gkA0[4], gkA1[4], gkB0[4], gkB1[4];
            LN2_TS(rowp, tsA0); LN2_TS(rowp + rstep, tsA1); LN2_TS(rowp + 2 * rstep, tsB0); LN2_TS(rowp + 3 * rstep, tsB1);
            LN2_LOAD(rowp, tsA0, yvA0, xvA0, gkA0);
            LN2_LOAD(rowp + rstep, tsA1, yvA1, xvA1, gkA1);
            for (; rowp < T; rowp += 4 * rstep) {
                LN2_LOAD(rowp + 2 * rstep, tsB0, yvB0, xvB0, gkB0);
                LN2_LOAD(rowp + 3 * rstep, tsB1, yvB1, xvB1, gkB1);
                LN2_TS(rowp + 4 * rstep, tsA0); LN2_TS(rowp + 5 * rstep, tsA1);
                LN2_COMPUTE(rowp, yvA0, xvA0, gkA0);
                if (rowp + rstep < T) LN2_COMPUTE(rowp + rstep, yvA1, xvA1, gkA1);
                LN2_LOAD(rowp + 4 * rstep, tsA0, yvA0, xvA0, gkA0);
                LN2_LOAD(rowp + 5 * rstep, tsA1, yvA1, xvA1, gkA1);
                LN2_TS(rowp + 6 * rstep, tsB0); LN2_TS(rowp + 7 * rstep, tsB1);
                if (rowp + 2 * rstep < T) LN2_COMPUTE(rowp + 2 * rstep, yvB0, xvB0, gkB0);
                if (rowp + 3 * rstep < T) LN2_COMPUTE(rowp + 3 * rstep, yvB1, xvB1, gkB1);
            }
#undef LN2_TS
#undef LN2_CL
#undef LN2_LOAD
#undef LN2_COMPUTE
        }
        if (l + 1 < l_hi) GRID_BAR();
#undef IN
    }
}

extern "C" void kernel_launch(void* const* d_in, const int* in_sizes, int n_in, void* d_out, int out_size, void* d_ws, size_t ws_size, hipStream_t stream) {
    static int grid = 0;
    if (grid == 0) {
        if (n_in != 23 || out_size != T * D || ws_size < WS_END) { fprintf(stderr, "kernel_launch: unexpected shapes (n_in %d, out %d, ws %zu)\n", n_in, out_size, ws_size); grid = -1; return; }
        int dev = 0, cus = 0;
        if (hipGetDevice(&dev) != hipSuccess || hipDeviceGetAttribute(&cus, hipDeviceAttributeMultiprocessorCount, dev) != hipSuccess) { grid = -1; return; }
        bool ok = true;
#define SETA(k) ok = ok && (hipFuncSetAttribute((const void*)mk_fwd<k>, hipFuncAttributeMaxDynamicSharedMemorySize, LDS_BYTES) == hipSuccess)
        SETA(0); SETA(-1); SETA(PH_PROJ); SETA(PH_HG); SETA(PH_LRUAU); SETA(PH_COMB); SETA(PH_OUTG); SETA(PH_LN1R); SETA(PH_MOE1); SETA(PH_MOE2); SETA(PH_LN2);
#undef SETA
        if (!ok) { fprintf(stderr, "kernel_launch: hipFuncSetAttribute failed\n"); grid = -1; return; }
        (void)hipGetLastError();
        grid = cus;
    }
    if (grid < 0) return;
    (void)hipMemsetAsync((char*)d_ws + WS_CTL, 0, CTL_BYTES, stream);
    Args a{};
    for (int i = 0; i < 23; ++i) a.in[i] = (const float*)d_in[i];
    a.out = (float*)d_out; a.ws = (unsigned char*)d_ws;
    a.l_lo = 0; a.l_hi = NL; a.ph_lo = 0; a.ph_hi = PH_END; a.pro = 1; a.pad = 0;
#ifdef MULTI_LAUNCH
    hipLaunchKernelGGL(mk_fwd<-1>, dim3(grid), dim3(NTHR), LDS_BYTES, stream, a);
    for (int l = 0; l < NL; ++l) {
        a.l_lo = l; a.l_hi = l + 1;
        hipLaunchKernelGGL(mk_fwd<PH_PROJ>, dim3(grid), dim3(NTHR), LDS_BYTES, stream, a);
        hipLaunchKernelGGL(mk_fwd<PH_HG>, dim3(grid), dim3(NTHR), LDS_BYTES, stream, a);
        hipLaunchKernelGGL(mk_fwd<PH_LRUAU>, dim3(grid), dim3(NTHR), LDS_BYTES, stream, a);
        hipLaunchKernelGGL(mk_fwd<PH_COMB>, dim3(grid), dim3(NTHR), LDS_BYTES, stream, a);
        hipLaunchKernelGGL(mk_fwd<PH_OUTG>, dim3(grid), dim3(NTHR), LDS_BYTES, stream, a);
        hipLaunchKernelGGL(mk_fwd<PH_LN1R>, dim3(grid), dim3(NTHR), LDS_BYTES, stream, a);
        hipLaunchKernelGGL(mk_fwd<PH_MOE1>, dim3(grid), dim3(NTHR), LDS_BYTES, stream, a);
        hipLaunchKernelGGL(mk_fwd<PH_MOE2>, dim3(grid), dim3(NTHR), LDS_BYTES, stream, a);
        hipLaunchKernelGGL(mk_fwd<PH_LN2>, dim3(grid), dim3(NTHR), LDS_BYTES, stream, a);
    }
#else
    hipLaunchKernelGGL(mk_fwd<0>, dim3(grid), dim3(NTHR), LDS_BYTES, stream, a);
#endif
}
```

```cpp
#include <hip/hip_runtime.h>
#include <cstdio>
#include <cstdint>

#define GAS __attribute__((address_space(1)))
#define LAS __attribute__((address_space(3)))
typedef unsigned short bf16_t;
typedef short bf16x8 __attribute__((ext_vector_type(8)));
typedef float f32x4 __attribute__((ext_vector_type(4)));
typedef float f32x2 __attribute__((ext_vector_type(2)));
typedef unsigned u32x4 __attribute__((ext_vector_type(4)));
typedef unsigned u32x2 __attribute__((ext_vector_type(2)));

constexpr int BATCH = 8, SEQ = 4096, D = 1024, T = BATCH * SEQ, NL = 4;
constexpr int HGW = 512, LRW = 512, HGH = 4, HD = 128, LRH = 8, LHD = 64;
constexpr int INC = 3584, NE = 32, TOPK = 4, DE = 1024;
constexpr int ECAP = 32768;
constexpr int NSLOT = T * TOPK + NE * 256;
constexpr float ALPHA = 1.6817928305074290f;
constexpr float LN_EPS = 1e-5f, RMS_EPS = 1e-6f;
constexpr int NWAVES = 8, NTHR = 512;
constexpr int LDS_BYTES = 147456;

constexpr size_t MiB = 1u << 20;
constexpr size_t WS_CTL = 0, CTL_BYTES = 1 * MiB;
constexpr size_t WS_LBT = 1 * MiB;
constexpr size_t WS_RWH = 2 * MiB, WS_RWL = 3 * MiB;
constexpr size_t WS_WIN = 4 * MiB;
constexpr size_t WS_WOUT = 32 * MiB;
constexpr size_t WS_WGU = 40 * MiB;
constexpr size_t WS_WDN = 552 * MiB;
constexpr size_t WS_XB = 808 * MiB;
constexpr size_t WS_XRES = 872 * MiB;
constexpr size_t WS_PROJ = 1000 * MiB;
constexpr size_t WS_MIX = 1224 * MiB;
constexpr size_t WS_Y = 1288 * MiB;
constexpr size_t WS_X1 = 1416 * MiB;
constexpr size_t WS_X1B = 1544 * MiB;
constexpr size_t WS_HID = 1608 * MiB;
constexpr size_t WS_YS = 1880 * MiB;
constexpr size_t WS_RTOK = 2152 * MiB;
constexpr size_t WS_RGATE = 2156 * MiB;
constexpr size_t WS_TSLOT = 2160 * MiB;
constexpr size_t WS_ODIR = 2162 * MiB;
constexpr size_t WS_HDIR = 2290 * MiB;
constexpr size_t WS_AU = 2418 * MiB;
constexpr size_t WS_SFIN = 2674 * MiB;
constexpr size_t WS_DSEG = 2690 * MiB;
constexpr size_t WS_LSUM = 2691 * MiB;
constexpr size_t WS_LRUW = 2696 * MiB;
constexpr size_t WS_END = 2700 * MiB;
constexpr size_t WS_OLOC = WS_ODIR, WS_QSEG = WS_ODIR + 64 * MiB;
constexpr size_t WS_XQ = WS_XRES, WS_WINQ = WS_XRES + 64 * MiB;
constexpr size_t WS_X1Q = WS_X1;
constexpr int CW_CNT = 16384, CW_SGU = 2048, CW_SDN = 2304, CW_SIN = 2560, CW_BAR = 8192;

#define LDS_WAIT() asm volatile("s_waitcnt lgkmcnt(0)" ::: "memory")
typedef __bf16 bf16x2_t __attribute__((ext_vector_type(2)));
__device__ __forceinline__ unsigned pk2(float lo, float hi) { bf16x2_t v; v[0] = (__bf16)lo; v[1] = (__bf16)hi; return __builtin_bit_cast(unsigned, v); }
__device__ __forceinline__ unsigned f2bf(float f) { return pk2(f, 0.f) & 0xffffu; }
__device__ __forceinline__ float bf2f(unsigned b) { return __builtin_bit_cast(float, b << 16); }
__device__ __forceinline__ float wave_sum(float v) {
#pragma unroll
    for (int o = 1; o < 64; o <<= 1) v += __shfl_xor(v, o);
    return v;
}
__device__ __forceinline__ float rcpf_(float x) { return __builtin_amdgcn_rcpf(x); }
__device__ __forceinline__ float rsqf_(float x) { return __builtin_amdgcn_rsqf(x); }
__device__ __forceinline__ float exp_(float x) { return __builtin_amdgcn_exp2f(x * 1.4426950408889634f); }
__device__ __forceinline__ float log_(float x) { return __builtin_amdgcn_logf(x) * 0.6931471805599453f; }
__device__ __forceinline__ float sigmoidf_(float z) { return rcpf_(1.0f + __builtin_amdgcn_exp2f(z * -1.4426950408889634f)); }
__device__ __forceinline__ float gelu_tanh_(float z) { return z * sigmoidf_(1.5957691216057308f * (z + 0.044715f * z * z * z)); }

namespace pg8 {
constexpr int BM = 256, BK = 64, HALF = 128, HTB = HALF * BK * 2, STAGE_BYTES = 8 * HTB, NXCD = 8, WGM = 8;
constexpr int KD = 1024;
__host__ __device__ __forceinline__ int lds_byte(int r, int c) { const int st = (r >> 4) * 2 + (c >> 5), rr = r & 15, cc = c & 31, ob = rr * 64 + cc * 2; return st * 1024 + (ob ^ (((ob >> 9) & 1) << 5)); }
__host__ __device__ __forceinline__ void stage_rc(int b, int& R, int& C) { const int st = b / 1024, sb = b % 1024, swz = sb ^ (((sb >> 9) & 1) << 5); R = (st >> 1) * 16 + swz / 64; C = (st & 1) * 32 + (swz % 64) / 2; }
__host__ __device__ __forceinline__ int perm32(int rho) { const int n = rho >> 4, i = rho & 15; return 8 * (i >> 2) + 4 * n + (i & 3); }
struct Unit { int pm, pn, e, j; };
typedef int i32x8 __attribute__((ext_vector_type(8)));
__device__ __forceinline__ i32x8 cat8(bf16x8 a, bf16x8 b) { const u32x4 x = __builtin_bit_cast(u32x4, a), y = __builtin_bit_cast(u32x4, b); return (i32x8){(int)x[0], (int)x[1], (int)x[2], (int)x[3], (int)y[0], (int)y[1], (int)y[2], (int)y[3]}; }
__device__ __forceinline__ unsigned cvt_pk_bf16(float lo, float hi) { return pk2(lo, hi); }

struct StaticOrder {
    int nM, nN, nwg, G, c;
    __device__ void init(int M, int N, int G_, int c_) { nM = M / BM; nN = N / BM; nwg = nM * nN; G = G_; c = c_; }
    __device__ bool next(int i, Unit& u) const {
        const long L = (long)i * G + c; if (L >= nwg) return false;
        int wgid = (int)L; { const int q = nwg / NXCD, r = nwg % NXCD, xcd = wgid % NXCD, off = wgid / NXCD; wgid = (xcd < r ? xcd * (q + 1) : r * (q + 1) + (xcd - r) * q) + off; }
        const int nig = WGM * nN, gid = wgid / nig, fm = gid * WGM, gsz = (nM - fm) < WGM ? (nM - fm) : WGM;
        u.pm = fm + ((wgid % nig) % gsz); u.pn = (wgid % nig) / gsz; u.e = 0; u.j = 0; return true;
    }
};

template <class P>
__device__ __forceinline__ void gemm_phase(LAS unsigned char* lds, const P& p) {
    int tid_l = (int)threadIdx.x; asm volatile("" : "+v"(tid_l));
    const int tid = tid_l, wid = __builtin_amdgcn_readfirstlane(tid >> 6), lane = tid & 63, wr = wid >> 2, wc = wid & 3, fr = lane & 15, fq = lane >> 4;
    constexpr int RB = P::FP8 ? KD : 2 * KD;
    constexpr int nt = RB / 128;
    unsigned voffB[2];
#pragma unroll
    for (int i = 0; i < 2; ++i) { int R, C; stage_rc(tid * 16 + i * 8192, R, C); const int r32_ = R & 31;
        const int Rb = P::WIDE ? (64 * (R >> 5) + 16 * ((r32_ & 15) >> 2) + 4 * (r32_ >> 4) + (r32_ & 3))
                             : (P::PERM ? ((R & ~31) + perm32(r32_)) : R);
        voffB[i] = (unsigned)(Rb * RB + C * 2); }
    constexpr unsigned hstepB = (unsigned)(P::WIDE ? 8 : HALF) * RB;
    const unsigned ldsw = (unsigned)wid * 1024u;
    const int aoff = lds_byte(wr * 64 + fr, fq * 8), boff = lds_byte(wc * 32 + fr, fq * 8);
    const char* const abase = p.a_base();
#define PG8_SA(b, h) (((b) * 2 + (h)) * HTB)
#define PG8_SB(b, h) ((4 + (b) * 2 + (h)) * HTB)
#define PG8_STAGE_A(bufoff, o, koff) do { _Pragma("unroll") for (int _i = 0; _i < 2; ++_i) \
        __builtin_amdgcn_global_load_lds((const unsigned*)(abase + (size_t)(o)[_i] + (koff)), (LAS unsigned*)(lds + (bufoff) + ldsw + _i * 8192), 16, 0, 0); } while (0)
#define PG8_STAGE_B(bufoff, gbase, koff) do { _Pragma("unroll") for (int _i = 0; _i < 2; ++_i) \
        __builtin_amdgcn_global_load_lds((const unsigned*)((gbase) + (size_t)(voffB[_i] + (koff))), (LAS unsigned*)(lds + (bufoff) + ldsw + _i * 8192), 16, 0, 0); } while (0)
#define PG8_LDA(dst, b, h) do { _Pragma("unroll") for (int m = 0; m < 4; ++m) _Pragma("unroll") for (int k = 0; k < 2; ++k) dst[m][k] = *(const LAS bf16x8*)(lds + PG8_SA(b, h) + aoff + m * 2048 + k * 1024); } while (0)
#define PG8_LDB(dst, b, h) do { _Pragma("unroll") for (int n = 0; n < 2; ++n) _Pragma("unroll") for (int k = 0; k < 2; ++k) dst[n][k] = *(const LAS bf16x8*)(lds + PG8_SB(b, h) + boff + n * 2048 + k * 1024); } while (0)
#define PG8_MMA(ai, bj, At, Bt) do { __builtin_amdgcn_s_setprio(1); _Pragma("unroll") for (int m = 0; m < 4; ++m) _Pragma("unroll") for (int n = 0; n < 2; ++n) { \
        if constexpr (P::FP8) { const i32x8 b8_ = cat8(Bt[n][0], Bt[n][1]), a8_ = cat8(At[m][0], At[m][1]); \
            asm volatile("v_mfma_scale_f32_16x16x128_f8f6f4 %0, %1, %2, %0, %3, %4 op_sel_hi:[0,0,0]" : "+v"(acc[ai][bj][m][n]) : "v"(b8_), "v"(a8_), "v"(sclW), "v"(sclX)); } \
        else { _Pragma("unroll") for (int k = 0; k < 2; ++k) acc[ai][bj][m][n] = __builtin_amdgcn_mfma_f32_16x16x32_bf16(Bt[n][k], At[m][k], acc[ai][bj][m][n], 0, 0, 0); } } __builtin_amdgcn_s_setprio(0); } while (0)
#define PG8_WAIT_V(n) asm volatile("s_waitcnt vmcnt(" #n ")" ::: "memory")
#define PG8_WAIT_L(n) asm volatile("s_waitcnt lgkmcnt(" #n ")" ::: "memory")
#define PG8_BAR __builtin_amdgcn_s_barrier()
#define PG8_SCHED __builtin_amdgcn_sched_barrier(0)
    Unit cur, nxt; int ui = 0; nxt.pm = nxt.pn = nxt.e = nxt.j = 0;
    if (!p.next(0, cur)) return;
    f32x4 acc[2][2][4][2];
#pragma unroll
    for (int a = 0; a < 2; ++a)
#pragma unroll
        for (int b = 0; b < 2; ++b)
#pragma unroll
            for (int m = 0; m < 4; ++m)
#pragma unroll
                for (int n = 0; n < 2; ++n) acc[a][b][m][n] = (f32x4){0.f, 0.f, 0.f, 0.f};
    bf16x8 At[4][2], B0[2][2], B1[2][2];
    unsigned oC[2][2];
    int kN[2][2];
#define PG8_RC(i, R_, C_) int R_, C_; { int t2_ = tid; asm volatile("" : "+v"(t2_)); stage_rc(t2_ * 16 + (i) * 8192, R_, C_); }
    { PG8_RC(0, R0, C0); PG8_RC(1, R1, C1); const int RR[2] = {R0, R1}; p.a_key(cur, RR, kN);
#pragma unroll
      for (int h = 0; h < 2; ++h) { oC[h][0] = (unsigned)(kN[h][0] * RB + C0 * 2); oC[h][1] = (unsigned)(kN[h][1] * RB + C1 * 2); } }
    const char* cB = p.b_base(cur);
    constexpr int BIAS_OFF = STAGE_BYTES + 2048;
    if (P::HAS_BIAS && wid == 0) p.dma_bias(cur, (LAS unsigned*)(lds + BIAS_OFF), lane);
    int sclW = p.scale_w(cur); const int sclX = p.scale_x();
    PG8_STAGE_B(PG8_SB(0, 0), cB, 0u); PG8_STAGE_B(PG8_SB(0, 1), cB + hstepB, 0u); PG8_STAGE_A(PG8_SA(0, 0), oC[0], 0u); PG8_STAGE_A(PG8_SA(0, 1), oC[1], 0u);
    if (wr == 1) PG8_BAR;
    PG8_WAIT_V(2); PG8_BAR;
    PG8_STAGE_B(PG8_SB(1, 0), cB, 128u); PG8_STAGE_A(PG8_SA(1, 0), oC[0], 128u); PG8_STAGE_B(PG8_SB(1, 1), cB + hstepB, 128u);
    PG8_WAIT_V(6); PG8_BAR;
    for (;;) {
        const bool has_next = p.next(ui + 1, nxt);
        const char* nB = cB;
        if (has_next) { PG8_RC(0, R0, C0); PG8_RC(1, R1, C1); (void)C0; (void)C1; const int RR[2] = {R0, R1}; p.a_key(nxt, RR, kN); nB = p.b_base(nxt);
            if (P::HAS_BIAS && wid == 0) p.dma_bias(nxt, (LAS unsigned*)(lds + BIAS_OFF + ((ui + 1) & 1) * 1024), lane); }
#pragma unroll 1
        for (int t = 0; t < nt; t += 2) {
            const bool last = (t == nt - 2);
            const unsigned k1 = (unsigned)(t + 1) * 128u, k2 = last ? 0u : (unsigned)(t + 2) * 128u, k3 = k2 + 128u;
            unsigned o2[2][2];
            if (last) { asm volatile("" : "+v"(kN[0][0]), "+v"(kN[0][1]), "+v"(kN[1][0]), "+v"(kN[1][1])); PG8_RC(0, R0, C0); PG8_RC(1, R1, C1); (void)R0; (void)R1;
#pragma unroll
                for (int h = 0; h < 2; ++h) { o2[h][0] = (unsigned)(kN[h][0] * RB + C0 * 2); o2[h][1] = (unsigned)(kN[h][1] * RB + C1 * 2); } }
            else {
#pragma unroll
                for (int h = 0; h < 2; ++h)
#pragma unroll
                    for (int i = 0; i < 2; ++i) o2[h][i] = oC[h][i]; }
            const char* b2 = last ? nB : cB;
            PG8_LDB(B0, 0, 0); PG8_LDB(B1, 0, 1); PG8_SCHED; PG8_LDA(At, 0, 0); PG8_STAGE_A(PG8_SA(1, 1), oC[1], k1);
            PG8_WAIT_V(8); PG8_WAIT_L(0); PG8_BAR; PG8_MMA(0, 0, At, B0); PG8_MMA(0, 1, At, B1); PG8_BAR; PG8_SCHED;
            PG8_LDA(At, 0, 1); PG8_STAGE_B(PG8_SB(0, 0), b2, k2); PG8_STAGE_B(PG8_SB(0, 1), b2 + hstepB, k2); PG8_STAGE_A(PG8_SA(0, 0), o2[0], k2);
            PG8_WAIT_V(8); PG8_WAIT_L(0); PG8_BAR; PG8_MMA(1, 0, At, B0); PG8_MMA(1, 1, At, B1); PG8_BAR; PG8_SCHED;
            PG8_LDB(B0, 1, 0); PG8_LDB(B1, 1, 1); PG8_SCHED; PG8_LDA(At, 1, 0); PG8_STAGE_A(PG8_SA(0, 1), o2[1], k2);
            PG8_WAIT_V(8); PG8_WAIT_L(0); PG8_BAR; PG8_MMA(0, 0, At, B0); PG8_MMA(0, 1, At, B1); PG8_BAR; PG8_SCHED;
            PG8_LDA(At, 1, 1); PG8_STAGE_B(PG8_SB(1, 0), b2, k3); PG8_STAGE_B(PG8_SB(1, 1), b2 + hstepB, k3); PG8_STAGE_A(PG8_SA(1, 0), o2[0], k3);
            PG8_WAIT_V(8); PG8_WAIT_L(0); PG8_BAR; PG8_MMA(1, 0, At, B0); PG8_MMA(1, 1, At, B1); PG8_BAR; PG8_SCHED;
        }
        if (wr == 0) PG8_BAR;
        if constexpr (P::FP8) asm volatile("s_nop 15\n\ts_nop 7" ::: "memory");
        p.epi(acc, cur, (const LAS float*)(lds + BIAS_OFF + (ui & 1) * 1024), wr, wc, fr, fq);
        if (!has_next) break;
#pragma unroll
        for (int a = 0; a < 2; ++a)
#pragma unroll
            for (int b = 0; b < 2; ++b)
#pragma unroll
                for (int m = 0; m < 4; ++m)
#pragma unroll
                    for (int n = 0; n < 2; ++n) acc[a][b][m][n] = (f32x4){0.f, 0.f, 0.f, 0.f};
        cur = nxt; cB = nB; ++ui; sclW = p.scale_w(cur);
        { PG8_RC(0, R0, C0); PG8_RC(1, R1, C1); (void)R0; (void)R1;
#pragma unroll
          for (int h = 0; h < 2; ++h) { oC[h][0] = (unsigned)(kN[h][0] * RB + C0 * 2); oC[h][1] = (unsigned)(kN[h][1] * RB + C1 * 2); } }
        if (wr == 1) PG8_BAR;
    }
    PG8_WAIT_V(0);
    PG8_BAR;
#undef PG8_RC
#undef PG8_SA
#undef PG8_SB
#undef PG8_STAGE_A
#undef PG8_STAGE_B
#undef PG8_LDA
#undef PG8_LDB
#undef PG8_MMA
#undef PG8_WAIT_V
#undef PG8_WAIT_L
#undef PG8_BAR
#undef PG8_SCHED
}
}

template <bool Q> struct ProbProjT {
    static constexpr bool WIDE = false;
    static constexpr bool HAS_BIAS = false; __device__ __forceinline__ void dma_bias(const pg8::Unit&, LAS unsigned*, int) const {}
    static constexpr bool PERM = true, FP8 = Q;
    __device__ __forceinline__ int scale_w(const pg8::Unit&) const { return (127 - sw) * 0x01010101; }
    __device__ __forceinline__ int scale_x() const { return 0x7f7f7f7f; }
    const void* A; const void* Bt; bf16_t* C; int ldc; int sw; pg8::StaticOrder S;
    __device__ __forceinline__ bool next(int i, pg8::Unit& u) const { return S.next(i, u); }
    __device__ __forceinline__ const char* a_base() const { return (const char*)A; }
    __device__ __forceinline__ void a_key(const pg8::Unit& u, const int (&R)[2], int (&k)[2][2]) const {
#pragma unroll
        for (int h = 0; h < 2; ++h)
#pragma unroll
            for (int i = 0; i < 2; ++i) k[h][i] = u.pm * 256 + h * 128 + R[i];
    }
    __device__ __forceinline__ const char* b_base(const pg8::Unit& u) const { return (const char*)Bt + (size_t)u.pn * 256 * pg8::KD * (Q ? 1 : 2); }
    __device__ __forceinline__ void epi(const f32x4 (&acc)[2][2][4][2], const pg8::Unit& u, const LAS float*, int wr, int wc, int fr, int fq) const {
        const int row0 = u.pm * 256 + wr * 64 + fr, col0 = u.pn * 256 + wc * 32 + 8 * fq;
#pragma unroll
        for (int ai = 0; ai < 2; ++ai)
#pragma unroll
            for (int m = 0; m < 4; ++m) { bf16_t* rowp = C + (size_t)(row0 + ai * 128 + m * 16) * ldc + col0;
#pragma unroll
                for (int bj = 0; bj < 2; ++bj) { const f32x4 v0 = acc[ai][bj][m][0], v1 = acc[ai][bj][m][1];
                    u32x4 w; w.x = pg8::cvt_pk_bf16(v0[0], v0[1]); w.y = pg8::cvt_pk_bf16(v0[2], v0[3]); w.z = pg8::cvt_pk_bf16(v1[0], v1[1]); w.w = pg8::cvt_pk_bf16(v1[2], v1[3]);
                    *(u32x4*)(rowp + bj * 128) = w; } }
    }
};
struct ProbOut {
    static constexpr bool WIDE = false;
    static constexpr bool HAS_BIAS = false; __device__ __forceinline__ void dma_bias(const pg8::Unit&, LAS unsigned*, int) const {}
    static constexpr bool PERM = false, FP8 = false;
    __device__ __forceinline__ int scale_w(const pg8::Unit&) const { return 0; }
    __device__ __forceinline__ int scale_x() const { return 0; }
    const bf16_t* A; const bf16_t* Bt; float* C; pg8::StaticOrder S;
    __device__ __forceinline__ bool next(int i, pg8::Unit& u) const { return S.next(i, u); }
    __device__ __forceinline__ const char* a_base() const { return (const char*)A; }
    __device__ __forceinline__ void a_key(const pg8::Unit& u, const int (&R)[2], int (&k)[2][2]) const {
#pragma unroll
        for (int h = 0; h < 2; ++h)
#pragma unroll
            for (int i = 0; i < 2; ++i) k[h][i] = u.pm * 256 + h * 128 + R[i];
    }
    __device__ __forceinline__ const char* b_base(const pg8::Unit& u) const { return (const char*)Bt + (size_t)u.pn * 256 * pg8::KD * 2; }
    __device__ __forceinline__ void epi(const f32x4 (&acc)[2][2][4][2], const pg8::Unit& u, const LAS float*, int wr, int wc, int fr, int fq) const {
        const int row0 = u.pm * 256 + wr * 64 + fr, col0 = u.pn * 256 + wc * 32 + 4 * fq;
#pragma unroll
        for (int ai = 0; ai < 2; ++ai)
#pragma unroll
            for (int m = 0; m < 4; ++m) { float* rowp = C + (size_t)(row0 + ai * 128 + m * 16) * D + col0;
#pragma unroll
                for (int bj = 0; bj < 2; ++bj)
#pragma unroll
                    for (int n = 0; n < 2; ++n) *(f32x4*)(rowp + bj * 128 + n * 16) = acc[ai][bj][m][n]; }
    }
};
struct MoeTab { const LAS int* cnt; const LAS int* pblk; const LAS int* scl; const LAS unsigned short* eb; };
__device__ __forceinline__ bool moe_next(const MoeTab& tb, int npn, int G, int c, int i, pg8::Unit& u) {
    const int nb = tb.pblk[32]; int blk, pn;
    if (G == 256) {
        const int x = c & 7, q = c >> 3, npnh = npn >> 2, tau = 8 * i + x, sr = tau / npnh, pnh = tau - sr * npnh;
        blk = sr * 8 + (q & 7); pn = pnh * 4 + (q >> 3); if (blk >= nb) return false;
    } else { const long L = (long)i * G + c; if (L >= (long)nb * npn) return false; blk = (int)(L / npn); pn = (int)(L % npn); }
    const int e = tb.eb[blk];
    u.e = __builtin_amdgcn_readfirstlane(e); u.pm = __builtin_amdgcn_readfirstlane(blk); u.pn = __builtin_amdgcn_readfirstlane(pn); u.j = u.pm - tb.pblk[u.e]; u.j = __builtin_amdgcn_readfirstlane(u.j);
    return true;
}
constexpr float YS_SCALE = 8.0f;
constexpr float HID_SCALE = 4.0f; constexpr int HID_SCALE_LOG2 = 2;
struct ProbMoe1 {
    static constexpr bool WIDE = false;
    static constexpr bool HAS_BIAS = true;
    __device__ __forceinline__ void dma_bias(const pg8::Unit& u, LAS unsigned* slot, int lane) const {
        const float* src = bgu + (size_t)u.e * 2048 + u.pn * 128 + (lane < 32 ? 4 * lane : 1024 + 4 * (lane - 32)); __builtin_amdgcn_global_load_lds((const unsigned*)src, slot, 16, 0, 0); }
    static constexpr bool PERM = true, FP8 = true;
    const unsigned char* X; const unsigned char* Wgu; const float* bgu; unsigned char* hid; const int* rtok; MoeTab tb; int G, c;
    __device__ __forceinline__ int scale_w(const pg8::Unit& u) const { return (127 - tb.scl[u.e]) * 0x01010101; }
    __device__ __forceinline__ int scale_x() const { return 0x7f7f7f7f; }
    __device__ __forceinline__ bool next(int i, pg8::Unit& u) const { return moe_next(tb, 8, G, c, i, u); }
    __device__ __forceinline__ const char* a_base() const { return (const char*)X; }
    __device__ __forceinline__ void a_key(const pg8::Unit& u, const int (&R)[2], int (&k)[2][2]) const {
        const int n1 = tb.cnt[u.e] - 1;
#pragma unroll
        for (int h = 0; h < 2; ++h)
#pragma unroll
            for (int i = 0; i < 2; ++i) { const int rank = u.j * 256 + h * 128 + R[i]; k[h][i] = rtok[u.e * ECAP + (rank < n1 ? rank : n1)]; }
    }
    __device__ __forceinline__ const char* b_base(const pg8::Unit& u) const { return (const char*)Wgu + ((size_t)u.e * 2048 + (size_t)u.pn * 256) * pg8::KD; }
    __device__ __forceinline__ void epi(const f32x4 (&acc)[2][2][4][2], const pg8::Unit& u, const LAS float* bs, int wr, int wc, int fr, int fq) const {
        const int row0 = u.pm * 256 + wr * 64 + fr, col0 = u.pn * 128 + wc * 32 + 8 * fq; const int cl = wc * 32 + 8 * fq;
        const f32x4 bg0 = *(const LAS f32x4*)(bs + cl), bg1 = *(const LAS f32x4*)(bs + cl + 4), bu0 = *(const LAS f32x4*)(bs + 128 + cl), bu1 = *(const LAS f32x4*)(bs + 128 + cl + 4);
#pragma unroll
        for (int ai = 0; ai < 2; ++ai)
#pragma unroll
            for (int m = 0; m < 4; ++m) {
                float hv[8];
#pragma unroll
                for (int n = 0; n < 2; ++n) { const f32x4 g4 = acc[ai][0][m][n] + (n ? bg1 : bg0), u4 = acc[ai][1][m][n] + (n ? bu1 : bu0);
#pragma unroll
                    for (int q = 0; q < 4; q += 2) {
                        f32x2 g = {fminf(g4[q], 7.0f), fminf(g4[q + 1], 7.0f)}, up = {__builtin_amdgcn_fmed3f(u4[q], -7.0f, 7.0f), __builtin_amdgcn_fmed3f(u4[q + 1], -7.0f, 7.0f)};
                        const f32x2 ar = g * (f32x2){-1.702f * 1.4426950408889634f, -1.702f * 1.4426950408889634f};
                        f32x2 den = {__builtin_amdgcn_exp2f(ar[0]), __builtin_amdgcn_exp2f(ar[1])}; den = den + (f32x2){1.0f, 1.0f};
                        const f32x2 sg = {__builtin_amdgcn_rcpf(den[0]), __builtin_amdgcn_rcpf(den[1])};
                        const f32x2 r = (up * (f32x2){HID_SCALE, HID_SCALE} + (f32x2){HID_SCALE, HID_SCALE}) * (g * sg);
                        hv[n * 4 + q] = r[0]; hv[n * 4 + q + 1] = r[1]; } }
                int w0 = 0, w1 = 0;
                w0 = __builtin_amdgcn_cvt_pk_fp8_f32(hv[0], hv[1], w0, false); w0 = __builtin_amdgcn_cvt_pk_fp8_f32(hv[2], hv[3], w0, true);
                w1 = __builtin_amdgcn_cvt_pk_fp8_f32(hv[4], hv[5], w1, false); w1 = __builtin_amdgcn_cvt_pk_fp8_f32(hv[6], hv[7], w1, true);
                *(u32x2*)(hid + (size_t)(row0 + ai * 128 + m * 16) * DE + col0) = (u32x2){(unsigned)w0, (unsigned)w1}; }
    }
};
struct ProbMoe2 {
    static constexpr bool WIDE = true;
    static constexpr bool HAS_BIAS = true;
    __device__ __forceinline__ void dma_bias(const pg8::Unit& u, LAS unsigned* slot, int lane) const { __builtin_amdgcn_global_load_lds((const unsigned*)(bdn + (size_t)u.e * 1024 + u.pn * 256 + 4 * lane), slot, 16, 0, 0); }
    static constexpr bool PERM = true, FP8 = true;
    const unsigned char* hid; const unsigned char* Wdn; const float* bdn; unsigned char* ys; const float* rgate; MoeTab tb; int G, c;
    __device__ __forceinline__ int scale_w(const pg8::Unit& u) const { return (127 - tb.scl[u.e]) * 0x01010101; }
    __device__ __forceinline__ int scale_x() const { return (127 - HID_SCALE_LOG2) * 0x01010101; }
    __device__ __forceinline__ bool next(int i, pg8::Unit& u) const { return moe_next(tb, 4, G, c, i, u); }
    __device__ __forceinline__ const char* a_base() const { return (const char*)hid; }
    __device__ __forceinline__ void a_key(const pg8::Unit& u, const int (&R)[2], int (&k)[2][2]) const {
#pragma unroll
        for (int h = 0; h < 2; ++h)
#pragma unroll
            for (int i = 0; i < 2; ++i) k[h][i] = u.pm * 256 + h * 128 + R[i];
    }
    __device__ __forceinline__ const char* b_base(const pg8::Unit& u) const { return (const char*)Wdn + ((size_t)u.e * 1024 + (size_t)u.pn * 256) * pg8::KD; }
    __device__ __forceinline__ void epi(const f32x4 (&acc)[2][2][4][2], const pg8::Unit& u, const LAS float* bs, int wr, int wc, int fr, int fq) const {
        const int row0 = u.pm * 256 + wr * 64 + fr, col0 = u.pn * 256 + wc * 64 + 16 * fq; const int cl = wc * 64 + 16 * fq;
        f32x4 bv[2][2];
#pragma unroll
        for (int bj = 0; bj < 2; ++bj)
#pragma unroll
            for (int n = 0; n < 2; ++n) bv[bj][n] = *(const LAS f32x4*)(bs + cl + 8 * bj + 4 * n) * YS_SCALE;
#pragma unroll
        for (int ai = 0; ai < 2; ++ai)
#pragma unroll
            for (int m = 0; m < 4; ++m) { int w4[4];
#pragma unroll
                for (int bj = 0; bj < 2; ++bj)
#pragma unroll
                    for (int n = 0; n < 2; ++n) { const f32x4 v = acc[ai][bj][m][n] * YS_SCALE + bv[bj][n]; int t_ = 0; t_ = __builtin_amdgcn_cvt_pk_fp8_f32(v[0], v[1], t_, false); t_ = __builtin_amdgcn_cvt_pk_fp8_f32(v[2], v[3], t_, true); w4[bj * 2 + n] = t_; }
                *(u32x4*)(ys + (size_t)(row0 + ai * 128 + m * 16) * D + col0) = (u32x4){(unsigned)w4[0], (unsigned)w4[1], (unsigned)w4[2], (unsigned)w4[3]}; }
    }
};

constexpr int HA_QH = 0, HA_KH = 8704, HA_QT = 17408, HA_KT = 26112, HA_VT = 36352, HA_DEC = 46592, HA_OPB = 47104;
constexpr int HA_ST = 2 * HA_OPB, HA_P = HA_ST + 34816, HA_TOT = HA_P + 2560;
__device__ __forceinline__ void hg_phase_a(LAS unsigned char* lds, int item, int l, const bf16_t* proj, const float* lbt, bf16_t* oloc, bf16_t* qseg, float* sfin, float* dseg) {
    int tid_l = (int)threadIdx.x; asm volatile("" : "+v"(tid_l));
    const int tid = tid_l, lane = tid & 63, w = __builtin_amdgcn_readfirstlane(tid >> 6), fr = lane & 15, fq = lane >> 4;
    const int seg = item & 3, dir = (item >> 2) & 1, h = (item >> 3) & 3, b = item >> 5;
    const int d0 = 2 * lane;
    const f32x2 lb2 = *(const f32x2*)(lbt + (size_t)l * 2 * HGW + dir * HGW + h * 128 + d0); const f32x2 omlb2 = (f32x2){1.0f, 1.0f} - lb2;
    LAS float* tot = (LAS float*)(lds + HA_TOT);
    __syncthreads();
    { unsigned z_ = 0u; asm volatile("" : "+v"(z_));
      for (int i = tid; i < 34816 / 16; i += NTHR) *(LAS u32x4*)(lds + HA_ST + i * 16) = (u32x4){z_, z_, z_, z_}; }
    f32x4 accS[8];
#pragma unroll
    for (int i = 0; i < 8; ++i) accS[i] = (f32x4){0.f, 0.f, 0.f, 0.f};
    float Gc[2] = {0.f, 0.f};
    unsigned rq[4], ri[4], rf[4];
    float cs[2][4], kk[2][4], qq[2][4]; unsigned vv[4];
    const unsigned colq2_ = (unsigned)(h * 128 + d0) * 2u;
    const unsigned oloff_ = ((unsigned)(dir ? 15 - fr : fr) * (unsigned)HGW + (unsigned)(h * 128 + w * 16 + 4 * fq)) * 2u;
#define HG_ROW(c, p) ((unsigned)(b * SEQ + (dir ? (SEQ - 1 - (seg * 1024 + (c) * 32 + (p))) : (seg * 1024 + (c) * 32 + (p)))))
#define HG_LOAD(c) do { unsigned colq2 = colq2_; asm volatile("" : "+v"(colq2)); _Pragma("unroll") for (int i = 0; i < 4; ++i) { const char* rp_ = (const char*)proj + (size_t)HG_ROW(c, 4 * w + i) * (INC * 2); const char* rpf_ = rp_ + (size_t)dir * 1024; \
            rq[i] = *(const unsigned*)(rp_ + colq2); ri[i] = *(const unsigned*)(rp_ + (colq2 + 1024u)); rf[i] = *(const unsigned*)(rpf_ + (colq2 + 2048u)); } } while (0)
#define HG_E1() do { f32x2 run2; _Pragma("unroll") for (int e = 0; e < 2; ++e) { float run = 0.f; const float lb = lb2[e], omlb = omlb2[e]; \
            _Pragma("unroll") for (int i = 0; i < 4; ++i) { const float z = e ? bf2f(rf[i] >> 16) : bf2f(rf[i] & 0xffffu), sg = sigmoidf_(z); const float f = lb + omlb * sg; run += log_(f); cs[e][i] = run; kk[e][i] = omlb * (1.0f - sg); \
                const float zq = e ? bf2f(rq[i] >> 16) : bf2f(rq[i] & 0xffffu); qq[e][i] = zq * sigmoidf_(zq); } run2[e] = run; } \
            _Pragma("unroll") for (int i = 0; i < 4; ++i) vv[i] = ri[i]; *(LAS f32x2*)(tot + w * 128 + d0) = run2; } while (0)
#define HG_E2(c, ob) do { unsigned colq2 = colq2_; asm volatile("" : "+v"(colq2)); f32x2 off = {0.f, 0.f}, gref = {0.f, 0.f}, glast = {0.f, 0.f}; \
          _Pragma("unroll") for (int g_ = 0; g_ < 8; ++g_) { const f32x2 t_ = *(const LAS f32x2*)(tot + g_ * 128 + d0); if (g_ < w) off += t_; if (g_ < 4) gref += t_; glast += t_; } \
          float egref[2], eglr[2], egc[2]; _Pragma("unroll") for (int e = 0; e < 2; ++e) { egref[e] = exp_(gref[e]); eglr[e] = exp_(glast[e] - gref[e]); egc[e] = exp_(gref[e] + Gc[e]); } \
          float kt[2][4]; \
          _Pragma("unroll") for (int i = 0; i < 4; ++i) { const int p = 4 * w + i; float qh[2], kh[2]; \
              _Pragma("unroll") for (int e = 0; e < 2; ++e) { const float g = off[e] + cs[e][i]; const float e1 = exp_(g - gref[e]), e2 = rcpf_(e1); qh[e] = qq[e][i] * e1; kh[e] = kk[e][i] * e2; kt[e][i] = kh[e] * eglr[e]; } \
              *(LAS unsigned*)(lds + (ob) + HA_QH + p * 272 + d0 * 2) = pk2(qh[0], qh[1]); *(LAS unsigned*)(lds + (ob) + HA_KH + p * 272 + d0 * 2) = pk2(kh[0], kh[1]); \
              *(LAS unsigned*)(lds + (ob) + HA_QT + p * 272 + d0 * 2) = pk2(qh[0] * egref[0], qh[1] * egref[1]); *(unsigned*)((char*)qseg + (size_t)((unsigned)dir * T + HG_ROW(c, p)) * (HGW * 2) + colq2) = pk2(qh[0] * egc[0], qh[1] * egc[1]); } \
          _Pragma("unroll") for (int e = 0; e < 2; ++e) { \
              *(LAS u32x2*)(lds + (ob) + HA_KT + (d0 + e) * 80 + w * 8) = (u32x2){pk2(kt[e][0], kt[e][1]), pk2(kt[e][2], kt[e][3])}; \
              *(LAS u32x2*)(lds + (ob) + HA_VT + (d0 + e) * 80 + w * 8) = e ? (u32x2){(vv[0] >> 16) | (vv[1] & 0xffff0000u), (vv[2] >> 16) | (vv[3] & 0xffff0000u)} : (u32x2){(vv[0] & 0xffffu) | (vv[1] << 16), (vv[2] & 0xffffu) | (vv[3] << 16)}; } \
          if (w == 0) *(LAS f32x2*)(lds + (ob) + HA_DEC + d0 * 4) = (f32x2){exp_(glast[0]), exp_(glast[1])}; Gc[0] += glast[0]; Gc[1] += glast[1]; } while (0)
    HG_LOAD(0);
    HG_E1();
    HG_LOAD(1);
    __syncthreads();
    HG_E2(0, 0);
#define HG_XM() do { \
        if (w < 4) { const int tt = w >> 1, st = w & 1; f32x4 sc = (f32x4){0.f, 0.f, 0.f, 0.f}; \
            if (st <= tt) { \
        _Pragma("unroll") \
                for (int ks = 0; ks < 4; ++ks) { const bf16x8 a = *(const LAS bf16x8*)(lds + ob + HA_QH + (tt * 16 + fr) * 272 + ks * 64 + fq * 16), bb = *(const LAS bf16x8*)(lds + ob + HA_KH + (st * 16 + fr) * 272 + ks * 64 + fq * 16); \
                    sc = __builtin_amdgcn_mfma_f32_16x16x32_bf16(a, bb, sc, 0, 0, 0); } } \
        _Pragma("unroll") \
            for (int r = 0; r < 4; ++r) { const int t = tt * 16 + 4 * fq + r, s_ = st * 16 + fr; *(LAS unsigned short*)(lds + HA_P + t * 80 + s_ * 2) = (unsigned short)((s_ <= t) ? f2bf(sc[r]) : 0u); } } \
        _Pragma("unroll") \
        for (int ks = 0; ks < 4; ++ks) { const bf16x8 bs = *(const LAS bf16x8*)(lds + HA_ST + (w * 16 + fr) * 272 + ks * 64 + fq * 16); \
        _Pragma("unroll") \
            for (int tt = 0; tt < 2; ++tt) { const bf16x8 a = *(const LAS bf16x8*)(lds + ob + HA_QT + (tt * 16 + fr) * 272 + ks * 64 + fq * 16); ao[tt] = __builtin_amdgcn_mfma_f32_16x16x32_bf16(bs, a, ao[tt], 0, 0, 0); } } \
    } while (0)
#define HG_YM() do { \
        { const bf16x8 bv = *(const LAS bf16x8*)(lds + ob + HA_VT + (w * 16 + fr) * 80 + fq * 16); unsigned oloff = oloff_; asm volatile("" : "+v"(oloff)); \
        _Pragma("unroll") \
          for (int tt = 0; tt < 2; ++tt) { const bf16x8 a = *(const LAS bf16x8*)(lds + HA_P + (tt * 16 + fr) * 80 + fq * 16); ao[tt] = __builtin_amdgcn_mfma_f32_16x16x32_bf16(bv, a, ao[tt], 0, 0, 0); \
              const unsigned srow = dir ? HG_ROW(c, tt * 16 + 15) : HG_ROW(c, tt * 16); *(u32x2*)((char*)oloc + (size_t)((unsigned)dir * T + srow) * (HGW * 2) + oloff) = (u32x2){pk2(ao[tt][0], ao[tt][1]), pk2(ao[tt][2], ao[tt][3])}; } } \
        { const bf16x8 ak = *(const LAS bf16x8*)(lds + ob + HA_KT + (w * 16 + fr) * 80 + fq * 16); \
          const f32x4 dv = *(const LAS f32x4*)(lds + ob + HA_DEC + (w * 16 + 4 * fq) * 4); \
          bf16x8 bvs[8]; \
        _Pragma("unroll") \
          for (int vt = 0; vt < 8; ++vt) bvs[vt] = *(const LAS bf16x8*)(lds + ob + HA_VT + (vt * 16 + fr) * 80 + fq * 16); \
        _Pragma("unroll") \
          for (int vt = 0; vt < 8; ++vt) accS[vt] = accS[vt] * dv; \
        _Pragma("unroll") \
          for (int vt = 0; vt < 8; ++vt) accS[vt] = __builtin_amdgcn_mfma_f32_16x16x32_bf16(ak, bvs[vt], accS[vt], 0, 0, 0); \
        _Pragma("unroll") \
          for (int vt = 0; vt < 8; ++vt) { u32x2 sw; sw.x = pk2(accS[vt][0], accS[vt][1]); sw.y = pk2(accS[vt][2], accS[vt][3]); \
              *(LAS u32x2*)(lds + HA_ST + (vt * 16 + fr) * 272 + (w * 16 + 4 * fq) * 2) = sw; } } \
    } while (0)
    for (int c = 0; c < 32; ++c) {
        const int ob = (c & 1) * HA_OPB, obn = ((c + 1) & 1) * HA_OPB;
        __syncthreads();
        f32x4 ao[2] = {(f32x4){0.f, 0.f, 0.f, 0.f}, (f32x4){0.f, 0.f, 0.f, 0.f}};
        if (w < 4) { HG_XM(); HG_E1(); } else { HG_E1(); HG_XM(); }
        { const int cn_ = c + 2 < 32 ? c + 2 : 31; HG_LOAD(cn_); }
        __syncthreads();
        if (w < 4) { HG_YM(); if (c + 1 < 32) HG_E2(c + 1, obn); } else { if (c + 1 < 32) HG_E2(c + 1, obn); HG_YM(); }
    }
#undef HG_XM
#undef HG_YM
#undef HG_ROW
#undef HG_LOAD
#undef HG_E1
#undef HG_E2
#pragma unroll
    for (int vt = 0; vt < 8; ++vt) *(f32x4*)(sfin + (size_t)item * 16384 + (size_t)(vt * 16 + fr) * 128 + w * 16 + 4 * fq) = accS[vt];
    if (w == 0) *(f32x2*)(dseg + (size_t)item * 128 + d0) = (f32x2){exp_(Gc[0]), exp_(Gc[1])};
    __syncthreads();
}

__device__ __forceinline__ void hg_phase_c(LAS unsigned char* lds, int cb, int l, const bf16_t* proj, const bf16_t* oloc, const bf16_t* qseg, const float* sfin, const float* dseg, const float* hgn, bf16_t* mix) {
    int tid_l = (int)threadIdx.x; asm volatile("" : "+v"(tid_l));
    const int tid = tid_l, lane = tid & 63, w = __builtin_amdgcn_readfirstlane(tid >> 6), fr = lane & 15, fq = lane >> 4;
    const int half = cb & 1, segtok = (cb >> 1) & 3, h = (cb >> 3) & 3, b = cb >> 5;
    __syncthreads();
#pragma unroll
    for (int dir = 0; dir < 2; ++dir) { const int k = dir ? 3 - segtok : segtok; const int item0 = ((b * 4 + h) * 2 + dir) * 4;
        f32x4 s0[8], s1[8], s2[8], d1[8], d2[8];
#pragma unroll
        for (int i = 0; i < 8; ++i) { const int e4 = tid + NTHR * i; const int v = e4 >> 5, d0 = (e4 & 31) * 4; const size_t so = (size_t)v * 128 + d0;
            s0[i] = k > 0 ? *(const f32x4*)(sfin + (size_t)(item0 + 0) * 16384 + so) : (f32x4){0.f, 0.f, 0.f, 0.f};
            s1[i] = k > 1 ? *(const f32x4*)(sfin + (size_t)(item0 + 1) * 16384 + so) : (f32x4){0.f, 0.f, 0.f, 0.f};
            s2[i] = k > 2 ? *(const f32x4*)(sfin + (size_t)(item0 + 2) * 16384 + so) : (f32x4){0.f, 0.f, 0.f, 0.f};
            d1[i] = k > 1 ? *(const f32x4*)(dseg + (size_t)(item0 + 1) * 128 + d0) : (f32x4){1.f, 1.f, 1.f, 1.f};
            d2[i] = k > 2 ? *(const f32x4*)(dseg + (size_t)(item0 + 2) * 128 + d0) : (f32x4){1.f, 1.f, 1.f, 1.f}; }
#pragma unroll
        for (int i = 0; i < 8; ++i) { const int e4 = tid + NTHR * i; const int v = e4 >> 5, d0 = (e4 & 31) * 4; f32x4 cv = s0[i];
            if (k > 1) cv = cv * d1[i] + s1[i];
            if (k > 2) cv = cv * d2[i] + s2[i];
            u32x2 cw; cw.x = pk2(cv[0], cv[1]); cw.y = pk2(cv[2], cv[3]); *(LAS u32x2*)(lds + dir * 34816 + v * 272 + d0 * 2) = cw; } }
    __syncthreads();
    f32x4 gnv[8];
#pragma unroll
    for (int vt = 0; vt < 8; ++vt) gnv[vt] = *(const f32x4*)(hgn + h * 128 + vt * 16 + 4 * fq);
    const int kf = segtok, kb = 3 - segtok;
#pragma unroll 1
    for (int tile = 0; tile < 4; ++tile) {
        const int t = segtok * 1024 + (half * 4 + tile) * 128 + w * 16 + fr; const size_t row = (size_t)b * SEQ + t;
        bf16x8 bq[2][4]; u32x2 olf[8], olb[8], zgv[8];
#pragma unroll
        for (int dir = 0; dir < 2; ++dir)
#pragma unroll
            for (int ks = 0; ks < 4; ++ks) bq[dir][ks] = *(const bf16x8*)(qseg + ((size_t)dir * T + row) * HGW + h * 128 + ks * 32 + fq * 8);
#pragma unroll
        for (int vt = 0; vt < 8; ++vt) { const int v0 = vt * 16 + 4 * fq; olf[vt] = *(const u32x2*)(oloc + (size_t)row * HGW + h * 128 + v0); olb[vt] = *(const u32x2*)(oloc + ((size_t)T + row) * HGW + h * 128 + v0);
            zgv[vt] = *(const u32x2*)(proj + row * INC + 2048 + h * 128 + v0); }
        f32x4 acc[8];
#pragma unroll
        for (int i = 0; i < 8; ++i) acc[i] = (f32x4){0.f, 0.f, 0.f, 0.f};
#pragma unroll
        for (int dir = 0; dir < 2; ++dir) { const int k = dir ? kb : kf;
            if (k > 0) {
#pragma unroll
                for (int ks = 0; ks < 4; ++ks) {
#pragma unroll
                    for (int vt = 0; vt < 8; ++vt) { const bf16x8 ac = *(const LAS bf16x8*)(lds + dir * 34816 + (vt * 16 + fr) * 272 + ks * 64 + fq * 16); acc[vt] = __builtin_amdgcn_mfma_f32_16x16x32_bf16(ac, bq[dir][ks], acc[vt], 0, 0, 0); } } } }
        float ss = 0.f;
#pragma unroll
        for (int vt = 0; vt < 8; ++vt) { const u32x2 of = olf[vt], ob = olb[vt];
            acc[vt][0] += bf2f(of.x & 0xffffu) + bf2f(ob.x & 0xffffu); acc[vt][1] += bf2f(of.x >> 16) + bf2f(ob.x >> 16); acc[vt][2] += bf2f(of.y & 0xffffu) + bf2f(ob.y & 0xffffu); acc[vt][3] += bf2f(of.y >> 16) + bf2f(ob.y >> 16);
            ss += (acc[vt][0] * acc[vt][0] + acc[vt][1] * acc[vt][1]) + (acc[vt][2] * acc[vt][2] + acc[vt][3] * acc[vt][3]); }
        ss += __shfl_xor(ss, 16); ss += __shfl_xor(ss, 32);
        const float rs = rsqf_(ss * (1.0f / 128.f) + RMS_EPS);
#pragma unroll
        for (int vt = 0; vt < 8; ++vt) { const int v0 = vt * 16 + 4 * fq; const u32x2 zg = zgv[vt]; const f32x4 gn = gnv[vt];
            const float z0 = bf2f(zg.x & 0xffffu), z1 = bf2f(zg.x >> 16), z2 = bf2f(zg.y & 0xffffu), z3 = bf2f(zg.y >> 16);
            u32x2 ow; ow.x = pk2(acc[vt][0] * rs * gn[0] * (z0 * sigmoidf_(z0)), acc[vt][1] * rs * gn[1] * (z1 * sigmoidf_(z1))); ow.y = pk2(acc[vt][2] * rs * gn[2] * (z2 * sigmoidf_(z2)), acc[vt][3] * rs * gn[3] * (z3 * sigmoidf_(z3)));
            *(u32x2*)(mix + row * D + h * 128 + v0) = ow; }
    }
}

constexpr int LR_XC = 0, LR_CAR = 65536, LR_RED = 73728, LR_HS = 75776;
template <int MODE>
__device__ __forceinline__ void lru_pair(LAS unsigned char* lds, int b, int kpair, const bf16_t* proj, const float* cw, const float* cbias, const bf16_t* lruw_l, const float* ba_l, const float* bx_l, const float* lam_l, float* lsum, const float* lrn, bf16_t* mix) {
    int tid_l = (int)threadIdx.x; asm volatile("" : "+v"(tid_l));
    const int tid = tid_l, lane = tid & 63, w = __builtin_amdgcn_readfirstlane(tid >> 6), fr = lane & 15, fq = lane >> 4;
    __syncthreads();
    if (MODE == 1) {
        const int c0 = tid, k0s = 2 * kpair; float cf = 0.f, cbk = 0.f;
        const float* Af = lsum + ((size_t)(0 * 2 + 0) * BATCH + b) * 64 * LRW + c0; const float* Hf = lsum + ((size_t)(0 * 2 + 1) * BATCH + b) * 64 * LRW + c0;
        const float* Ab = lsum + ((size_t)(1 * 2 + 0) * BATCH + b) * 64 * LRW + c0; const float* Hb = lsum + ((size_t)(1 * 2 + 1) * BATCH + b) * 64 * LRW + c0;
        for (int k0 = 0; k0 < k0s; k0 += 16) { float av[16], hv[16];
#pragma unroll
            for (int q = 0; q < 16; ++q) { const int kk = k0 + q; const bool ok = kk < k0s; av[q] = ok ? Af[(size_t)kk * LRW] : 1.0f; hv[q] = ok ? Hf[(size_t)kk * LRW] : 0.0f; }
#pragma unroll
            for (int q = 0; q < 16; ++q) cf = av[q] * cf + hv[q]; }
        for (int k0 = 63; k0 > k0s + 1; k0 -= 16) { float av[16], hv[16];
#pragma unroll
            for (int q = 0; q < 16; ++q) { const int kk = k0 - q; const bool ok = kk > k0s + 1; av[q] = ok ? Ab[(size_t)kk * LRW] : 1.0f; hv[q] = ok ? Hb[(size_t)kk * LRW] : 0.0f; }
#pragma unroll
            for (int q = 0; q < 16; ++q) cbk = av[q] * cbk + hv[q]; }
        LAS float* car = (LAS float*)(lds + LR_CAR);
        car[(0 * 2 + 0) * 512 + c0] = cf; car[(1 * 2 + 0) * 512 + c0] = Af[(size_t)k0s * LRW] * cf + Hf[(size_t)k0s * LRW];
        car[(1 * 2 + 1) * 512 + c0] = cbk; car[(0 * 2 + 1) * 512 + c0] = Ab[(size_t)(k0s + 1) * LRW] * cbk + Hb[(size_t)(k0s + 1) * LRW];
    }
#pragma unroll 1
    for (int sub = 0; sub < 2; ++sub) {
        const int ksub = 2 * kpair + sub; const size_t row0 = (size_t)b * SEQ + (size_t)ksub * 64;
        if (sub) __syncthreads();
        { const int cp = (tid & 255) * 2, th = tid >> 8; const int t0 = ksub * 64 + th * 32;
          const f32x2 w0 = *(const f32x2*)(cw + cp), w1 = *(const f32x2*)(cw + LRW + cp), w2 = *(const f32x2*)(cw + 2 * LRW + cp), w3 = *(const f32x2*)(cw + 3 * LRW + cp), bs = *(const f32x2*)(cbias + cp);
          const bf16_t* zp = proj + ((size_t)b * SEQ + t0) * INC + 2560 + cp;
          unsigned zr[35];
#pragma unroll
          for (int q = 0; q < 35; ++q) { const bool edge = (q < 2) || (q == 34); const bool ok = (q < 2) ? (t0 != 0) : (t0 + 32 < SEQ);
              const long ro = edge ? (ok ? (long)(q - 2) : 0L) : (long)(q - 2); const unsigned zv = *(const unsigned*)(zp + ro * INC); zr[q] = (edge && !ok) ? 0u : zv; }
          const int hd = cp >> 6, ii = cp & 63;
#pragma unroll
          for (int q = 0; q < 32; ++q) { const int tl = th * 32 + q;
              const float x0 = bs[0] + w0[0] * bf2f(zr[q] & 0xffffu) + w1[0] * bf2f(zr[q + 1] & 0xffffu) + w2[0] * bf2f(zr[q + 2] & 0xffffu) + w3[0] * bf2f(zr[q + 3] & 0xffffu);
              const float x1 = bs[1] + w0[1] * bf2f(zr[q] >> 16) + w1[1] * bf2f(zr[q + 1] >> 16) + w2[1] * bf2f(zr[q + 2] >> 16) + w3[1] * bf2f(zr[q + 3] >> 16);
              *(LAS unsigned*)(lds + LR_XC + hd * 8192 + tl * 128 + ((((ii >> 3) ^ (tl & 7))) << 4) + (ii & 7) * 2) = pk2(x0, x1); } }
        __syncthreads();
        float ssq[16];
#pragma unroll
        for (int k = 0; k < 16; ++k) ssq[k] = 0.f;
        bf16x8 bw[2][4]; float cst[2][3];
#pragma unroll
        for (int q_ = 0; q_ < 4; ++q_) bw[1][q_] = (bf16x8){0, 0, 0, 0, 0, 0, 0, 0};
        cst[1][0] = cst[1][1] = cst[1][2] = 0.f;
#define LR_LOADW(it, buf) do { const int jt_ = (it) >> 1, dir_ = (it) & 1, j_ = jt_ * 16 + fr, c_ = w * 64 + j_; \
            _Pragma("unroll") for (int ks_ = 0; ks_ < 2; ++ks_) { bw[buf][ks_ * 2 + 0] = *(const bf16x8*)(lruw_l + ((size_t)((dir_ * 2 + 0) * LRH + w) * 64 + j_) * 64 + ks_ * 32 + fq * 8); \
                                                                  bw[buf][ks_ * 2 + 1] = *(const bf16x8*)(lruw_l + ((size_t)((dir_ * 2 + 1) * LRH + w) * 64 + j_) * 64 + ks_ * 32 + fq * 8); } \
            cst[buf][0] = ba_l[dir_ * LRW + c_]; cst[buf][1] = bx_l[dir_ * LRW + c_]; cst[buf][2] = lam_l[dir_ * LRW + c_]; } while (0)
        LR_LOADW(0, 0);
#pragma unroll 1
        for (int jt = 0; jt < 4; ++jt) {
            const int j = jt * 16 + fr, c = w * 64 + j;
            float xcv[16], hsum[16];
#pragma unroll
            for (int k = 0; k < 16; ++k) { const int tl = 16 * fq + k; xcv[k] = bf2f(*(const LAS unsigned short*)(lds + LR_XC + w * 8192 + tl * 128 + ((((j >> 3) ^ (tl & 7))) << 4) + (j & 7) * 2)); }
#pragma unroll
            for (int dir = 0; dir < 2; ++dir) {
                constexpr int dummy = 0; (void)dummy;
                const int it = jt * 2 + dir; constexpr int dummy2 = 0; (void)dummy2; const int buf = dir;
                { const int itn_ = (it + 1 < 8) ? it + 1 : 7; LR_LOADW(itn_, dir ^ 1); }
                const float bav = cst[buf][0], bxv = cst[buf][1], lamv = cst[buf][2];
                const float sp8 = -8.0f * ((lamv < -20.f) ? -lamv : log_(1.0f + exp_(-lamv)));
                f32x4 aR[4], aI[4];
#pragma unroll
                for (int tt = 0; tt < 4; ++tt) { aR[tt] = (f32x4){0.f, 0.f, 0.f, 0.f}; aI[tt] = (f32x4){0.f, 0.f, 0.f, 0.f}; }
#pragma unroll
                for (int ks = 0; ks < 2; ++ks) {
#pragma unroll
                    for (int tt = 0; tt < 4; ++tt) { const int tla = 16 * (fr >> 2) + 4 * tt + (fr & 3); const bf16x8 av = *(const LAS bf16x8*)(lds + LR_XC + w * 8192 + tla * 128 + ((((ks * 4 + fq) ^ (tla & 7))) << 4));
                        aR[tt] = __builtin_amdgcn_mfma_f32_16x16x32_bf16(av, bw[buf][ks * 2 + 0], aR[tt], 0, 0, 0); aI[tt] = __builtin_amdgcn_mfma_f32_16x16x32_bf16(av, bw[buf][ks * 2 + 1], aI[tt], 0, 0, 0); } }
                float hl[16], pc[16]; float hh = 0.f, pp = 1.0f;
                { constexpr float NL2E = -1.4426950408889634f; const f32x2 nl2 = {NL2E, NL2E}, one2 = {1.0f, 1.0f}, bar2 = {bav * NL2E, bav * NL2E}, bxr2 = {bxv * NL2E, bxv * NL2E}, spl2 = {sp8 * -NL2E, sp8 * -NL2E};
#pragma unroll
                  for (int k = 0; k < 16; k += 2) { const int tt = k >> 2, r = k & 3;
                    const f32x2 er = (f32x2){aR[tt][r], aR[tt][r + 1]} * nl2 + bar2, ei = (f32x2){aI[tt][r], aI[tt][r + 1]} * nl2 + bxr2;
                    const f32x2 dr = (f32x2){__builtin_amdgcn_exp2f(er[0]), __builtin_amdgcn_exp2f(er[1])} + one2, di = (f32x2){__builtin_amdgcn_exp2f(ei[0]), __builtin_amdgcn_exp2f(ei[1])} + one2;
                    const f32x2 rr = {__builtin_amdgcn_rcpf(dr[0]), __builtin_amdgcn_rcpf(dr[1])}, ig = {__builtin_amdgcn_rcpf(di[0]), __builtin_amdgcn_rcpf(di[1])};
                    const f32x2 ea = rr * spl2; const f32x2 a = {__builtin_amdgcn_exp2f(ea[0]), __builtin_amdgcn_exp2f(ea[1])};
                    const f32x2 om = one2 - a * a; const f32x2 sq = {__builtin_amdgcn_sqrtf(__builtin_fabsf(om[0])), __builtin_amdgcn_sqrtf(__builtin_fabsf(om[1]))};
                    const f32x2 u = sq * (ig * (f32x2){xcv[k], xcv[k + 1]});
                    pc[k] = a[0]; pc[k + 1] = a[1]; hl[k] = u[0]; hl[k + 1] = u[1]; } }
#pragma unroll
                for (int kk = 0; kk < 16; ++kk) { const int k = dir ? 15 - kk : kk; hh = pc[k] * hh + hl[k]; pp = pp * pc[k]; hl[k] = hh; pc[k] = pp; }
                const float P0 = __shfl(pp, fr), P1 = __shfl(pp, fr + 16), P2 = __shfl(pp, fr + 32), P3 = __shfl(pp, fr + 48);
                const float H0 = __shfl(hh, fr), H1 = __shfl(hh, fr + 16), H2 = __shfl(hh, fr + 32), H3 = __shfl(hh, fr + 48);
                float cin, pin, Ht, At;
                if (dir == 0) { const float c1 = H0, c2 = P1 * c1 + H1, c3 = P2 * c2 + H2; const float p1 = P0, p2 = P0 * P1, p3 = p2 * P2;
                    cin = fq == 0 ? 0.f : (fq == 1 ? c1 : (fq == 2 ? c2 : c3)); pin = fq == 0 ? 1.0f : (fq == 1 ? p1 : (fq == 2 ? p2 : p3)); Ht = P3 * c3 + H3; At = p3 * P3; }
                else { const float c2 = H3, c1 = P2 * c2 + H2, c0_ = P1 * c1 + H1; const float p2 = P3, p1 = P3 * P2, p0 = p1 * P1;
                    cin = fq == 3 ? 0.f : (fq == 2 ? c2 : (fq == 1 ? c1 : c0_)); pin = fq == 3 ? 1.0f : (fq == 2 ? p2 : (fq == 1 ? p1 : p0)); Ht = P0 * c0_ + H0; At = p0 * P0; }
                if (MODE == 0) { if (fq == 0) { lsum[(((size_t)(dir * 2 + 0) * BATCH + b) * 64 + ksub) * LRW + c] = At; lsum[(((size_t)(dir * 2 + 1) * BATCH + b) * 64 + ksub) * LRW + c] = Ht; } }
                else { const float ein = cin + pin * ((const LAS float*)(lds + LR_CAR))[(sub * 2 + dir) * 512 + c];
#pragma unroll
                    for (int k = 0; k < 16; ++k) { const float hv = hl[k] + pc[k] * ein; hsum[k] = dir ? hsum[k] + hv : hv; } }
            }
            if (MODE == 1) {
#pragma unroll
                for (int k = 0; k < 16; ++k) { ssq[k] += hsum[k] * hsum[k]; *(LAS unsigned short*)(lds + LR_HS + (16 * fq + k) * 1024 + c * 2) = (unsigned short)f2bf(hsum[k]); }
            }
        }
#undef LR_LOADW
        if (MODE == 1) {
            LAS float* red = (LAS float*)(lds + LR_RED);
#pragma unroll
            for (int k = 0; k < 16; ++k) {
#define LR_DPP_ADD(ctrl) ssq[k] += __builtin_bit_cast(float, __builtin_amdgcn_update_dpp(0, __builtin_bit_cast(int, ssq[k]), ctrl, 0xf, 0xf, false))
                LR_DPP_ADD(0xB1); LR_DPP_ADD(0x4E); LR_DPP_ADD(0x141); LR_DPP_ADD(0x140);
#undef LR_DPP_ADD
            }
            if (fr == 0) {
#pragma unroll
                for (int k = 0; k < 16; ++k) red[w * 64 + 16 * fq + k] = ssq[k]; }
            __syncthreads();
#pragma unroll 2
            for (int i = 0; i < 8; ++i) { const int idx = tid + NTHR * i, tk = idx >> 6, c8 = (idx & 63) * 8; float t_ = 0.f;
#pragma unroll
                for (int ww = 0; ww < 8; ++ww) t_ += red[ww * 64 + tk];
                const float rs = rsqf_(t_ * (1.0f / 512.f) + RMS_EPS);
                const u32x4 hw = *(const LAS u32x4*)(lds + LR_HS + tk * 1024 + c8 * 2); const size_t row = row0 + tk; const u32x4 zw = *(const u32x4*)(proj + row * INC + 3072 + c8);
                const f32x4 g0 = *(const f32x4*)(lrn + c8), g1 = *(const f32x4*)(lrn + c8 + 4); unsigned ow[4];
#pragma unroll
                for (int q = 0; q < 4; ++q) { float hv[2] = {bf2f(hw[q] & 0xffffu), bf2f(hw[q] >> 16)}, zz[2] = {bf2f(zw[q] & 0xffffu), bf2f(zw[q] >> 16)}, rr[2];
#pragma unroll
                    for (int e2 = 0; e2 < 2; ++e2) { const int cc = 2 * q + e2; rr[e2] = hv[e2] * rs * (cc < 4 ? g0[cc] : g1[cc - 4]) * gelu_tanh_(zz[e2]); }
                    ow[q] = pk2(rr[0], rr[1]); }
                *(u32x4*)(mix + row * D + 512 + c8) = (u32x4){ow[0], ow[1], ow[2], ow[3]}; }
        }
    }
}

#define XB_TMO      128
#define XB_XCNT(j)  (256  + 64 * (j))
#define XB_XSUB(j)  (1280 + 64 * (j))
#define XB_XGEN(j)  (2304 + 64 * (j))
#define XB_TOP      3328
#define XB_TOPGEN   3392
#define XCD_BAR_WORDS 3456
#define XB_SPIN_CAP (1u << 18)
__device__ __forceinline__ unsigned xb_ld(unsigned* p)              { return __hip_atomic_load(p, __ATOMIC_RELAXED, __HIP_MEMORY_SCOPE_AGENT); }
__device__ __forceinline__ unsigned xb_add(unsigned* p, unsigned v) { return __hip_atomic_fetch_add(p, v, __ATOMIC_RELAXED, __HIP_MEMORY_SCOPE_AGENT); }
__device__ __forceinline__ unsigned xb_xcc_id() { return (unsigned)__builtin_amdgcn_s_getreg((3 << 11) | 20) & 0xFu; }
#define XB_SPIN(cond, bar) do { unsigned _sp = 0; while (cond) { __builtin_amdgcn_s_sleep(1); \
    if ((++_sp & 255u) == 0u) { if (xb_ld(&(bar)[XB_TMO])) break; if (_sp > XB_SPIN_CAP) { atomicAdd(&(bar)[XB_TMO], 1u); break; } } } } while (0)
struct XcdBarrier { unsigned* bar; unsigned x; volatile LAS unsigned* st; };
__device__ __forceinline__ XcdBarrier xcd_barrier_post(unsigned* bar, volatile LAS unsigned* st) {
    XcdBarrier b; b.bar = bar; b.x = xb_xcc_id(); b.st = st;
    if (threadIdx.x == 0) (void)xb_add(&bar[XB_XCNT(b.x)], 1u);
    return b;
}
__device__ __forceinline__ void xcd_barrier_complete(unsigned* bar, unsigned x, unsigned& nloc, unsigned& nx) {
    const unsigned G = gridDim.x * gridDim.y * gridDim.z;
    unsigned sum, cnt, mine, sp = 0u;
    for (;;) {
        sum = 0u; cnt = 0u; mine = 0u;
#pragma unroll
        for (unsigned j = 0; j < 16; ++j) { const unsigned c = xb_ld(&bar[XB_XCNT(j)]); sum += c; cnt += (c > 0u) ? 1u : 0u; mine = (j == x) ? c : mine; }
        if (sum == G) break;
        __builtin_amdgcn_s_sleep(1);
        if ((++sp & 255u) == 0u) { if (xb_ld(&bar[XB_TMO])) break; if (sp > XB_SPIN_CAP) { atomicAdd(&bar[XB_TMO], 1u); break; } }
    }
    nloc = mine > 0u ? mine : 1u; nx = cnt > 0u ? cnt : 1u;
}
__device__ __forceinline__ void xcd_barrier(const XcdBarrier& b_in) {
    XcdBarrier b = b_in; asm volatile("" : "+s"(b.bar), "+s"(b.x));
    asm volatile("s_waitcnt vmcnt(0)" ::: "memory");
    __syncthreads();
    if (threadIdx.x == 0) {
        unsigned* bar = b.bar;
        __builtin_amdgcn_s_waitcnt(0);
        unsigned nloc = b.st[0], nx = b.st[1];
        if (nloc == 0u) { xcd_barrier_complete(bar, b.x, nloc, nx); b.st[0] = nloc; b.st[1] = nx; }
        const unsigned old = xb_add(&bar[XB_XSUB(b.x)], 1u);
        const unsigned gen = old / nloc;
        if (old + 1u == (gen + 1u) * nloc) {
            __builtin_amdgcn_fence(__ATOMIC_RELEASE, "agent");
            asm volatile("s_waitcnt vmcnt(0)" ::: "memory");
            const unsigned og = xb_add(&bar[XB_TOP], 1u);
            const unsigned tg = og / nx;
            if (og + 1u == (tg + 1u) * nx) xb_add(&bar[XB_TOPGEN], 1u);
            else XB_SPIN(xb_ld(&bar[XB_TOPGEN]) == tg, bar);
            __builtin_amdgcn_fence(__ATOMIC_ACQUIRE, "agent");
            xb_add(&bar[XB_XGEN(b.x)], 1u);
            asm volatile("s_waitcnt vmcnt(0)" ::: "memory");
        } else {
            XB_SPIN(xb_ld(&bar[XB_XGEN(b.x)]) == gen, bar);
            __builtin_amdgcn_fence(__ATOMIC_ACQUIRE, "agent");
            asm volatile("s_waitcnt vmcnt(0)" ::: "memory");
        }
    }
    __syncthreads();
}

struct Args { const float* in[23]; float* out; unsigned char* ws; int l_lo, l_hi, ph_lo, ph_hi, pro, pad; };
enum { I_X = 0, I_WIN, I_HGLB, I_HGNORM, I_CONVW, I_CONVB, I_WA, I_BA, I_WX, I_BX, I_LAM, I_LRUNORM, I_WOUT, I_LN1G, I_LN1B, I_RW, I_RB, I_WGU, I_BGU, I_WDN, I_BDN, I_LN2G, I_LN2B };
enum { PH_PROJ = 1, PH_HG = 2, PH_LRUAU = 3, PH_LRUSCAN = 4, PH_COMB = 5, PH_OUTG = 6, PH_LN1R = 7, PH_MOE1 = 8, PH_MOE2 = 9, PH_LN2 = 10, PH_END = 11 };

__device__ __forceinline__ void transpose_item(const float* W, int N, int k0, int n0, bf16_t* WT, size_t dst_row0, int KP, LAS float* scr, int lane) {
#pragma unroll 8
    for (int i = 0; i < 32; ++i) { const int kk = 2 * i + (lane >> 5); scr[kk * 33 + (lane & 31)] = W[(size_t)(k0 + kk) * N + n0 + (lane & 31)]; }
    LDS_WAIT(); asm volatile("" ::: "memory");
    const int c = lane & 7;
#pragma unroll
    for (int j = 0; j < 4; ++j) { const int n = (lane >> 3) + 8 * j; const LAS float* s = scr + (8 * c) * 33 + n;
        u32x4 o; o.x = pk2(s[0 * 33], s[1 * 33]); o.y = pk2(s[2 * 33], s[3 * 33]); o.z = pk2(s[4 * 33], s[5 * 33]); o.w = pk2(s[6 * 33], s[7 * 33]);
        *(u32x4*)(WT + (dst_row0 + n) * KP + k0 + 8 * c) = o; }
    LDS_WAIT(); asm volatile("" ::: "memory");
}

__device__ __forceinline__ void transpose_item_q(const float* W, int N, int k0, int n0, unsigned char* WT, size_t dst_row0, int KP, float mul, LAS float* scr, int lane) {
#pragma unroll 8
    for (int i = 0; i < 32; ++i) { const int kk = 2 * i + (lane >> 5); scr[kk * 33 + (lane & 31)] = W[(size_t)(k0 + kk) * N + n0 + (lane & 31)]; }
    LDS_WAIT(); asm volatile("" ::: "memory");
    const int c = lane & 7;
#pragma unroll
    for (int j = 0; j < 4; ++j) { const int n = (lane >> 3) + 8 * j; const LAS float* s = scr + (8 * c) * 33 + n; int w0 = 0, w1 = 0;
        w0 = __builtin_amdgcn_cvt_pk_fp8_f32(s[0 * 33] * mul, s[1 * 33] * mul, w0, false); w0 = __builtin_amdgcn_cvt_pk_fp8_f32(s[2 * 33] * mul, s[3 * 33] * mul, w0, true);
        w1 = __builtin_amdgcn_cvt_pk_fp8_f32(s[4 * 33] * mul, s[5 * 33] * mul, w1, false); w1 = __builtin_amdgcn_cvt_pk_fp8_f32(s[6 * 33] * mul, s[7 * 33] * mul, w1, true);
        *(u32x2*)(WT + (dst_row0 + n) * KP + k0 + 8 * c) = (u32x2){(unsigned)w0, (unsigned)w1}; }
    LDS_WAIT(); asm volatile("" ::: "memory");
}
__device__ __forceinline__ void transpose_item_q2(const float* W, int N, int k0, int n0, unsigned char* WT, size_t dst_row0, int KP, float mul, LAS float* scr, int lane) {
#pragma unroll 8
    for (int i = 0; i < 32; ++i) { const int kk = 4 * i + (lane >> 4), n = lane & 15; scr[n * 132 + kk] = W[(size_t)(k0 + kk) * N + n0 + n]; }
    LDS_WAIT(); asm volatile("" ::: "memory");
    const int c = lane & 15;
#pragma unroll
    for (int j = 0; j < 4; ++j) { const int n = (lane >> 4) + 4 * j; const f32x4 a = *(const LAS f32x4*)(scr + n * 132 + 8 * c), b = *(const LAS f32x4*)(scr + n * 132 + 8 * c + 4); int w0 = 0, w1 = 0;
        w0 = __builtin_amdgcn_cvt_pk_fp8_f32(a[0] * mul, a[1] * mul, w0, false); w0 = __builtin_amdgcn_cvt_pk_fp8_f32(a[2] * mul, a[3] * mul, w0, true);
        w1 = __builtin_amdgcn_cvt_pk_fp8_f32(b[0] * mul, b[1] * mul, w1, false); w1 = __builtin_amdgcn_cvt_pk_fp8_f32(b[2] * mul, b[3] * mul, w1, true);
        *(u32x2*)(WT + (dst_row0 + n) * KP + k0 + 8 * c) = (u32x2){(unsigned)w0, (unsigned)w1}; }
    LDS_WAIT(); asm volatile("" ::: "memory");
}
__device__ __forceinline__ int fp8_scale_exp(const float* W, int stride, int lane) {
    float a = 0.f;
#pragma unroll
    for (int q = 0; q < 8; ++q) a += fabsf(W[(size_t)(lane * 8 + q) * stride]);
    a = wave_sum(a) * (1.0f / 512.f);
    int s = (a > 0.f) ? (int)rintf(-log2f(a)) : 0; return s < -24 ? -24 : (s > 24 ? 24 : s);
}

typedef const __attribute__((address_space(4))) Args* CArgs;
#define PHASE_ENV() \
    CArgs A = (CArgs)__builtin_amdgcn_kernarg_segment_ptr(); asm volatile("" : "+s"(A)); \
    int tid_l_ = (int)threadIdx.x, bid_l_ = (int)blockIdx.x, G_l_ = (int)gridDim.x; asm volatile("" : "+v"(tid_l_), "+s"(bid_l_), "+s"(G_l_)); \
    const int tid = tid_l_, lane = tid & 63, wave = __builtin_amdgcn_readfirstlane(tid >> 6), G = G_l_, bid = bid_l_, gw = bid * NWAVES + wave, NGW = G * NWAVES; (void)lane; (void)gw; (void)NGW; \
    unsigned char* ws = A->ws; \
    unsigned* ctl = (unsigned*)(ws + WS_CTL); (void)ctl; \
    float* lbt = (float*)(ws + WS_LBT); (void)lbt; \
    bf16_t* rwh = (bf16_t*)(ws + WS_RWH); bf16_t* rwl = (bf16_t*)(ws + WS_RWL); (void)rwh; (void)rwl; \
    bf16_t* win_t = (bf16_t*)(ws + WS_WIN); bf16_t* wout_t = (bf16_t*)(ws + WS_WOUT); bf16_t* wgu_t = (bf16_t*)(ws + WS_WGU); bf16_t* wdn_t = (bf16_t*)(ws + WS_WDN); (void)win_t; (void)wout_t; (void)wgu_t; (void)wdn_t; \
    bf16_t* xb = (bf16_t*)(ws + WS_XB); float* xres = (float*)(ws + WS_XRES); bf16_t* proj = (bf16_t*)(ws + WS_PROJ); bf16_t* mix = (bf16_t*)(ws + WS_MIX); (void)xb; (void)xres; (void)proj; (void)mix; \
    float* ybuf = (float*)(ws + WS_Y); bf16_t* ybf = (bf16_t*)(ws + WS_Y); (void)ybf; float* x1 = (float*)(ws + WS_X1); bf16_t* x1b = (bf16_t*)(ws + WS_X1B); unsigned char* hid = ws + WS_HID; unsigned char* wguq = ws + WS_WGU; unsigned char* wdnq = ws + WS_WDN; unsigned char* x1q = ws + WS_X1Q; unsigned char* xq = ws + WS_XQ; unsigned char* winq = ws + WS_WINQ; (void)xq; (void)winq; (void)wguq; (void)wdnq; (void)x1q; unsigned char* ysl = ws + WS_YS; (void)ybuf; (void)x1; (void)x1b; (void)hid; (void)ysl; \
    int* rtok = (int*)(ws + WS_RTOK); float* rgate = (float*)(ws + WS_RGATE); int* tslot = (int*)(ws + WS_TSLOT); (void)rtok; (void)rgate; (void)tslot; \
    float* odir = (float*)(ws + WS_ODIR); float* hdir = (float*)(ws + WS_HDIR); float* aub = (float*)(ws + WS_AU); (void)odir; (void)hdir; (void)aub; \
    bf16_t* oloc = (bf16_t*)(ws + WS_OLOC); bf16_t* qseg = (bf16_t*)(ws + WS_QSEG); float* sfin = (float*)(ws + WS_SFIN); float* dseg = (float*)(ws + WS_DSEG); float* lsum = (float*)(ws + WS_LSUM); bf16_t* lruw = (bf16_t*)(ws + WS_LRUW); (void)oloc; (void)qseg; (void)sfin; (void)dseg; (void)lsum; (void)lruw; \
    const float* xin = (l == 0) ? A->in[I_X] : (const float*)xres; float* xout = (l == NL - 1) ? A->out : xres; unsigned* cntg = ctl + CW_CNT + 1024 * l; (void)xin; (void)xout; (void)cntg

#define MOE_TABLES(sclp) do { __syncthreads(); \
    if (tid < 32) { tabcnt[tid] = (int)__hip_atomic_load(cntg + 32 * tid, __ATOMIC_RELAXED, __HIP_MEMORY_SCOPE_AGENT); tabscl[tid] = (sclp) ? ((const int*)(sclp))[tid] : 0; } \
    __syncthreads(); \
    if (tid == 0) { int s_ = 0; for (int e_ = 0; e_ < 32; ++e_) { tabpblk[e_] = s_; s_ += (tabcnt[e_] + 255) >> 8; } tabpblk[32] = s_; } \
    __syncthreads(); \
    for (int i_ = tid; i_ < tabpblk[32] && i_ < 1024; i_ += NTHR) { int e_ = 0; for (int q2_ = 1; q2_ < 32; ++q2_) e_ += (tabpblk[q2_] <= i_) ? 1 : 0; tabeb[i_] = (unsigned short)e_; }     \
    __syncthreads(); } while (0)

template <int PH> __global__ void __launch_bounds__(NTHR, 2) mk_fwd(Args args) {
    extern __shared__ __attribute__((aligned(16))) unsigned char lds_raw[];
    LAS unsigned char* lds = (LAS unsigned char*)lds_raw;
    const int tid = threadIdx.x, lane = tid & 63, wave = __builtin_amdgcn_readfirstlane(tid >> 6);
    const int G = gridDim.x, bid = blockIdx.x;
    const int gw = bid * NWAVES + wave, NGW = G * NWAVES;
    LAS int* tabcnt = (LAS int*)(lds + 131072 + 1024); LAS int* tabpblk = (LAS int*)(lds + 131072 + 1024 + 256); LAS int* tabscl = (LAS int*)(lds + 131072 + 1024 + 512); LAS unsigned short* tabeb = (LAS unsigned short*)(lds + 131072 + 6144);
    XcdBarrier bar; bar.bar = nullptr; bar.x = 0; bar.st = nullptr;
    if (PH == 0) {
        volatile LAS unsigned* bst = (volatile LAS unsigned*)(lds + LDS_BYTES - 16);
        if (tid == 0) { bst[0] = 0u; bst[1] = 0u; }
        __syncthreads();
        bar = xcd_barrier_post((unsigned*)(args.ws + WS_CTL) + CW_BAR, bst);
    }
#define GRID_BAR() do { if (PH == 0) xcd_barrier(bar); } while (0)
#ifndef PROBE_REP
#define PROBE_REP 0
#endif
#define REPS(k) (((PROBE_REP >> (k)) & 1) ? 2 : 1)

    for (int rep_ = 0; rep_ < REPS(0); ++rep_) if (PH == -1 || PH == 0) {
        const int l = 0; PHASE_ENV();
        LAS float* scr = (LAS float*)(lds + wave * 16384);
        { constexpr int per = 8 * 224; for (int it = gw; it < NL * per; it += NGW) { const int ll = it / per, r = it % per, kb = r / 224, nb = r % 224; const float* src = A->in[I_WIN] + (size_t)ll * D * INC;
            const int sx = fp8_scale_exp(src, 7177, lane); if (r == 0 && lane == 0) ((int*)ctl)[CW_SIN + ll] = sx;
            transpose_item_q2(src, INC, kb * 128, nb * 16, winq + (size_t)ll * INC * D, (size_t)nb * 16, D, exp2f((float)sx), scr, lane); } }
        { constexpr int per = 16 * 32; for (int it = gw; it < NL * per; it += NGW) { const int ll = it / per, r = it % per, kb = r / 32, nb = r % 32;
            transpose_item(A->in[I_WOUT] + (size_t)ll * D * D, D, kb * 64, nb * 32, wout_t + (size_t)ll * D * D, (size_t)nb * 32, D, scr, lane); } }
        for (int pe = gw >> 4; pe < NL * NE; pe += NGW >> 4) { const float* src = A->in[I_WGU] + (size_t)pe * D * 2048; const int sx = fp8_scale_exp(src, 4099, lane); const float mul = exp2f((float)sx);
            if ((gw & 15) == 0 && lane == 0) ((int*)ctl)[CW_SGU + pe] = sx;
            for (int r = gw & 15; r < 8 * 128; r += 16) { const int kb = r / 128, nb = r % 128; const int n0 = nb * 16, cc = n0 & 1023, isup = n0 >> 10; const size_t drow = (size_t)(cc >> 7) * 256 + (size_t)isup * 128 + (cc & 127);
                transpose_item_q2(src, 2048, kb * 128, n0, wguq + (size_t)pe * 2048 * D, drow, D, mul, scr, lane); } }
        for (int pe = gw >> 4; pe < NL * NE; pe += NGW >> 4) { const float* src = A->in[I_WDN] + (size_t)pe * DE * D; const int sx = fp8_scale_exp(src, 2051, lane); const float mul = exp2f((float)sx);
            if ((gw & 15) == 0 && lane == 0) ((int*)ctl)[CW_SDN + pe] = sx;
            for (int r = gw & 15; r < 8 * 64; r += 16) { const int kb = r / 64, nb = r % 64;
                transpose_item_q2(src, D, kb * 128, nb * 16, wdnq + (size_t)pe * D * DE, (size_t)nb * 16, DE, mul, scr, lane); } }
        for (int i = bid * NTHR + tid; i < NL * NE * D; i += G * NTHR) { const int ll = i / (NE * D), r = i % (NE * D), e = r / D, d = r % D; const float w = A->in[I_RW][(size_t)ll * D * NE + (size_t)d * NE + e];
            const unsigned h = f2bf(w); rwh[i] = (bf16_t)h; rwl[i] = (bf16_t)f2bf(w - bf2f(h)); }
        for (int i = bid * NTHR + tid; i < NL * 2 * 2 * LRH * LHD * LHD; i += G * NTHR) { const int ii = i & 63, jj = (i >> 6) & 63, hh = (i >> 12) & 7, wh = (i >> 15) & 1, dl = i >> 16;
            const float* src = wh ? A->in[I_WX] : A->in[I_WA]; lruw[i] = (bf16_t)f2bf(src[((size_t)dl * LRH + hh) * LHD * LHD + (size_t)ii * LHD + jj]); }
        for (size_t i = (size_t)bid * NTHR + tid; i < (size_t)T * D / 4; i += (size_t)G * NTHR) { const f32x4 v = ((const f32x4*)A->in[I_X])[i]; u32x2 o; o.x = pk2(v[0], v[1]); o.y = pk2(v[2], v[3]); ((u32x2*)xb)[i] = o; int q_ = 0; q_ = __builtin_amdgcn_cvt_pk_fp8_f32(v[0], v[1], q_, false); q_ = __builtin_amdgcn_cvt_pk_fp8_f32(v[2], v[3], q_, true); ((int*)xq)[i] = q_; }
        for (int i = bid * NTHR + tid; i < 2 * HGW; i += G * NTHR) { const float* p = A->in[I_HGLB] + i; float v[NL], mx = -3.0e38f;
#pragma unroll
            for (int q = 0; q < NL; ++q) { v[q] = p[(size_t)q * 2 * HGW]; mx = fmaxf(mx, v[q]); }
            float s = 0.f;
#pragma unroll
            for (int q = 0; q < NL; ++q) { v[q] = expf(v[q] - mx); s += v[q]; }
            float cum = 0.f;
#pragma unroll
            for (int q = 0; q < NL; ++q) { if (q > 0) cum += v[q] / s; lbt[(size_t)q * 2 * HGW + i] = fminf(fmaxf(cum, 0.f), 1.0f - 1e-6f); } }
    }
    GRID_BAR();

    const int l_lo = (PH == 0) ? 0 : args.l_lo, l_hi = (PH == 0) ? NL : args.l_hi;
    for (int l = l_lo; l < l_hi; ++l) {
#define IN(k) (PH == 0 || PH == (k))

        for (int rep_ = 0; rep_ < REPS(PH_PROJ); ++rep_) if (IN(PH_PROJ)) {
            if (rep_) GRID_BAR();
            PHASE_ENV();
            ProbProjT<true> p; p.A = xq; p.Bt = winq + (size_t)l * INC * D; p.sw = ((const int*)ctl)[CW_SIN + l]; p.C = proj; p.ldc = INC; p.S.init(T, INC, G, bid);
            pg8::gemm_phase(lds, p);
        }
        GRID_BAR();
        for (int rep_ = 0; rep_ < REPS(PH_HG); ++rep_) if (IN(PH_HG)) {
            if (rep_) GRID_BAR();
            PHASE_ENV();
            for (int item = bid; item < 256; item += G) hg_phase_a(lds, item, l, proj, lbt, oloc, qseg, sfin, dseg);
        }
        for (int rep_ = 0; rep_ < REPS(PH_LRUAU); ++rep_) if (IN(PH_LRUAU)) {
            if (rep_) GRID_BAR();
            PHASE_ENV();
            for (int it = bid; it < BATCH * 32; it += G)
                lru_pair<0>(lds, it >> 5, it & 31, proj, A->in[I_CONVW] + (size_t)l * 4 * LRW, A->in[I_CONVB] + (size_t)l * LRW, lruw + (size_t)l * 2 * 2 * LRH * LHD * LHD,
                               A->in[I_BA] + (size_t)l * 2 * LRW, A->in[I_BX] + (size_t)l * 2 * LRW, A->in[I_LAM] + (size_t)l * 2 * LRW, lsum, nullptr, nullptr);
        }
        GRID_BAR();
        for (int rep_ = 0; rep_ < REPS(PH_COMB); ++rep_) if (IN(PH_COMB)) {
            if (rep_) GRID_BAR();
            PHASE_ENV();
            const float* hgn = A->in[I_HGNORM] + (size_t)l * HGW;
            for (int cb = bid; cb < 256; cb += G) hg_phase_c(lds, cb, l, proj, oloc, qseg, sfin, dseg, hgn, mix);
            for (int it = bid; it < BATCH * 32; it += G)
                lru_pair<1>(lds, it >> 5, it & 31, proj, A->in[I_CONVW] + (size_t)l * 4 * LRW, A->in[I_CONVB] + (size_t)l * LRW, lruw + (size_t)l * 2 * 2 * LRH * LHD * LHD,
                               A->in[I_BA] + (size_t)l * 2 * LRW, A->in[I_BX] + (size_t)l * 2 * LRW, A->in[I_LAM] + (size_t)l * 2 * LRW, lsum, A->in[I_LRUNORM] + (size_t)l * LRW, mix);
        }
        GRID_BAR();
        for (int rep_ = 0; rep_ < REPS(PH_OUTG); ++rep_) if (IN(PH_OUTG)) {
            if (rep_) GRID_BAR();
            PHASE_ENV();
            ProbProjT<false> p; p.A = mix; p.Bt = wout_t + (size_t)l * D * D; p.sw = 0; p.C = ybf; p.ldc = D; p.S.init(T, D, G, bid);
            pg8::gemm_phase(lds, p);
        }
        GRID_BAR();
        if (IN(PH_LN1R)) {
            PHASE_ENV();
            LAS float* S1 = (LAS float*)lds;
            LAS float* S2 = S1 + 256;
            LAS float* PART = S2 + 256;
            constexpr int LN1_MAXT = 16;
            LAS int* hist = (LAS int*)(PART + 8 * 32 * 36); LAS int* basee = hist + 32; LAS int* sel = basee + 32; LAS float* gsel = (LAS float*)(sel + LN1_MAXT * 128);
            LAS float* G1L = gsel + LN1_MAXT * 128; LAS float* B1L = G1L + D;
            const float* rb = A->in[I_RB] + (size_t)l * NE;
            const int tk = lane & 15, kq = lane >> 4, colb = wave * 128 + kq * 8;
            bf16x8 wfh[2][4], wfl[2][4];
#pragma unroll
            for (int et = 0; et < 2; ++et)
#pragma unroll
                for (int ks = 0; ks < 4; ++ks) { const size_t off = (size_t)l * NE * D + (size_t)(et * 16 + tk) * D + colb + 32 * ks; wfh[et][ks] = *(const bf16x8*)(rwh + off); wfl[et][ks] = *(const bf16x8*)(rwl + off); }
            if (tid < 32) hist[tid] = 0;
            { const float* src_ = (tid < 256) ? (A->in[I_LN1G] + (size_t)l * D + 4 * tid) : (A->in[I_LN1B] + (size_t)l * D + 4 * (tid - 256)); *(LAS f32x4*)(G1L + 4 * tid) = *(const f32x4*)src_; }
            int tix = 0;
            for (int tile = bid; tile < T / 32; tile += G, ++tix) {
                float tv[2][4][8];
#pragma unroll
                for (int tt = 0; tt < 2; ++tt) { const size_t row = (size_t)tile * 32 + tt * 16 + tk;
#pragma unroll
                    for (int ks = 0; ks < 4; ++ks) { const u32x4 xw = *(const u32x4*)(xb + row * D + colb + 32 * ks), yw = *(const u32x4*)(ybf + row * D + colb + 32 * ks);
#pragma unroll
                        for (int q = 0; q < 4; ++q) { tv[tt][ks][2 * q] = bf2f(xw[q] & 0xffffu) * ALPHA + bf2f(yw[q] & 0xffffu); tv[tt][ks][2 * q + 1] = bf2f(xw[q] >> 16) * ALPHA + bf2f(yw[q] >> 16); } } }
                float mean[2], rstd[2];
#pragma unroll
                for (int tt = 0; tt < 2; ++tt) { float s_ = 0.f;
#pragma unroll
                    for (int ks = 0; ks < 4; ++ks)
#pragma unroll
                        for (int q = 0; q < 8; ++q) s_ += tv[tt][ks][q];
                    s_ += __shfl_xor(s_, 16); s_ += __shfl_xor(s_, 32); if (kq == 0) S1[wave * 32 + tt * 16 + tk] = s_; }
                __syncthreads();
#pragma unroll
                for (int tt = 0; tt < 2; ++tt) { float m_ = 0.f;
#pragma unroll
                    for (int ww = 0; ww < 8; ++ww) m_ += S1[ww * 32 + tt * 16 + tk];
                    mean[tt] = m_ * (1.f / D); float s_ = 0.f;
#pragma unroll
                    for (int ks = 0; ks < 4; ++ks)
#pragma unroll
                        for (int q = 0; q < 8; ++q) { tv[tt][ks][q] -= mean[tt]; s_ += tv[tt][ks][q] * tv[tt][ks][q]; }
                    s_ += __shfl_xor(s_, 16); s_ += __shfl_xor(s_, 32); if (kq == 0) S2[wave * 32 + tt * 16 + tk] = s_; }
                __syncthreads();
                f32x4 acc[2][2];
#pragma unroll
                for (int et = 0; et < 2; ++et)
#pragma unroll
                    for (int tt = 0; tt < 2; ++tt) acc[et][tt] = (f32x4){0.f, 0.f, 0.f, 0.f};
#pragma unroll
                for (int tt = 0; tt < 2; ++tt) { float v_ = 0.f;
#pragma unroll
                    for (int ww = 0; ww < 8; ++ww) v_ += S2[ww * 32 + tt * 16 + tk];
                    rstd[tt] = rsqf_(v_ * (1.f / D) + LN_EPS); const size_t row = (size_t)tile * 32 + tt * 16 + tk;
#pragma unroll
                    for (int ks = 0; ks < 4; ++ks) { const f32x4 ga = *(const LAS f32x4*)(G1L + colb + 32 * ks), gb = *(const LAS f32x4*)(G1L + colb + 32 * ks + 4), ba_ = *(const LAS f32x4*)(B1L + colb + 32 * ks), bb_ = *(const LAS f32x4*)(B1L + colb + 32 * ks + 4);
                        float o[8]; unsigned hw[4], lw[4];
#pragma unroll
                        for (int q = 0; q < 8; ++q) o[q] = tv[tt][ks][q] * rstd[tt] * (q < 4 ? ga[q] : gb[q - 4]) + (q < 4 ? ba_[q] : bb_[q - 4]);
#pragma unroll
                        for (int q = 0; q < 4; ++q) { hw[q] = pk2(o[2 * q], o[2 * q + 1]); lw[q] = pk2(o[2 * q] - bf2f(hw[q] & 0xffffu), o[2 * q + 1] - bf2f(hw[q] >> 16)); }
                        *(u32x4*)(x1b + row * D + colb + 32 * ks) = (u32x4){hw[0], hw[1], hw[2], hw[3]};
                        { int q0 = 0, q1 = 0; q0 = __builtin_amdgcn_cvt_pk_fp8_f32(o[0], o[1], q0, false); q0 = __builtin_amdgcn_cvt_pk_fp8_f32(o[2], o[3], q0, true); q1 = __builtin_amdgcn_cvt_pk_fp8_f32(o[4], o[5], q1, false); q1 = __builtin_amdgcn_cvt_pk_fp8_f32(o[6], o[7], q1, true);
                          *(u32x2*)(x1q + row * D + colb + 32 * ks) = (u32x2){(unsigned)q0, (unsigned)q1}; }
                        const bf16x8 xh = __builtin_bit_cast(bf16x8, (u32x4){hw[0], hw[1], hw[2], hw[3]}), xl = __builtin_bit_cast(bf16x8, (u32x4){lw[0], lw[1], lw[2], lw[3]});
#pragma unroll
                        for (int et = 0; et < 2; ++et) { acc[et][tt] = __builtin_amdgcn_mfma_f32_16x16x32_bf16(wfh[et][ks], xh, acc[et][tt], 0, 0, 0); acc[et][tt] = __builtin_amdgcn_mfma_f32_16x16x32_bf16(wfl[et][ks], xh, acc[et][tt], 0, 0, 0); acc[et][tt] = __builtin_amdgcn_mfma_f32_16x16x32_bf16(wfh[et][ks], xl, acc[et][tt], 0, 0, 0); } } }
#pragma unroll
                for (int et = 0; et < 2; ++et)
#pragma unroll
                    for (int tt = 0; tt < 2; ++tt) *(LAS f32x4*)(PART + (wave * 32 + tt * 16 + tk) * 36 + et * 16 + 4 * kq) = acc[et][tt];
                __syncthreads();
                {
                    const int tok = tid >> 4, sub = tid & 15; float l0 = rb[2 * sub], l1 = rb[2 * sub + 1];
#pragma unroll
                    for (int ww = 0; ww < 8; ++ww) { const f32x2 pv = *(const LAS f32x2*)(PART + (ww * 32 + tok) * 36 + 2 * sub); l0 += pv[0]; l1 += pv[1]; }
                    float tvv[4]; int tee[4];
#pragma unroll
                    for (int k = 0; k < 4; ++k) { const bool hi_ = l1 > l0; float bv = hi_ ? l1 : l0; int bi = hi_ ? 2 * sub + 1 : 2 * sub;
#define TOPK_STEP(ctrl) { const float ov = __builtin_bit_cast(float, __builtin_amdgcn_update_dpp(0, __builtin_bit_cast(int, bv), ctrl, 0xf, 0xf, false)); const int oi = __builtin_amdgcn_update_dpp(0, bi, ctrl, 0xf, 0xf, false); \
                            const bool take = (ov > bv) | ((ov == bv) & (oi < bi)); bv = take ? ov : bv; bi = take ? oi : bi; }
                        TOPK_STEP(0xB1) TOPK_STEP(0x4E) TOPK_STEP(0x141) TOPK_STEP(0x140)
#undef TOPK_STEP
                        tvv[k] = bv; tee[k] = bi; l0 = (bi == 2 * sub) ? -3.3e38f : l0; l1 = (bi == 2 * sub + 1) ? -3.3e38f : l1; }
                    if (sub < 4) { float wsum = 0.f, wk = 0.f; int ek = 0;
#pragma unroll
                        for (int k = 0; k < 4; ++k) { const float wv_ = exp_(tvv[k] - tvv[0]); wsum += wv_; if (k == sub) { wk = wv_; ek = tee[k]; } }
                        const int lr = atomicAdd((int*)(hist + ek), 1); sel[tix * 128 + tok * 4 + sub] = ek * 65536 + lr; gsel[tix * 128 + tok * 4 + sub] = wk / wsum; } }
            }
            __syncthreads();
            if (tid < 32) { const int hh = hist[tid]; basee[tid] = hh ? (int)atomicAdd(cntg + 32 * tid, (unsigned)hh) : 0; }
            __syncthreads();
            for (int i = tid; i < tix * 128; i += NTHR) { const int sv = sel[i], e = sv >> 16, rank = basee[e] + (sv & 65535); const int tok = (bid + (i >> 7) * G) * 32 + ((i & 127) >> 2); const int idx = e * ECAP + rank;
                rtok[idx] = tok; rgate[idx] = gsel[i]; tslot[tok * 4 + (i & 3)] = idx; }
            __syncthreads();
        }
        GRID_BAR();
        for (int rep_ = 0; rep_ < REPS(PH_MOE1); ++rep_) if (IN(PH_MOE1)) {
            if (rep_) GRID_BAR();
            PHASE_ENV();
            MOE_TABLES((const int*)ctl + CW_SGU + l * NE);
            ProbMoe1 p; p.X = x1q; p.Wgu = wguq + (size_t)l * NE * 2048 * D; p.bgu = A->in[I_BGU] + (size_t)l * NE * 2048; p.hid = hid; p.rtok = rtok; p.tb.cnt = tabcnt; p.tb.pblk = tabpblk; p.tb.scl = tabscl; p.tb.eb = tabeb; p.G = G; p.c = bid;
            pg8::gemm_phase(lds, p);
        }
        GRID_BAR();
        for (int rep_ = 0; rep_ < REPS(PH_MOE2); ++rep_) if (IN(PH_MOE2)) {
            if (rep_) GRID_BAR();
            PHASE_ENV();
            MOE_TABLES((const int*)ctl + CW_SDN + l * NE);
            ProbMoe2 p; p.hid = hid; p.Wdn = wdnq + (size_t)l * NE * D * DE; p.bdn = A->in[I_BDN] + (size_t)l * NE * D; p.ys = ysl; p.rgate = rgate; p.tb.cnt = tabcnt; p.tb.pblk = tabpblk; p.tb.scl = tabscl; p.tb.eb = tabeb; p.G = G; p.c = bid;
            pg8::gemm_phase(lds, p);
        }
        GRID_BAR();
        for (int rep_ = 0; rep_ < REPS(PH_LN2); ++rep_) if (IN(PH_LN2)) {
            if (rep_) GRID_BAR();
            PHASE_ENV();
            MOE_TABLES((const int*)nullptr);
            const float* g2 = A->in[I_LN2G] + (size_t)l * D; const float* b2 = A->in[I_LN2B] + (size_t)l * D;
            typedef int i32x4 __attribute__((ext_vector_type(4)));
            const int c0 = lane * 16; const int rstep = NGW;
#define LN2_CL(rp) ((rp) < T ? (rp) : T - 1)
#define LN2_TS(rp, TS) do { TS = *(const i32x4*)(tslot + (size_t)LN2_CL(rp) * 4); } while (0)
#define LN2_LOAD(rp, TS, YV, XV, GK) do { _Pragma("unroll") for (int k = 0; k < 4; ++k) { const int idx = TS[k]; GK[k] = rgate[idx]; const int e = idx >> 15, rank = idx & (ECAP - 1); \
                        YV[k] = *(const u32x4*)(ysl + (size_t)(tabpblk[e] * 256 + rank) * D + lane * 16); } \
                    XV[0] = *(const u32x4*)(x1b + (size_t)LN2_CL(rp) * D + lane * 16); XV[1] = *(const u32x4*)(x1b + (size_t)LN2_CL(rp) * D + lane * 16 + 8); } while (0)
#define LN2_COMPUTE(rp, YV, XV, GK_) do { const int row = (rp); float v[16]; float s_ = 0.f; const float GK[4] = {GK_[0] * (1.0f / YS_SCALE), GK_[1] * (1.0f / YS_SCALE), GK_[2] * (1.0f / YS_SCALE), GK_[3] * (1.0f / YS_SCALE)}; \
                    _Pragma("unroll") for (int q = 0; q < 4; ++q) { float m0 = 0.f, m1 = 0.f, m2 = 0.f, m3 = 0.f; \
                        _Pragma("unroll") for (int k = 0; k < 4; ++k) { const f32x2 lo2 = __builtin_amdgcn_cvt_pk_f32_fp8((int)YV[k][q], false), hi2 = __builtin_amdgcn_cvt_pk_f32_fp8((int)YV[k][q], true); \
                            m0 += GK[k] * lo2[0]; m1 += GK[k] * lo2[1]; m2 += GK[k] * hi2[0]; m3 += GK[k] * hi2[1]; } \
                        const unsigned xa = XV[q >> 1][(q & 1) * 2], xb_ = XV[q >> 1][(q & 1) * 2 + 1]; \
                        v[4 * q] = bf2f(xa & 0xffffu) * ALPHA + m0; v[4 * q + 1] = bf2f(xa >> 16) * ALPHA + m1; v[4 * q + 2] = bf2f(xb_ & 0xffffu) * ALPHA + m2; v[4 * q + 3] = bf2f(xb_ >> 16) * ALPHA + m3; \
                        s_ += (v[4 * q] + v[4 * q + 1]) + (v[4 * q + 2] + v[4 * q + 3]); } \
                    const float mean = wave_sum(s_) * (1.f / D); float s2 = 0.f; \
                    _Pragma("unroll") for (int q = 0; q < 16; ++q) { v[q] -= mean; s2 += v[q] * v[q]; } \
                    const float rstd = rsqf_(wave_sum(s2) * (1.f / D) + LN_EPS); float o[16]; \
                    _Pragma("unroll") for (int q4 = 0; q4 < 4; ++q4) { const f32x4 gg = g2r[q4], bb = b2r[q4]; _Pragma("unroll") for (int i = 0; i < 4; ++i) o[4 * q4 + i] = v[4 * q4 + i] * rstd * gg[i] + bb[i]; } \
                    if (l == NL - 1) { _Pragma("unroll") for (int q4 = 0; q4 < 4; ++q4) *(f32x4*)(A->out + (size_t)row * D + c0 + 4 * q4) = (f32x4){o[4 * q4], o[4 * q4 + 1], o[4 * q4 + 2], o[4 * q4 + 3]}; } \
                    else { *(u32x4*)(xb + (size_t)row * D + c0) = (u32x4){pk2(o[0], o[1]), pk2(o[2], o[3]), pk2(o[4], o[5]), pk2(o[6], o[7])}; *(u32x4*)(xb + (size_t)row * D + c0 + 8) = (u32x4){pk2(o[8], o[9]), pk2(o[10], o[11]), pk2(o[12], o[13]), pk2(o[14], o[15])}; \
                        int q4_[4]; _Pragma("unroll") for (int qq = 0; qq < 4; ++qq) { int t_ = 0; t_ = __builtin_amdgcn_cvt_pk_fp8_f32(o[4 * qq], o[4 * qq + 1], t_, false); t_ = __builtin_amdgcn_cvt_pk_fp8_f32(o[4 * qq + 2], o[4 * qq + 3], t_, true); q4_[qq] = t_; } \
                        *(u32x4*)(xq + (size_t)row * D + c0) = (u32x4){(unsigned)q4_[0], (unsigned)q4_[1], (unsigned)q4_[2], (unsigned)q4_[3]}; } } while (0)
            f32x4 g2r[4], b2r[4];
#pragma unroll
            for (int q4 = 0; q4 < 4; ++q4) { g2r[q4] = *(const f32x4*)(g2 + c0 + 4 * q4); b2r[q4] = *(const f32x4*)(b2 + c0 + 4 * q4); }
            int rowp = gw;
            i32x4 tsA0, tsA1, tsB0, tsB1;
            u32x4 yvA0[4], xvA0[2], yvA1[4], xvA1[2], yvB0[4], xvB0[2], yvB1[4], xvB1[2]; float gkA0[4], gkA1[4], gkB0[4], gkB1[4];
            LN2_TS(rowp, tsA0); LN2_TS(rowp + rstep, tsA1); LN2_TS(rowp + 2 * rstep, tsB0); LN2_TS(rowp + 3 * rstep, tsB1);
            LN2_LOAD(rowp, tsA0, yvA0, xvA0, gkA0);
            LN2_LOAD(rowp + rstep, tsA1, yvA1, xvA1, gkA1);
            for (; rowp < T; rowp += 4 * rstep) {
                LN2_LOAD(rowp + 2 * rstep, tsB0, yvB0, xvB0, gkB0);
                LN2_LOAD(rowp + 3 * rstep, tsB1, yvB1, xvB1, gkB1);
                LN2_TS(rowp + 4 * rstep, tsA0); LN2_TS(rowp + 5 * rstep, tsA1);
                LN2_COMPUTE(rowp, yvA0, xvA0, gkA0);
                if (rowp + rstep < T) LN2_COMPUTE(rowp + rstep, yvA1, xvA1, gkA1);
                LN2_LOAD(rowp + 4 * rstep, tsA0, yvA0, xvA0, gkA0);
                LN2_LOAD(rowp + 5 * rstep, tsA1, yvA1, xvA1, gkA1);
                LN2_TS(rowp + 6 * rstep, tsB0); LN2_TS(rowp + 7 * rstep, tsB1);
                if (rowp + 2 * rstep < T) LN2_COMPUTE(rowp + 2 * rstep, yvB0, xvB0, gkB0);
                if (rowp + 3 * rstep < T) LN2_COMPUTE(rowp + 3 * rstep, yvB1, xvB1, gkB1);
            }
#undef LN2_TS
#undef LN2_CL
#undef LN2_LOAD
#undef LN2_COMPUTE
        }
        if (l + 1 < l_hi) GRID_BAR();
#undef IN
    }
}

extern "C" void kernel_launch(void* const* d_in, const int* in_sizes, int n_in, void* d_out, int out_size, void* d_ws, size_t ws_size, hipStream_t stream) {
    static int grid = 0;
    if (grid == 0) {
        if (n_in != 23 || out_size != T * D || ws_size < WS_END) { fprintf(stderr, "kernel_launch: unexpected shapes (n_in %d, out %d, ws %zu)\n", n_in, out_size, ws_size); grid = -1; return; }
        int dev = 0, cus = 0;
        if (hipGetDevice(&dev) != hipSuccess || hipDeviceGetAttribute(&cus, hipDeviceAttributeMultiprocessorCount, dev) != hipSuccess) { grid = -1; return; }
        bool ok = true;
#define SETA(k) ok = ok && (hipFuncSetAttribute((const void*)mk_fwd<k>, hipFuncAttributeMaxDynamicSharedMemorySize, LDS_BYTES) == hipSuccess)
#ifdef MULTI_LAUNCH
        SETA(0); SETA(-1); SETA(PH_PROJ); SETA(PH_HG); SETA(PH_LRUAU); SETA(PH_COMB); SETA(PH_OUTG); SETA(PH_LN1R); SETA(PH_MOE1); SETA(PH_MOE2); SETA(PH_LN2);
#else
        SETA(0);
#endif
#undef SETA
        if (!ok) { fprintf(stderr, "kernel_launch: hipFuncSetAttribute failed\n"); grid = -1; return; }
        (void)hipGetLastError();
        grid = cus;
    }
    if (grid < 0) return;
    (void)hipMemsetAsync((char*)d_ws + WS_CTL, 0, CTL_BYTES, stream);
    Args a{};
    for (int i = 0; i < 23; ++i) a.in[i] = (const float*)d_in[i];
    a.out = (float*)d_out; a.ws = (unsigned char*)d_ws;
    a.l_lo = 0; a.l_hi = NL; a.ph_lo = 0; a.ph_hi = PH_END; a.pro = 1; a.pad = 0;
#ifdef MULTI_LAUNCH
    hipLaunchKernelGGL(mk_fwd<-1>, dim3(grid), dim3(NTHR), LDS_BYTES, stream, a);
    for (int l = 0; l < NL; ++l) {
        a.l_lo = l; a.l_hi = l + 1;
        hipLaunchKernelGGL(mk_fwd<PH_PROJ>, dim3(grid), dim3(NTHR), LDS_BYTES, stream, a);
        hipLaunchKernelGGL(mk_fwd<PH_HG>, dim3(grid), dim3(NTHR), LDS_BYTES, stream, a);
        hipLaunchKernelGGL(mk_fwd<PH_LRUAU>, dim3(grid), dim3(NTHR), LDS_BYTES, stream, a);
        hipLaunchKernelGGL(mk_fwd<PH_COMB>, dim3(grid), dim3(NTHR), LDS_BYTES, stream, a);
        hipLaunchKernelGGL(mk_fwd<PH_OUTG>, dim3(grid), dim3(NTHR), LDS_BYTES, stream, a);
        hipLaunchKernelGGL(mk_fwd<PH_LN1R>, dim3(grid), dim3(NTHR), LDS_BYTES, stream, a);
        hipLaunchKernelGGL(mk_fwd<PH_MOE1>, dim3(grid), dim3(NTHR), LDS_BYTES, stream, a);
        hipLaunchKernelGGL(mk_fwd<PH_MOE2>, dim3(grid), dim3(NTHR), LDS_BYTES, stream, a);
        hipLaunchKernelGGL(mk_fwd<PH_LN2>, dim3(grid), dim3(NTHR), LDS_BYTES, stream, a);
    }
#else
    hipLaunchKernelGGL(mk_fwd<0>, dim3(grid), dim3(NTHR), LDS_BYTES, stream, a);
#endif
}
```

```cpp
#include <hip/hip_runtime.h>
#include <cstdio>
#include <cstdint>

#define GAS __attribute__((address_space(1)))
#define LAS __attribute__((address_space(3)))
typedef unsigned short bf16_t;
typedef short bf16x8 __attribute__((ext_vector_type(8)));
typedef float f32x4 __attribute__((ext_vector_type(4)));
typedef float f32x2 __attribute__((ext_vector_type(2)));
typedef unsigned u32x4 __attribute__((ext_vector_type(4)));
typedef unsigned u32x2 __attribute__((ext_vector_type(2)));

constexpr int BATCH = 8, SEQ = 4096, D = 1024, T = BATCH * SEQ, NL = 4;
constexpr int HGW = 512, LRW = 512, HGH = 4, HD = 128, LRH = 8, LHD = 64;
constexpr int INC = 3584, NE = 32, TOPK = 4, DE = 1024;
constexpr int ECAP = 32768;
constexpr int NSLOT = T * TOPK + NE * 256;
constexpr float ALPHA = 1.6817928305074290f;
constexpr float LN_EPS = 1e-5f, RMS_EPS = 1e-6f;
constexpr int NWAVES = 8, NTHR = 512;
constexpr int LDS_BYTES = 147456;

constexpr size_t MiB = 1u << 20;
constexpr size_t WS_CTL = 0, CTL_BYTES = 1 * MiB;
constexpr size_t WS_LBT = 1 * MiB;
constexpr size_t WS_RWH = 2 * MiB, WS_RWL = 3 * MiB;
constexpr size_t WS_WIN = 4 * MiB;
constexpr size_t WS_WOUT = 32 * MiB;
constexpr size_t WS_WGU = 40 * MiB;
constexpr size_t WS_WDN = 552 * MiB;
constexpr size_t WS_XB = 808 * MiB;
constexpr size_t WS_XRES = 872 * MiB;
constexpr size_t WS_PROJ = 1000 * MiB;
constexpr size_t WS_MIX = 1224 * MiB;
constexpr size_t WS_Y = 1288 * MiB;
constexpr size_t WS_X1 = 1416 * MiB;
constexpr size_t WS_X1B = 1544 * MiB;
constexpr size_t WS_HID = 1608 * MiB;
constexpr size_t WS_YS = 1880 * MiB;
constexpr size_t WS_RTOK = 2152 * MiB;
constexpr size_t WS_RGATE = 2156 * MiB;
constexpr size_t WS_TSLOT = 2160 * MiB;
constexpr size_t WS_ODIR = 2162 * MiB;
constexpr size_t WS_HDIR = 2290 * MiB;
constexpr size_t WS_AU = 2418 * MiB;
constexpr size_t WS_SFIN = 2674 * MiB;
constexpr size_t WS_DSEG = 2690 * MiB;
constexpr size_t WS_LSUM = 2691 * MiB;
constexpr size_t WS_LRUW = 2696 * MiB;
constexpr size_t WS_END = 2700 * MiB;
constexpr size_t WS_OLOC = WS_ODIR, WS_QSEG = WS_ODIR + 64 * MiB;
constexpr size_t WS_XQ = WS_XRES, WS_WINQ = WS_XRES + 64 * MiB;
constexpr size_t WS_X1Q = WS_X1;
constexpr int MIX_SHIFT = 1; constexpr float MIX_SCALE = 2.0f;
constexpr int CW_CNT = 16384, CW_SGU = 2048, CW_SDN = 2304, CW_SIN = 2560, CW_SOUT = 2624, CW_BAR = 8192;

#define LDS_WAIT() asm volatile("s_waitcnt lgkmcnt(0)" ::: "memory")
typedef __bf16 bf16x2_t __attribute__((ext_vector_type(2)));
__device__ __forceinline__ unsigned pk2(float lo, float hi) { bf16x2_t v; v[0] = (__bf16)lo; v[1] = (__bf16)hi; return __builtin_bit_cast(unsigned, v); }
__device__ __forceinline__ unsigned f2bf(float f) { return pk2(f, 0.f) & 0xffffu; }
__device__ __forceinline__ float bf2f(unsigned b) { return __builtin_bit_cast(float, b << 16); }
__device__ __forceinline__ float wave_sum(float v) {
#pragma unroll
    for (int o = 1; o < 64; o <<= 1) v += __shfl_xor(v, o);
    return v;
}
__device__ __forceinline__ float rcpf_(float x) { return __builtin_amdgcn_rcpf(x); }
__device__ __forceinline__ float rsqf_(float x) { return __builtin_amdgcn_rsqf(x); }
__device__ __forceinline__ float exp_(float x) { return __builtin_amdgcn_exp2f(x * 1.4426950408889634f); }
__device__ __forceinline__ float log_(float x) { return __builtin_amdgcn_logf(x) * 0.6931471805599453f; }
__device__ __forceinline__ float sigmoidf_(float z) { return rcpf_(1.0f + __builtin_amdgcn_exp2f(z * -1.4426950408889634f)); }
__device__ __forceinline__ float gelu_tanh_(float z) { return z * sigmoidf_(1.5957691216057308f * (z + 0.044715f * z * z * z)); }

namespace pg8 {
constexpr int BM = 256, BK = 64, HALF = 128, HTB = HALF * BK * 2, STAGE_BYTES = 8 * HTB, NXCD = 8, WGM = 8;
constexpr int KD = 1024;
__host__ __device__ __forceinline__ int lds_byte(int r, int c) { const int st = (r >> 4) * 2 + (c >> 5), rr = r & 15, cc = c & 31, ob = rr * 64 + cc * 2; return st * 1024 + (ob ^ (((ob >> 9) & 1) << 5)); }
__host__ __device__ __forceinline__ void stage_rc(int b, int& R, int& C) { const int st = b / 1024, sb = b % 1024, swz = sb ^ (((sb >> 9) & 1) << 5); R = (st >> 1) * 16 + swz / 64; C = (st & 1) * 32 + (swz % 64) / 2; }
__host__ __device__ __forceinline__ int perm32(int rho) { const int n = rho >> 4, i = rho & 15; return 8 * (i >> 2) + 4 * n + (i & 3); }
struct Unit { int pm, pn, e, j; };
typedef int i32x8 __attribute__((ext_vector_type(8)));
__device__ __forceinline__ i32x8 cat8(bf16x8 a, bf16x8 b) { const u32x4 x = __builtin_bit_cast(u32x4, a), y = __builtin_bit_cast(u32x4, b); return (i32x8){(int)x[0], (int)x[1], (int)x[2], (int)x[3], (int)y[0], (int)y[1], (int)y[2], (int)y[3]}; }
__device__ __forceinline__ unsigned cvt_pk_bf16(float lo, float hi) { return pk2(lo, hi); }

struct StaticOrder {
    int nM, nN, nwg, G, c;
    __device__ void init(int M, int N, int G_, int c_) { nM = M / BM; nN = N / BM; nwg = nM * nN; G = G_; c = c_; }
    __device__ bool next(int i, Unit& u) const {
        const long L = (long)i * G + c; if (L >= nwg) return false;
        int wgid = (int)L; { const int q = nwg / NXCD, r = nwg % NXCD, xcd = wgid % NXCD, off = wgid / NXCD; wgid = (xcd < r ? xcd * (q + 1) : r * (q + 1) + (xcd - r) * q) + off; }
        const int nig = WGM * nN, gid = wgid / nig, fm = gid * WGM, gsz = (nM - fm) < WGM ? (nM - fm) : WGM;
        u.pm = fm + ((wgid % nig) % gsz); u.pn = (wgid % nig) / gsz; u.e = 0; u.j = 0; return true;
    }
};

template <class P>
__device__ __forceinline__ void gemm_phase(LAS unsigned char* lds, const P& p) {
    int tid_l = (int)threadIdx.x; asm volatile("" : "+v"(tid_l));
    const int tid = tid_l, wid = __builtin_amdgcn_readfirstlane(tid >> 6), lane = tid & 63, wr = wid >> 2, wc = wid & 3, fr = lane & 15, fq = lane >> 4;
    constexpr int RB = P::FP8 ? KD : 2 * KD;
    constexpr int nt = RB / 128;
    unsigned voffB[2];
#pragma unroll
    for (int i = 0; i < 2; ++i) { int R, C; stage_rc(tid * 16 + i * 8192, R, C); const int r32_ = R & 31;
        const int Rb = P::WIDE ? (64 * (R >> 5) + 16 * ((r32_ & 15) >> 2) + 4 * (r32_ >> 4) + (r32_ & 3))
                             : (P::PERM ? ((R & ~31) + perm32(r32_)) : R);
        voffB[i] = (unsigned)(Rb * RB + C * 2); }
    constexpr unsigned hstepB = (unsigned)(P::WIDE ? 8 : HALF) * RB;
    const unsigned ldsw = (unsigned)wid * 1024u;
    const int aoff = lds_byte(wr * 64 + fr, fq * 8), boff = lds_byte(wc * 32 + fr, fq * 8);
    const char* const abase = p.a_base();
#define PG8_SA(b, h) (((b) * 2 + (h)) * HTB)
#define PG8_SB(b, h) ((4 + (b) * 2 + (h)) * HTB)
#define PG8_STAGE_A(bufoff, o, koff) do { _Pragma("unroll") for (int _i = 0; _i < 2; ++_i) \
        __builtin_amdgcn_global_load_lds((const unsigned*)(abase + (size_t)(o)[_i] + (koff)), (LAS unsigned*)(lds + (bufoff) + ldsw + _i * 8192), 16, 0, 0); } while (0)
#define PG8_STAGE_B(bufoff, gbase, koff) do { _Pragma("unroll") for (int _i = 0; _i < 2; ++_i) \
        __builtin_amdgcn_global_load_lds((const unsigned*)((gbase) + (size_t)(voffB[_i] + (koff))), (LAS unsigned*)(lds + (bufoff) + ldsw + _i * 8192), 16, 0, 0); } while (0)
#define PG8_LDA(dst, b, h) do { _Pragma("unroll") for (int m = 0; m < 4; ++m) _Pragma("unroll") for (int k = 0; k < 2; ++k) dst[m][k] = *(const LAS bf16x8*)(lds + PG8_SA(b, h) + aoff + m * 2048 + k * 1024); } while (0)
#define PG8_LDB(dst, b, h) do { _Pragma("unroll") for (int n = 0; n < 2; ++n) _Pragma("unroll") for (int k = 0; k < 2; ++k) dst[n][k] = *(const LAS bf16x8*)(lds + PG8_SB(b, h) + boff + n * 2048 + k * 1024); } while (0)
#define PG8_MMA(ai, bj, At, Bt) do { __builtin_amdgcn_s_setprio(1); _Pragma("unroll") for (int m = 0; m < 4; ++m) _Pragma("unroll") for (int n = 0; n < 2; ++n) { \
        if constexpr (P::FP8) { const i32x8 b8_ = cat8(Bt[n][0], Bt[n][1]), a8_ = cat8(At[m][0], At[m][1]); \
            asm volatile("v_mfma_scale_f32_16x16x128_f8f6f4 %0, %1, %2, %0, %3, %4 op_sel_hi:[0,0,0]" : "+v"(acc[ai][bj][m][n]) : "v"(b8_), "v"(a8_), "v"(sclW), "v"(sclX)); } \
        else { _Pragma("unroll") for (int k = 0; k < 2; ++k) acc[ai][bj][m][n] = __builtin_amdgcn_mfma_f32_16x16x32_bf16(Bt[n][k], At[m][k], acc[ai][bj][m][n], 0, 0, 0); } } __builtin_amdgcn_s_setprio(0); } while (0)
#define PG8_WAIT_V(n) asm volatile("s_waitcnt vmcnt(" #n ")" ::: "memory")
#define PG8_WAIT_L(n) asm volatile("s_waitcnt lgkmcnt(" #n ")" ::: "memory")
#define PG8_BAR __builtin_amdgcn_s_barrier()
#define PG8_SCHED __builtin_amdgcn_sched_barrier(0)
    Unit cur, nxt; int ui = 0; nxt.pm = nxt.pn = nxt.e = nxt.j = 0;
    if (!p.next(0, cur)) return;
    f32x4 acc[2][2][4][2];
#pragma unroll
    for (int a = 0; a < 2; ++a)
#pragma unroll
        for (int b = 0; b < 2; ++b)
#pragma unroll
            for (int m = 0; m < 4; ++m)
#pragma unroll
                for (int n = 0; n < 2; ++n) acc[a][b][m][n] = (f32x4){0.f, 0.f, 0.f, 0.f};
    bf16x8 At[4][2], B0[2][2], B1[2][2];
    unsigned oC[2][2];
    int kN[2][2];
#define PG8_RC(i, R_, C_) int R_, C_; { int t2_ = tid; asm volatile("" : "+v"(t2_)); stage_rc(t2_ * 16 + (i) * 8192, R_, C_); }
    { PG8_RC(0, R0, C0); PG8_RC(1, R1, C1); const int RR[2] = {R0, R1}; p.a_key(cur, RR, kN);
#pragma unroll
      for (int h = 0; h < 2; ++h) { oC[h][0] = (unsigned)(kN[h][0] * RB + C0 * 2); oC[h][1] = (unsigned)(kN[h][1] * RB + C1 * 2); } }
    const char* cB = p.b_base(cur);
    constexpr int BIAS_OFF = STAGE_BYTES + 2048;
    if (P::HAS_BIAS && wid == 0) p.dma_bias(cur, (LAS unsigned*)(lds + BIAS_OFF), lane);
    int sclW = p.scale_w(cur); const int sclX = p.scale_x();
    PG8_STAGE_B(PG8_SB(0, 0), cB, 0u); PG8_STAGE_B(PG8_SB(0, 1), cB + hstepB, 0u); PG8_STAGE_A(PG8_SA(0, 0), oC[0], 0u); PG8_STAGE_A(PG8_SA(0, 1), oC[1], 0u);
    if (wr == 1) PG8_BAR;
    PG8_WAIT_V(2); PG8_BAR;
    PG8_STAGE_B(PG8_SB(1, 0), cB, 128u); PG8_STAGE_A(PG8_SA(1, 0), oC[0], 128u); PG8_STAGE_B(PG8_SB(1, 1), cB + hstepB, 128u);
    PG8_WAIT_V(6); PG8_BAR;
    for (;;) {
        const bool has_next = p.next(ui + 1, nxt);
        const char* nB = cB;
        if (has_next) { PG8_RC(0, R0, C0); PG8_RC(1, R1, C1); (void)C0; (void)C1; const int RR[2] = {R0, R1}; p.a_key(nxt, RR, kN); nB = p.b_base(nxt);
            if (P::HAS_BIAS && wid == 0) p.dma_bias(nxt, (LAS unsigned*)(lds + BIAS_OFF + ((ui + 1) & 1) * 1024), lane); }
#pragma unroll 1
        for (int t = 0; t < nt; t += 2) {
            const bool last = (t == nt - 2);
            const unsigned k1 = (unsigned)(t + 1) * 128u, k2 = last ? 0u : (unsigned)(t + 2) * 128u, k3 = k2 + 128u;
            unsigned o2[2][2];
            if (last) { asm volatile("" : "+v"(kN[0][0]), "+v"(kN[0][1]), "+v"(kN[1][0]), "+v"(kN[1][1])); PG8_RC(0, R0, C0); PG8_RC(1, R1, C1); (void)R0; (void)R1;
#pragma unroll
                for (int h = 0; h < 2; ++h) { o2[h][0] = (unsigned)(kN[h][0] * RB + C0 * 2); o2[h][1] = (unsigned)(kN[h][1] * RB + C1 * 2); } }
            else {
#pragma unroll
                for (int h = 0; h < 2; ++h)
#pragma unroll
                    for (int i = 0; i < 2; ++i) o2[h][i] = oC[h][i]; }
            const char* b2 = last ? nB : cB;
            PG8_LDB(B0, 0, 0); PG8_LDB(B1, 0, 1); PG8_SCHED; PG8_LDA(At, 0, 0); PG8_STAGE_A(PG8_SA(1, 1), oC[1], k1);
            PG8_WAIT_V(8); PG8_WAIT_L(0); PG8_BAR; PG8_MMA(0, 0, At, B0); PG8_MMA(0, 1, At, B1); PG8_BAR; PG8_SCHED;
            PG8_LDA(At, 0, 1); PG8_STAGE_B(PG8_SB(0, 0), b2, k2); PG8_STAGE_B(PG8_SB(0, 1), b2 + hstepB, k2); PG8_STAGE_A(PG8_SA(0, 0), o2[0], k2);
            PG8_WAIT_V(8); PG8_WAIT_L(0); PG8_BAR; PG8_MMA(1, 0, At, B0); PG8_MMA(1, 1, At, B1); PG8_BAR; PG8_SCHED;
            PG8_LDB(B0, 1, 0); PG8_LDB(B1, 1, 1); PG8_SCHED; PG8_LDA(At, 1, 0); PG8_STAGE_A(PG8_SA(0, 1), o2[1], k2);
            PG8_WAIT_V(8); PG8_WAIT_L(0); PG8_BAR; PG8_MMA(0, 0, At, B0); PG8_MMA(0, 1, At, B1); PG8_BAR; PG8_SCHED;
            PG8_LDA(At, 1, 1); PG8_STAGE_B(PG8_SB(1, 0), b2, k3); PG8_STAGE_B(PG8_SB(1, 1), b2 + hstepB, k3); PG8_STAGE_A(PG8_SA(1, 0), o2[0], k3);
            PG8_WAIT_V(8); PG8_WAIT_L(0); PG8_BAR; PG8_MMA(1, 0, At, B0); PG8_MMA(1, 1, At, B1); PG8_BAR; PG8_SCHED;
        }
        if (wr == 0) PG8_BAR;
        if constexpr (P::FP8) asm volatile("s_nop 15\n\ts_nop 7" ::: "memory");
        p.epi(acc, cur, (const LAS float*)(lds + BIAS_OFF + (ui & 1) * 1024), wr, wc, fr, fq);
        if (!has_next) break;
#pragma unroll
        for (int a = 0; a < 2; ++a)
#pragma unroll
            for (int b = 0; b < 2; ++b)
#pragma unroll
                for (int m = 0; m < 4; ++m)
#pragma unroll
                    for (int n = 0; n < 2; ++n) acc[a][b][m][n] = (f32x4){0.f, 0.f, 0.f, 0.f};
        cur = nxt; cB = nB; ++ui; sclW = p.scale_w(cur);
        { PG8_RC(0, R0, C0); PG8_RC(1, R1, C1); (void)R0; (void)R1;
#pragma unroll
          for (int h = 0; h < 2; ++h) { oC[h][0] = (unsigned)(kN[h][0] * RB + C0 * 2); oC[h][1] = (unsigned)(kN[h][1] * RB + C1 * 2); } }
        if (wr == 1) PG8_BAR;
    }
    PG8_WAIT_V(0);
    PG8_BAR;
#undef PG8_RC
#undef PG8_SA
#undef PG8_SB
#undef PG8_STAGE_A
#undef PG8_STAGE_B
#undef PG8_LDA
#undef PG8_LDB
#undef PG8_MMA
#undef PG8_WAIT_V
#undef PG8_WAIT_L
#undef PG8_BAR
#undef PG8_SCHED
}
}

template <bool Q> struct ProbProjT {
    static constexpr bool WIDE = false;
    static constexpr bool HAS_BIAS = false; __device__ __forceinline__ void dma_bias(const pg8::Unit&, LAS unsigned*, int) const {}
    static constexpr bool PERM = true, FP8 = Q;
    __device__ __forceinline__ int scale_w(const pg8::Unit&) const { return (127 - sw) * 0x01010101; }
    __device__ __forceinline__ int scale_x() const { return (127 - sxa) * 0x01010101; }
    const void* A; const void* Bt; bf16_t* C; int ldc; int sw; int sxa = 0; pg8::StaticOrder S;
    __device__ __forceinline__ bool next(int i, pg8::Unit& u) const { return S.next(i, u); }
    __device__ __forceinline__ const char* a_base() const { return (const char*)A; }
    __device__ __forceinline__ void a_key(const pg8::Unit& u, const int (&R)[2], int (&k)[2][2]) const {
#pragma unroll
        for (int h = 0; h < 2; ++h)
#pragma unroll
            for (int i = 0; i < 2; ++i) k[h][i] = u.pm * 256 + h * 128 + R[i];
    }
    __device__ __forceinline__ const char* b_base(const pg8::Unit& u) const { return (const char*)Bt + (size_t)u.pn * 256 * pg8::KD * (Q ? 1 : 2); }
    __device__ __forceinline__ void epi(const f32x4 (&acc)[2][2][4][2], const pg8::Unit& u, const LAS float*, int wr, int wc, int fr, int fq) const {
        const int row0 = u.pm * 256 + wr * 64 + fr, col0 = u.pn * 256 + wc * 32 + 8 * fq;
#pragma unroll
        for (int ai = 0; ai < 2; ++ai)
#pragma unroll
            for (int m = 0; m < 4; ++m) { bf16_t* rowp = C + (size_t)(row0 + ai * 128 + m * 16) * ldc + col0;
#pragma unroll
                for (int bj = 0; bj < 2; ++bj) { const f32x4 v0 = acc[ai][bj][m][0], v1 = acc[ai][bj][m][1];
                    u32x4 w; w.x = pg8::cvt_pk_bf16(v0[0], v0[1]); w.y = pg8::cvt_pk_bf16(v0[2], v0[3]); w.z = pg8::cvt_pk_bf16(v1[0], v1[1]); w.w = pg8::cvt_pk_bf16(v1[2], v1[3]);
                    *(u32x4*)(rowp + bj * 128) = w; } }
    }
};
struct ProbOut {
    static constexpr bool WIDE = false;
    static constexpr bool HAS_BIAS = false; __device__ __forceinline__ void dma_bias(const pg8::Unit&, LAS unsigned*, int) const {}
    static constexpr bool PERM = false, FP8 = false;
    __device__ __forceinline__ int scale_w(const pg8::Unit&) const { return 0; }
    __device__ __forceinline__ int scale_x() const { return 0; }
    const bf16_t* A; const bf16_t* Bt; float* C; pg8::StaticOrder S;
    __device__ __forceinline__ bool next(int i, pg8::Unit& u) const { return S.next(i, u); }
    __device__ __forceinline__ const char* a_base() const { return (const char*)A; }
    __device__ __forceinline__ void a_key(const pg8::Unit& u, const int (&R)[2], int (&k)[2][2]) const {
#pragma unroll
        for (int h = 0; h < 2; ++h)
#pragma unroll
            for (int i = 0; i < 2; ++i) k[h][i] = u.pm * 256 + h * 128 + R[i];
    }
    __device__ __forceinline__ const char* b_base(const pg8::Unit& u) const { return (const char*)Bt + (size_t)u.pn * 256 * pg8::KD * 2; }
    __device__ __forceinline__ void epi(const f32x4 (&acc)[2][2][4][2], const pg8::Unit& u, const LAS float*, int wr, int wc, int fr, int fq) const {
        const int row0 = u.pm * 256 + wr * 64 + fr, col0 = u.pn * 256 + wc * 32 + 4 * fq;
#pragma unroll
        for (int ai = 0; ai < 2; ++ai)
#pragma unroll
            for (int m = 0; m < 4; ++m) { float* rowp = C + (size_t)(row0 + ai * 128 + m * 16) * D + col0;
#pragma unroll
                for (int bj = 0; bj < 2; ++bj)
#pragma unroll
                    for (int n = 0; n < 2; ++n) *(f32x4*)(rowp + bj * 128 + n * 16) = acc[ai][bj][m][n]; }
    }
};
struct MoeTab { const LAS int* cnt; const LAS int* pblk; const LAS int* scl; const LAS unsigned short* eb; };
__device__ __forceinline__ bool moe_next(const MoeTab& tb, int npn, int G, int c, int i, pg8::Unit& u) {
    const int nb = tb.pblk[32]; int blk, pn;
    if (G == 256) {
        const int x = c & 7, q = c >> 3, npnh = npn >> 2, tau = 8 * i + x, sr = tau / npnh, pnh = tau - sr * npnh;
        blk = sr * 8 + (q & 7); pn = pnh * 4 + (q >> 3); if (blk >= nb) return false;
    } else { const long L = (long)i * G + c; if (L >= (long)nb * npn) return false; blk = (int)(L / npn); pn = (int)(L % npn); }
    const int e = tb.eb[blk];
    u.e = __builtin_amdgcn_readfirstlane(e); u.pm = __builtin_amdgcn_readfirstlane(blk); u.pn = __builtin_amdgcn_readfirstlane(pn); u.j = u.pm - tb.pblk[u.e]; u.j = __builtin_amdgcn_readfirstlane(u.j);
    return true;
}
constexpr float YS_SCALE = 8.0f;
constexpr float HID_SCALE = 4.0f; constexpr int HID_SCALE_LOG2 = 2;
struct ProbMoe1 {
    static constexpr bool WIDE = false;
    static constexpr bool HAS_BIAS = true;
    __device__ __forceinline__ void dma_bias(const pg8::Unit& u, LAS unsigned* slot, int lane) const {
        const float* src = bgu + (size_t)u.e * 2048 + u.pn * 128 + (lane < 32 ? 4 * lane : 1024 + 4 * (lane - 32)); __builtin_amdgcn_global_load_lds((const unsigned*)src, slot, 16, 0, 0); }
    static constexpr bool PERM = true, FP8 = true;
    const unsigned char* X; const unsigned char* Wgu; const float* bgu; unsigned char* hid; const int* rtok; MoeTab tb; int G, c;
    __device__ __forceinline__ int scale_w(const pg8::Unit& u) const { return (127 - tb.scl[u.e]) * 0x01010101; }
    __device__ __forceinline__ int scale_x() const { return 0x7f7f7f7f; }
    __device__ __forceinline__ bool next(int i, pg8::Unit& u) const { return moe_next(tb, 8, G, c, i, u); }
    __device__ __forceinline__ const char* a_base() const { return (const char*)X; }
    __device__ __forceinline__ void a_key(const pg8::Unit& u, const int (&R)[2], int (&k)[2][2]) const {
        const int n1 = tb.cnt[u.e] - 1;
#pragma unroll
        for (int h = 0; h < 2; ++h)
#pragma unroll
            for (int i = 0; i < 2; ++i) { const int rank = u.j * 256 + h * 128 + R[i]; k[h][i] = rtok[u.e * ECAP + (rank < n1 ? rank : n1)]; }
    }
    __device__ __forceinline__ const char* b_base(const pg8::Unit& u) const { return (const char*)Wgu + ((size_t)u.e * 2048 + (size_t)u.pn * 256) * pg8::KD; }
    __device__ __forceinline__ void epi(const f32x4 (&acc)[2][2][4][2], const pg8::Unit& u, const LAS float* bs, int wr, int wc, int fr, int fq) const {
        const int row0 = u.pm * 256 + wr * 64 + fr, col0 = u.pn * 128 + wc * 32 + 8 * fq; const int cl = wc * 32 + 8 * fq;
        const f32x4 bg0 = *(const LAS f32x4*)(bs + cl), bg1 = *(const LAS f32x4*)(bs + cl + 4), bu0 = *(const LAS f32x4*)(bs + 128 + cl), bu1 = *(const LAS f32x4*)(bs + 128 + cl + 4);
#pragma unroll
        for (int ai = 0; ai < 2; ++ai)
#pragma unroll
            for (int m = 0; m < 4; ++m) {
                float hv[8];
#pragma unroll
                for (int n = 0; n < 2; ++n) { const f32x4 g4 = acc[ai][0][m][n] + (n ? bg1 : bg0), u4 = acc[ai][1][m][n] + (n ? bu1 : bu0);
#pragma unroll
                    for (int q = 0; q < 4; q += 2) {
                        f32x2 g = {fminf(g4[q], 7.0f), fminf(g4[q + 1], 7.0f)}, up = {__builtin_amdgcn_fmed3f(u4[q], -7.0f, 7.0f), __builtin_amdgcn_fmed3f(u4[q + 1], -7.0f, 7.0f)};
                        const f32x2 ar = g * (f32x2){-1.702f * 1.4426950408889634f, -1.702f * 1.4426950408889634f};
                        f32x2 den = {__builtin_amdgcn_exp2f(ar[0]), __builtin_amdgcn_exp2f(ar[1])}; den = den + (f32x2){1.0f, 1.0f};
                        const f32x2 sg = {__builtin_amdgcn_rcpf(den[0]), __builtin_amdgcn_rcpf(den[1])};
                        const f32x2 r = (up * (f32x2){HID_SCALE, HID_SCALE} + (f32x2){HID_SCALE, HID_SCALE}) * (g * sg);
                        hv[n * 4 + q] = r[0]; hv[n * 4 + q + 1] = r[1]; } }
                int w0 = 0, w1 = 0;
                w0 = __builtin_amdgcn_cvt_pk_fp8_f32(hv[0], hv[1], w0, false); w0 = __builtin_amdgcn_cvt_pk_fp8_f32(hv[2], hv[3], w0, true);
                w1 = __builtin_amdgcn_cvt_pk_fp8_f32(hv[4], hv[5], w1, false); w1 = __builtin_amdgcn_cvt_pk_fp8_f32(hv[6], hv[7], w1, true);
                *(u32x2*)(hid + (size_t)(row0 + ai * 128 + m * 16) * DE + col0) = (u32x2){(unsigned)w0, (unsigned)w1}; }
    }
};
struct ProbMoe2 {
    static constexpr bool WIDE = true;
    static constexpr bool HAS_BIAS = true;
    __device__ __forceinline__ void dma_bias(const pg8::Unit& u, LAS unsigned* slot, int lane) const { __builtin_amdgcn_global_load_lds((const unsigned*)(bdn + (size_t)u.e * 1024 + u.pn * 256 + 4 * lane), slot, 16, 0, 0); }
    static constexpr bool PERM = true, FP8 = true;
    const unsigned char* hid; const unsigned char* Wdn; const float* bdn; unsigned char* ys; const float* rgate; MoeTab tb; int G, c;
    __device__ __forceinline__ int scale_w(const pg8::Unit& u) const { return (127 - tb.scl[u.e]) * 0x01010101; }
    __device__ __forceinline__ int scale_x() const { return (127 - HID_SCALE_LOG2) * 0x01010101; }
    __device__ __forceinline__ bool next(int i, pg8::Unit& u) const { return moe_next(tb, 4, G, c, i, u); }
    __device__ __forceinline__ const char* a_base() const { return (const char*)hid; }
    __device__ __forceinline__ void a_key(const pg8::Unit& u, const int (&R)[2], int (&k)[2][2]) const {
#pragma unroll
        for (int h = 0; h < 2; ++h)
#pragma unroll
            for (int i = 0; i < 2; ++i) k[h][i] = u.pm * 256 + h * 128 + R[i];
    }
    __device__ __forceinline__ const char* b_base(const pg8::Unit& u) const { return (const char*)Wdn + ((size_t)u.e * 1024 + (size_t)u.pn * 256) * pg8::KD; }
    __device__ __forceinline__ void epi(const f32x4 (&acc)[2][2][4][2], const pg8::Unit& u, const LAS float* bs, int wr, int wc, int fr, int fq) const {
        const int row0 = u.pm * 256 + wr * 64 + fr, col0 = u.pn * 256 + wc * 64 + 16 * fq; const int cl = wc * 64 + 16 * fq;
        f32x4 bv[2][2];
#pragma unroll
        for (int bj = 0; bj < 2; ++bj)
#pragma unroll
            for (int n = 0; n < 2; ++n) bv[bj][n] = *(const LAS f32x4*)(bs + cl + 8 * bj + 4 * n) * YS_SCALE;
#pragma unroll
        for (int ai = 0; ai < 2; ++ai)
#pragma unroll
            for (int m = 0; m < 4; ++m) { int w4[4];
#pragma unroll
                for (int bj = 0; bj < 2; ++bj)
#pragma unroll
                    for (int n = 0; n < 2; ++n) { const f32x4 v = acc[ai][bj][m][n] * YS_SCALE + bv[bj][n]; int t_ = 0; t_ = __builtin_amdgcn_cvt_pk_fp8_f32(v[0], v[1], t_, false); t_ = __builtin_amdgcn_cvt_pk_fp8_f32(v[2], v[3], t_, true); w4[bj * 2 + n] = t_; }
                *(u32x4*)(ys + (size_t)(row0 + ai * 128 + m * 16) * D + col0) = (u32x4){(unsigned)w4[0], (unsigned)w4[1], (unsigned)w4[2], (unsigned)w4[3]}; }
    }
};

constexpr int HA_QH = 0, HA_KH = 8704, HA_QT = 17408, HA_KT = 26112, HA_VT = 36352, HA_DEC = 46592, HA_OPB = 47104;
constexpr int HA_ST = 2 * HA_OPB, HA_P = HA_ST + 34816, HA_TOT = HA_P + 2560;
__device__ __forceinline__ void hg_phase_a(LAS unsigned char* lds, int item, int l, const bf16_t* proj, const float* lbt, bf16_t* oloc, bf16_t* qseg, float* sfin, float* dseg) {
    int tid_l = (int)threadIdx.x; asm volatile("" : "+v"(tid_l));
    const int tid = tid_l, lane = tid & 63, w = __builtin_amdgcn_readfirstlane(tid >> 6), fr = lane & 15, fq = lane >> 4;
    const int seg = item & 3, dir = (item >> 2) & 1, h = (item >> 3) & 3, b = item >> 5;
    const int d0 = 2 * lane;
    const f32x2 lb2 = *(const f32x2*)(lbt + (size_t)l * 2 * HGW + dir * HGW + h * 128 + d0); const f32x2 omlb2 = (f32x2){1.0f, 1.0f} - lb2;
    LAS float* tot = (LAS float*)(lds + HA_TOT);
    __syncthreads();
    { unsigned z_ = 0u; asm volatile("" : "+v"(z_));
      for (int i = tid; i < 34816 / 16; i += NTHR) *(LAS u32x4*)(lds + HA_ST + i * 16) = (u32x4){z_, z_, z_, z_}; }
    f32x4 accS[8];
#pragma unroll
    for (int i = 0; i < 8; ++i) accS[i] = (f32x4){0.f, 0.f, 0.f, 0.f};
    float Gc[2] = {0.f, 0.f};
    unsigned rq[4], ri[4], rf[4];
    float cs[2][4], kk[2][4], qq[2][4]; unsigned vv[4];
    const unsigned colq2_ = (unsigned)(h * 128 + d0) * 2u;
    const unsigned oloff_ = ((unsigned)(dir ? 15 - fr : fr) * (unsigned)HGW + (unsigned)(h * 128 + w * 16 + 4 * fq)) * 2u;
#define HG_ROW(c, p) ((unsigned)(b * SEQ + (dir ? (SEQ - 1 - (seg * 1024 + (c) * 32 + (p))) : (seg * 1024 + (c) * 32 + (p)))))
#define HG_LOAD(c) do { unsigned colq2 = colq2_; asm volatile("" : "+v"(colq2)); _Pragma("unroll") for (int i = 0; i < 4; ++i) { const char* rp_ = (const char*)proj + (size_t)HG_ROW(c, 4 * w + i) * (INC * 2); const char* rpf_ = rp_ + (size_t)dir * 1024; \
            rq[i] = *(const unsigned*)(rp_ + colq2); ri[i] = *(const unsigned*)(rp_ + (colq2 + 1024u)); rf[i] = *(const unsigned*)(rpf_ + (colq2 + 2048u)); } } while (0)
#define HG_E1() do { f32x2 run2; _Pragma("unroll") for (int e = 0; e < 2; ++e) { float run = 0.f; const float lb = lb2[e], omlb = omlb2[e]; \
            _Pragma("unroll") for (int i = 0; i < 4; ++i) { const float z = e ? bf2f(rf[i] >> 16) : bf2f(rf[i] & 0xffffu), sg = sigmoidf_(z); const float f = lb + omlb * sg; run += log_(f); cs[e][i] = run; kk[e][i] = omlb * (1.0f - sg); \
                const float zq = e ? bf2f(rq[i] >> 16) : bf2f(rq[i] & 0xffffu); qq[e][i] = zq * sigmoidf_(zq); } run2[e] = run; } \
            _Pragma("unroll") for (int i = 0; i < 4; ++i) vv[i] = ri[i]; *(LAS f32x2*)(tot + w * 128 + d0) = run2; } while (0)
#define HG_E2(c, ob) do { unsigned colq2 = colq2_; asm volatile("" : "+v"(colq2)); f32x2 off = {0.f, 0.f}, gref = {0.f, 0.f}, glast = {0.f, 0.f}; \
          _Pragma("unroll") for (int g_ = 0; g_ < 8; ++g_) { const f32x2 t_ = *(const LAS f32x2*)(tot + g_ * 128 + d0); if (g_ < w) off += t_; if (g_ < 4) gref += t_; glast += t_; } \
          float egref[2], eglr[2], egc[2]; _Pragma("unroll") for (int e = 0; e < 2; ++e) { egref[e] = exp_(gref[e]); eglr[e] = exp_(glast[e] - gref[e]); egc[e] = exp_(gref[e] + Gc[e]); } \
          float kt[2][4]; \
          _Pragma("unroll") for (int i = 0; i < 4; ++i) { const int p = 4 * w + i; float qh[2], kh[2]; \
              _Pragma("unroll") for (int e = 0; e < 2; ++e) { const float g = off[e] + cs[e][i]; const float e1 = exp_(g - gref[e]), e2 = rcpf_(e1); qh[e] = qq[e][i] * e1; kh[e] = kk[e][i] * e2; kt[e][i] = kh[e] * eglr[e]; } \
              *(LAS unsigned*)(lds + (ob) + HA_QH + p * 272 + d0 * 2) = pk2(qh[0], qh[1]); *(LAS unsigned*)(lds + (ob) + HA_KH + p * 272 + d0 * 2) = pk2(kh[0], kh[1]); \
              *(LAS unsigned*)(lds + (ob) + HA_QT + p * 272 + d0 * 2) = pk2(qh[0] * egref[0], qh[1] * egref[1]); *(unsigned*)((char*)qseg + (size_t)((unsigned)dir * T + HG_ROW(c, p)) * (HGW * 2) + colq2) = pk2(qh[0] * egc[0], qh[1] * egc[1]); } \
          _Pragma("unroll") for (int e = 0; e < 2; ++e) { \
              *(LAS u32x2*)(lds + (ob) + HA_KT + (d0 + e) * 80 + w * 8) = (u32x2){pk2(kt[e][0], kt[e][1]), pk2(kt[e][2], kt[e][3])}; \
              *(LAS u32x2*)(lds + (ob) + HA_VT + (d0 + e) * 80 + w * 8) = e ? (u32x2){(vv[0] >> 16) | (vv[1] & 0xffff0000u), (vv[2] >> 16) | (vv[3] & 0xffff0000u)} : (u32x2){(vv[0] & 0xffffu) | (vv[1] << 16), (vv[2] & 0xffffu) | (vv[3] << 16)}; } \
          if (w == 0) *(LAS f32x2*)(lds + (ob) + HA_DEC + d0 * 4) = (f32x2){exp_(glast[0]), exp_(glast[1])}; Gc[0] += glast[0]; Gc[1] += glast[1]; } while (0)
    HG_LOAD(0);
    HG_E1();
    HG_LOAD(1);
    __syncthreads();
    HG_E2(0, 0);
#define HG_XM() do { \
        if (w < 4) { const int tt = w >> 1, st = w & 1; f32x4 sc = (f32x4){0.f, 0.f, 0.f, 0.f}; \
            if (st <= tt) { \
        _Pragma("unroll") \
                for (int ks = 0; ks < 4; ++ks) { const bf16x8 a = *(const LAS bf16x8*)(lds + ob + HA_QH + (tt * 16 + fr) * 272 + ks * 64 + fq * 16), bb = *(const LAS bf16x8*)(lds + ob + HA_KH + (st * 16 + fr) * 272 + ks * 64 + fq * 16); \
                    sc = __builtin_amdgcn_mfma_f32_16x16x32_bf16(a, bb, sc, 0, 0, 0); } } \
        _Pragma("unroll") \
            for (int r = 0; r < 4; ++r) { const int t = tt * 16 + 4 * fq + r, s_ = st * 16 + fr; *(LAS unsigned short*)(lds + HA_P + t * 80 + s_ * 2) = (unsigned short)((s_ <= t) ? f2bf(sc[r]) : 0u); } } \
        _Pragma("unroll") \
        for (int ks = 0; ks < 4; ++ks) { const bf16x8 bs = *(const LAS bf16x8*)(lds + HA_ST + (w * 16 + fr) * 272 + ks * 64 + fq * 16); \
        _Pragma("unroll") \
            for (int tt = 0; tt < 2; ++tt) { const bf16x8 a = *(const LAS bf16x8*)(lds + ob + HA_QT + (tt * 16 + fr) * 272 + ks * 64 + fq * 16); ao[tt] = __builtin_amdgcn_mfma_f32_16x16x32_bf16(bs, a, ao[tt], 0, 0, 0); } } \
    } while (0)
#define HG_YM() do { \
        { const bf16x8 bv = *(const LAS bf16x8*)(lds + ob + HA_VT + (w * 16 + fr) * 80 + fq * 16); unsigned oloff = oloff_; asm volatile("" : "+v"(oloff)); \
        _Pragma("unroll") \
          for (int tt = 0; tt < 2; ++tt) { const bf16x8 a = *(const LAS bf16x8*)(lds + HA_P + (tt * 16 + fr) * 80 + fq * 16); ao[tt] = __builtin_amdgcn_mfma_f32_16x16x32_bf16(bv, a, ao[tt], 0, 0, 0); \
              const unsigned srow = dir ? HG_ROW(c, tt * 16 + 15) : HG_ROW(c, tt * 16); *(u32x2*)((char*)oloc + (size_t)((unsigned)dir * T + srow) * (HGW * 2) + oloff) = (u32x2){pk2(ao[tt][0], ao[tt][1]), pk2(ao[tt][2], ao[tt][3])}; } } \
        { const bf16x8 ak = *(const LAS bf16x8*)(lds + ob + HA_KT + (w * 16 + fr) * 80 + fq * 16); \
          const f32x4 dv = *(const LAS f32x4*)(lds + ob + HA_DEC + (w * 16 + 4 * fq) * 4); \
          bf16x8 bvs[8]; \
        _Pragma("unroll") \
          for (int vt = 0; vt < 8; ++vt) bvs[vt] = *(const LAS bf16x8*)(lds + ob + HA_VT + (vt * 16 + fr) * 80 + fq * 16); \
        _Pragma("unroll") \
          for (int vt = 0; vt < 8; ++vt) accS[vt] = accS[vt] * dv; \
        _Pragma("unroll") \
          for (int vt = 0; vt < 8; ++vt) accS[vt] = __builtin_amdgcn_mfma_f32_16x16x32_bf16(ak, bvs[vt], accS[vt], 0, 0, 0); \
        _Pragma("unroll") \
          for (int vt = 0; vt < 8; ++vt) { u32x2 sw; sw.x = pk2(accS[vt][0], accS[vt][1]); sw.y = pk2(accS[vt][2], accS[vt][3]); \
              *(LAS u32x2*)(lds + HA_ST + (vt * 16 + fr) * 272 + (w * 16 + 4 * fq) * 2) = sw; } } \
    } while (0)
    for (int c = 0; c < 32; ++c) {
        const int ob = (c & 1) * HA_OPB, obn = ((c + 1) & 1) * HA_OPB;
        __syncthreads();
        f32x4 ao[2] = {(f32x4){0.f, 0.f, 0.f, 0.f}, (f32x4){0.f, 0.f, 0.f, 0.f}};
        if (w < 4) { HG_XM(); HG_E1(); } else { HG_E1(); HG_XM(); }
        { const int cn_ = c + 2 < 32 ? c + 2 : 31; HG_LOAD(cn_); }
        __syncthreads();
        if (w < 4) { HG_YM(); if (c + 1 < 32) HG_E2(c + 1, obn); } else { if (c + 1 < 32) HG_E2(c + 1, obn); HG_YM(); }
    }
#undef HG_XM
#undef HG_YM
#undef HG_ROW
#undef HG_LOAD
#undef HG_E1
#undef HG_E2
#pragma unroll
    for (int vt = 0; vt < 8; ++vt) *(f32x4*)(sfin + (size_t)item * 16384 + (size_t)(vt * 16 + fr) * 128 + w * 16 + 4 * fq) = accS[vt];
    if (w == 0) *(f32x2*)(dseg + (size_t)item * 128 + d0) = (f32x2){exp_(Gc[0]), exp_(Gc[1])};
    __syncthreads();
}

__device__ __forceinline__ void hg_phase_c(LAS unsigned char* lds, int cb, int l, const bf16_t* proj, const bf16_t* oloc, const bf16_t* qseg, const float* sfin, const float* dseg, const float* hgn, bf16_t* mix) {
    int tid_l = (int)threadIdx.x; asm volatile("" : "+v"(tid_l));
    const int tid = tid_l, lane = tid & 63, w = __builtin_amdgcn_readfirstlane(tid >> 6), fr = lane & 15, fq = lane >> 4;
    const int half = cb & 1, segtok = (cb >> 1) & 3, h = (cb >> 3) & 3, b = cb >> 5;
    __syncthreads();
#pragma unroll
    for (int dir = 0; dir < 2; ++dir) { const int k = dir ? 3 - segtok : segtok; const int item0 = ((b * 4 + h) * 2 + dir) * 4;
        f32x4 s0[8], s1[8], s2[8], d1[8], d2[8];
#pragma unroll
        for (int i = 0; i < 8; ++i) { const int e4 = tid + NTHR * i; const int v = e4 >> 5, d0 = (e4 & 31) * 4; const size_t so = (size_t)v * 128 + d0;
            s0[i] = k > 0 ? *(const f32x4*)(sfin + (size_t)(item0 + 0) * 16384 + so) : (f32x4){0.f, 0.f, 0.f, 0.f};
            s1[i] = k > 1 ? *(const f32x4*)(sfin + (size_t)(item0 + 1) * 16384 + so) : (f32x4){0.f, 0.f, 0.f, 0.f};
            s2[i] = k > 2 ? *(const f32x4*)(sfin + (size_t)(item0 + 2) * 16384 + so) : (f32x4){0.f, 0.f, 0.f, 0.f};
            d1[i] = k > 1 ? *(const f32x4*)(dseg + (size_t)(item0 + 1) * 128 + d0) : (f32x4){1.f, 1.f, 1.f, 1.f};
            d2[i] = k > 2 ? *(const f32x4*)(dseg + (size_t)(item0 + 2) * 128 + d0) : (f32x4){1.f, 1.f, 1.f, 1.f}; }
#pragma unroll
        for (int i = 0; i < 8; ++i) { const int e4 = tid + NTHR * i; const int v = e4 >> 5, d0 = (e4 & 31) * 4; f32x4 cv = s0[i];
            if (k > 1) cv = cv * d1[i] + s1[i];
            if (k > 2) cv = cv * d2[i] + s2[i];
            u32x2 cw; cw.x = pk2(cv[0], cv[1]); cw.y = pk2(cv[2], cv[3]); *(LAS u32x2*)(lds + dir * 34816 + v * 272 + d0 * 2) = cw; } }
    __syncthreads();
    f32x4 gnv[8];
#pragma unroll
    for (int vt = 0; vt < 8; ++vt) gnv[vt] = *(const f32x4*)(hgn + h * 128 + vt * 16 + 4 * fq);
    const int kf = segtok, kb = 3 - segtok;
#pragma unroll 1
    for (int tile = 0; tile < 4; ++tile) {
        const int t = segtok * 1024 + (half * 4 + tile) * 128 + w * 16 + fr; const size_t row = (size_t)b * SEQ + t;
        bf16x8 bq[2][4]; u32x2 olf[8], olb[8], zgv[8];
#pragma unroll
        for (int dir = 0; dir < 2; ++dir)
#pragma unroll
            for (int ks = 0; ks < 4; ++ks) bq[dir][ks] = *(const bf16x8*)(qseg + ((size_t)dir * T + row) * HGW + h * 128 + ks * 32 + fq * 8);
#pragma unroll
        for (int vt = 0; vt < 8; ++vt) { const int v0 = vt * 16 + 4 * fq; olf[vt] = *(const u32x2*)(oloc + (size_t)row * HGW + h * 128 + v0); olb[vt] = *(const u32x2*)(oloc + ((size_t)T + row) * HGW + h * 128 + v0);
            zgv[vt] = *(const u32x2*)(proj + row * INC + 2048 + h * 128 + v0); }
        f32x4 acc[8];
#pragma unroll
        for (int i = 0; i < 8; ++i) acc[i] = (f32x4){0.f, 0.f, 0.f, 0.f};
#pragma unroll
        for (int dir = 0; dir < 2; ++dir) { const int k = dir ? kb : kf;
            if (k > 0) {
#pragma unroll
                for (int ks = 0; ks < 4; ++ks) {
#pragma unroll
                    for (int vt = 0; vt < 8; ++vt) { const bf16x8 ac = *(const LAS bf16x8*)(lds + dir * 34816 + (vt * 16 + fr) * 272 + ks * 64 + fq * 16); acc[vt] = __builtin_amdgcn_mfma_f32_16x16x32_bf16(ac, bq[dir][ks], acc[vt], 0, 0, 0); } } } }
        float ss = 0.f;
#pragma unroll
        for (int vt = 0; vt < 8; ++vt) { const u32x2 of = olf[vt], ob = olb[vt];
            acc[vt][0] += bf2f(of.x & 0xffffu) + bf2f(ob.x & 0xffffu); acc[vt][1] += bf2f(of.x >> 16) + bf2f(ob.x >> 16); acc[vt][2] += bf2f(of.y & 0xffffu) + bf2f(ob.y & 0xffffu); acc[vt][3] += bf2f(of.y >> 16) + bf2f(ob.y >> 16);
            ss += (acc[vt][0] * acc[vt][0] + acc[vt][1] * acc[vt][1]) + (acc[vt][2] * acc[vt][2] + acc[vt][3] * acc[vt][3]); }
        ss += __shfl_xor(ss, 16); ss += __shfl_xor(ss, 32);
        const float rs = rsqf_(ss * (1.0f / 128.f) + RMS_EPS);
#pragma unroll
        for (int vt = 0; vt < 8; ++vt) { const int v0 = vt * 16 + 4 * fq; const u32x2 zg = zgv[vt]; const f32x4 gn = gnv[vt];
            const float z0 = bf2f(zg.x & 0xffffu), z1 = bf2f(zg.x >> 16), z2 = bf2f(zg.y & 0xffffu), z3 = bf2f(zg.y >> 16);
            const float rs2 = rs * MIX_SCALE; int q_ = 0; q_ = __builtin_amdgcn_cvt_pk_fp8_f32(acc[vt][0] * rs2 * gn[0] * (z0 * sigmoidf_(z0)), acc[vt][1] * rs2 * gn[1] * (z1 * sigmoidf_(z1)), q_, false);
            q_ = __builtin_amdgcn_cvt_pk_fp8_f32(acc[vt][2] * rs2 * gn[2] * (z2 * sigmoidf_(z2)), acc[vt][3] * rs2 * gn[3] * (z3 * sigmoidf_(z3)), q_, true);
            *(int*)((unsigned char*)mix + row * D + h * 128 + v0) = q_; }
    }
}

constexpr int LR_XC = 0, LR_CAR = 65536, LR_RED = 73728, LR_HS = 75776;
template <int MODE>
__device__ __forceinline__ void lru_pair(LAS unsigned char* lds, int b, int kpair, const bf16_t* proj, const float* cw, const float* cbias, const bf16_t* lruw_l, const float* ba_l, const float* bx_l, const float* lam_l, float* lsum, const float* lrn, bf16_t* mix) {
    int tid_l = (int)threadIdx.x; asm volatile("" : "+v"(tid_l));
    const int tid = tid_l, lane = tid & 63, w = __builtin_amdgcn_readfirstlane(tid >> 6), fr = lane & 15, fq = lane >> 4;
    __syncthreads();
    if (MODE == 1) {
        const int c0 = tid, k0s = 2 * kpair; float cf = 0.f, cbk = 0.f;
        const float* Af = lsum + ((size_t)(0 * 2 + 0) * BATCH + b) * 64 * LRW + c0; const float* Hf = lsum + ((size_t)(0 * 2 + 1) * BATCH + b) * 64 * LRW + c0;
        const float* Ab = lsum + ((size_t)(1 * 2 + 0) * BATCH + b) * 64 * LRW + c0; const float* Hb = lsum + ((size_t)(1 * 2 + 1) * BATCH + b) * 64 * LRW + c0;
        for (int k0 = 0; k0 < k0s; k0 += 16) { float av[16], hv[16];
#pragma unroll
            for (int q = 0; q < 16; ++q) { const int kk = k0 + q; const bool ok = kk < k0s; av[q] = ok ? Af[(size_t)kk * LRW] : 1.0f; hv[q] = ok ? Hf[(size_t)kk * LRW] : 0.0f; }
#pragma unroll
            for (int q = 0; q < 16; ++q) cf = av[q] * cf + hv[q]; }
        for (int k0 = 63; k0 > k0s + 1; k0 -= 16) { float av[16], hv[16];
#pragma unroll
            for (int q = 0; q < 16; ++q) { const int kk = k0 - q; const bool ok = kk > k0s + 1; av[q] = ok ? Ab[(size_t)kk * LRW] : 1.0f; hv[q] = ok ? Hb[(size_t)kk * LRW] : 0.0f; }
#pragma unroll
            for (int q = 0; q < 16; ++q) cbk = av[q] * cbk + hv[q]; }
        LAS float* car = (LAS float*)(lds + LR_CAR);
        car[(0 * 2 + 0) * 512 + c0] = cf; car[(1 * 2 + 0) * 512 + c0] = Af[(size_t)k0s * LRW] * cf + Hf[(size_t)k0s * LRW];
        car[(1 * 2 + 1) * 512 + c0] = cbk; car[(0 * 2 + 1) * 512 + c0] = Ab[(size_t)(k0s + 1) * LRW] * cbk + Hb[(size_t)(k0s + 1) * LRW];
    }
#pragma unroll 1
    for (int sub = 0; sub < 2; ++sub) {
        const int ksub = 2 * kpair + sub; const size_t row0 = (size_t)b * SEQ + (size_t)ksub * 64;
        if (sub) __syncthreads();
        { const int cp = (tid & 255) * 2, th = tid >> 8; const int t0 = ksub * 64 + th * 32;
          const f32x2 w0 = *(const f32x2*)(cw + cp), w1 = *(const f32x2*)(cw + LRW + cp), w2 = *(const f32x2*)(cw + 2 * LRW + cp), w3 = *(const f32x2*)(cw + 3 * LRW + cp), bs = *(const f32x2*)(cbias + cp);
          const bf16_t* zp = proj + ((size_t)b * SEQ + t0) * INC + 2560 + cp;
          unsigned zr[35];
#pragma unroll
          for (int q = 0; q < 35; ++q) { const bool edge = (q < 2) || (q == 34); const bool ok = (q < 2) ? (t0 != 0) : (t0 + 32 < SEQ);
              const long ro = edge ? (ok ? (long)(q - 2) : 0L) : (long)(q - 2); const unsigned zv = *(const unsigned*)(zp + ro * INC); zr[q] = (edge && !ok) ? 0u : zv; }
          const int hd = cp >> 6, ii = cp & 63;
#pragma unroll
          for (int q = 0; q < 32; ++q) { const int tl = th * 32 + q;
              const float x0 = bs[0] + w0[0] * bf2f(zr[q] & 0xffffu) + w1[0] * bf2f(zr[q + 1] & 0xffffu) + w2[0] * bf2f(zr[q + 2] & 0xffffu) + w3[0] * bf2f(zr[q + 3] & 0xffffu);
              const float x1 = bs[1] + w0[1] * bf2f(zr[q] >> 16) + w1[1] * bf2f(zr[q + 1] >> 16) + w2[1] * bf2f(zr[q + 2] >> 16) + w3[1] * bf2f(zr[q + 3] >> 16);
              *(LAS unsigned*)(lds + LR_XC + hd * 8192 + tl * 128 + ((((ii >> 3) ^ (tl & 7))) << 4) + (ii & 7) * 2) = pk2(x0, x1); } }
        __syncthreads();
        float ssq[16];
#pragma unroll
        for (int k = 0; k < 16; ++k) ssq[k] = 0.f;
        bf16x8 bw[2][4]; float cst[2][3];
#pragma unroll
        for (int q_ = 0; q_ < 4; ++q_) bw[1][q_] = (bf16x8){0, 0, 0, 0, 0, 0, 0, 0};
        cst[1][0] = cst[1][1] = cst[1][2] = 0.f;
#define LR_LOADW(it, buf) do { const int jt_ = (it) >> 1, dir_ = (it) & 1, j_ = jt_ * 16 + fr, c_ = w * 64 + j_; \
            _Pragma("unroll") for (int ks_ = 0; ks_ < 2; ++ks_) { bw[buf][ks_ * 2 + 0] = *(const bf16x8*)(lruw_l + ((size_t)((dir_ * 2 + 0) * LRH + w) * 64 + j_) * 64 + ks_ * 32 + fq * 8); \
                                                                  bw[buf][ks_ * 2 + 1] = *(const bf16x8*)(lruw_l + ((size_t)((dir_ * 2 + 1) * LRH + w) * 64 + j_) * 64 + ks_ * 32 + fq * 8); } \
            cst[buf][0] = ba_l[dir_ * LRW + c_]; cst[buf][1] = bx_l[dir_ * LRW + c_]; cst[buf][2] = lam_l[dir_ * LRW + c_]; } while (0)
        LR_LOADW(0, 0);
#pragma unroll 1
        for (int jt = 0; jt < 4; ++jt) {
            const int j = jt * 16 + fr, c = w * 64 + j;
            float xcv[16], hsum[16];
#pragma unroll
            for (int k = 0; k < 16; ++k) { const int tl = 16 * fq + k; xcv[k] = bf2f(*(const LAS unsigned short*)(lds + LR_XC + w * 8192 + tl * 128 + ((((j >> 3) ^ (tl & 7))) << 4) + (j & 7) * 2)); }
#pragma unroll
            for (int dir = 0; dir < 2; ++dir) {
                constexpr int dummy = 0; (void)dummy;
                const int it = jt * 2 + dir; constexpr int dummy2 = 0; (void)dummy2; const int buf = dir;
                { const int itn_ = (it + 1 < 8) ? it + 1 : 7; LR_LOADW(itn_, dir ^ 1); }
                const float bav = cst[buf][0], bxv = cst[buf][1], lamv = cst[buf][2];
                const float sp8 = -8.0f * ((lamv < -20.f) ? -lamv : log_(1.0f + exp_(-lamv)));
                f32x4 aR[4], aI[4];
#pragma unroll
                for (int tt = 0; tt < 4; ++tt) { aR[tt] = (f32x4){0.f, 0.f, 0.f, 0.f}; aI[tt] = (f32x4){0.f, 0.f, 0.f, 0.f}; }
#pragma unroll
                for (int ks = 0; ks < 2; ++ks) {
#pragma unroll
                    for (int tt = 0; tt < 4; ++tt) { const int tla = 16 * (fr >> 2) + 4 * tt + (fr & 3); const bf16x8 av = *(const LAS bf16x8*)(lds + LR_XC + w * 8192 + tla * 128 + ((((ks * 4 + fq) ^ (tla & 7))) << 4));
                        aR[tt] = __builtin_amdgcn_mfma_f32_16x16x32_bf16(av, bw[buf][ks * 2 + 0], aR[tt], 0, 0, 0); aI[tt] = __builtin_amdgcn_mfma_f32_16x16x32_bf16(av, bw[buf][ks * 2 + 1], aI[tt], 0, 0, 0); } }
                float hl[16], pc[16]; float hh = 0.f, pp = 1.0f;
                { constexpr float NL2E = -1.4426950408889634f; const f32x2 nl2 = {NL2E, NL2E}, one2 = {1.0f, 1.0f}, bar2 = {bav * NL2E, bav * NL2E}, bxr2 = {bxv * NL2E, bxv * NL2E}, spl2 = {sp8 * -NL2E, sp8 * -NL2E};
#pragma unroll
                  for (int k = 0; k < 16; k += 2) { const int tt = k >> 2, r = k & 3;
                    const f32x2 er = (f32x2){aR[tt][r], aR[tt][r + 1]} * nl2 + bar2, ei = (f32x2){aI[tt][r], aI[tt][r + 1]} * nl2 + bxr2;
                    const f32x2 dr = (f32x2){__builtin_amdgcn_exp2f(er[0]), __builtin_amdgcn_exp2f(er[1])} + one2, di = (f32x2){__builtin_amdgcn_exp2f(ei[0]), __builtin_amdgcn_exp2f(ei[1])} + one2;
                    const f32x2 rr = {__builtin_amdgcn_rcpf(dr[0]), __builtin_amdgcn_rcpf(dr[1])}, ig = {__builtin_amdgcn_rcpf(di[0]), __builtin_amdgcn_rcpf(di[1])};
                    const f32x2 ea = rr * spl2; const f32x2 a = {__builtin_amdgcn_exp2f(ea[0]), __builtin_amdgcn_exp2f(ea[1])};
                    const f32x2 om = one2 - a * a; const f32x2 sq = {__builtin_amdgcn_sqrtf(__builtin_fabsf(om[0])), __builtin_amdgcn_sqrtf(__builtin_fabsf(om[1]))};
                    const f32x2 u = sq * (ig * (f32x2){xcv[k], xcv[k + 1]});
                    pc[k] = a[0]; pc[k + 1] = a[1]; hl[k] = u[0]; hl[k + 1] = u[1]; } }
#pragma unroll
                for (int kk = 0; kk < 16; ++kk) { const int k = dir ? 15 - kk : kk; hh = pc[k] * hh + hl[k]; pp = pp * pc[k]; hl[k] = hh; pc[k] = pp; }
                const float P0 = __shfl(pp, fr), P1 = __shfl(pp, fr + 16), P2 = __shfl(pp, fr + 32), P3 = __shfl(pp, fr + 48);
                const float H0 = __shfl(hh, fr), H1 = __shfl(hh, fr + 16), H2 = __shfl(hh, fr + 32), H3 = __shfl(hh, fr + 48);
                float cin, pin, Ht, At;
                if (dir == 0) { const float c1 = H0, c2 = P1 * c1 + H1, c3 = P2 * c2 + H2; const float p1 = P0, p2 = P0 * P1, p3 = p2 * P2;
                    cin = fq == 0 ? 0.f : (fq == 1 ? c1 : (fq == 2 ? c2 : c3)); pin = fq == 0 ? 1.0f : (fq == 1 ? p1 : (fq == 2 ? p2 : p3)); Ht = P3 * c3 + H3; At = p3 * P3; }
                else { const float c2 = H3, c1 = P2 * c2 + H2, c0_ = P1 * c1 + H1; const float p2 = P3, p1 = P3 * P2, p0 = p1 * P1;
                    cin = fq == 3 ? 0.f : (fq == 2 ? c2 : (fq == 1 ? c1 : c0_)); pin = fq == 3 ? 1.0f : (fq == 2 ? p2 : (fq == 1 ? p1 : p0)); Ht = P0 * c0_ + H0; At = p0 * P0; }
                if (MODE == 0) { if (fq == 0) { lsum[(((size_t)(dir * 2 + 0) * BATCH + b) * 64 + ksub) * LRW + c] = At; lsum[(((size_t)(dir * 2 + 1) * BATCH + b) * 64 + ksub) * LRW + c] = Ht; } }
                else { const float ein = cin + pin * ((const LAS float*)(lds + LR_CAR))[(sub * 2 + dir) * 512 + c];
#pragma unroll
                    for (int k = 0; k < 16; ++k) { const float hv = hl[k] + pc[k] * ein; hsum[k] = dir ? hsum[k] + hv : hv; } }
            }
            if (MODE == 1) {
#pragma unroll
                for (int k = 0; k < 16; ++k) { ssq[k] += hsum[k] * hsum[k]; *(LAS unsigned short*)(lds + LR_HS + (16 * fq + k) * 1024 + c * 2) = (unsigned short)f2bf(hsum[k]); }
            }
        }
#undef LR_LOADW
        if (MODE == 1) {
            LAS float* red = (LAS float*)(lds + LR_RED);
#pragma unroll
            for (int k = 0; k < 16; ++k) {
#define LR_DPP_ADD(ctrl) ssq[k] += __builtin_bit_cast(float, __builtin_amdgcn_update_dpp(0, __builtin_bit_cast(int, ssq[k]), ctrl, 0xf, 0xf, false))
                LR_DPP_ADD(0xB1); LR_DPP_ADD(0x4E); LR_DPP_ADD(0x141); LR_DPP_ADD(0x140);
#undef LR_DPP_ADD
            }
            if (fr == 0) {
#pragma unroll
                for (int k = 0; k < 16; ++k) red[w * 64 + 16 * fq + k] = ssq[k]; }
            __syncthreads();
#pragma unroll 2
            for (int i = 0; i < 8; ++i) { const int idx = tid + NTHR * i, tk = idx >> 6, c8 = (idx & 63) * 8; float t_ = 0.f;
#pragma unroll
                for (int ww = 0; ww < 8; ++ww) t_ += red[ww * 64 + tk];
                const float rs = rsqf_(t_ * (1.0f / 512.f) + RMS_EPS);
                const u32x4 hw = *(const LAS u32x4*)(lds + LR_HS + tk * 1024 + c8 * 2); const size_t row = row0 + tk; const u32x4 zw = *(const u32x4*)(proj + row * INC + 3072 + c8);
                const f32x4 g0 = *(const f32x4*)(lrn + c8), g1 = *(const f32x4*)(lrn + c8 + 4); int ow[2] = {0, 0}; const float rs2 = rs * MIX_SCALE;
#pragma unroll
                for (int q = 0; q < 4; ++q) { float hv[2] = {bf2f(hw[q] & 0xffffu), bf2f(hw[q] >> 16)}, zz[2] = {bf2f(zw[q] & 0xffffu), bf2f(zw[q] >> 16)}, rr[2];
#pragma unroll
                    for (int e2 = 0; e2 < 2; ++e2) { const int cc = 2 * q + e2; rr[e2] = hv[e2] * rs2 * (cc < 4 ? g0[cc] : g1[cc - 4]) * gelu_tanh_(zz[e2]); }
                    ow[q >> 1] = (q & 1) ? __builtin_amdgcn_cvt_pk_fp8_f32(rr[0], rr[1], ow[q >> 1], true) : __builtin_amdgcn_cvt_pk_fp8_f32(rr[0], rr[1], ow[q >> 1], false); }
                *(u32x2*)((unsigned char*)mix + row * D + 512 + c8) = (u32x2){(unsigned)ow[0], (unsigned)ow[1]}; }
        }
    }
}

#define XB_TMO      128
#define XB_XCNT(j)  (256  + 64 * (j))
#define XB_XSUB(j)  (1280 + 64 * (j))
#define XB_XGEN(j)  (2304 + 64 * (j))
#define XB_TOP      3328
#define XB_TOPGEN   3392
#define XCD_BAR_WORDS 3456
#define XB_SPIN_CAP (1u << 18)
__device__ __forceinline__ unsigned xb_ld(unsigned* p)              { return __hip_atomic_load(p, __ATOMIC_RELAXED, __HIP_MEMORY_SCOPE_AGENT); }
__device__ __forceinline__ unsigned xb_add(unsigned* p, unsigned v) { return __hip_atomic_fetch_add(p, v, __ATOMIC_RELAXED, __HIP_MEMORY_SCOPE_AGENT); }
__device__ __forceinline__ unsigned xb_xcc_id() { return (unsigned)__builtin_amdgcn_s_getreg((3 << 11) | 20) & 0xFu; }
#define XB_SPIN(cond, bar) do { unsigned _sp = 0; while (cond) { __builtin_amdgcn_s_sleep(1); \
    if ((++_sp & 255u) == 0u) { if (xb_ld(&(bar)[XB_TMO])) break; if (_sp > XB_SPIN_CAP) { atomicAdd(&(bar)[XB_TMO], 1u); break; } } } } while (0)
struct XcdBarrier { unsigned* bar; unsigned x; volatile LAS unsigned* st; };
__device__ __forceinline__ XcdBarrier xcd_barrier_post(unsigned* bar, volatile LAS unsigned* st) {
    XcdBarrier b; b.bar = bar; b.x = xb_xcc_id(); b.st = st;
    if (threadIdx.x == 0) (void)xb_add(&bar[XB_XCNT(b.x)], 1u);
    return b;
}
__device__ __forceinline__ void xcd_barrier_complete(unsigned* bar, unsigned x, unsigned& nloc, unsigned& nx) {
    const unsigned G = gridDim.x * gridDim.y * gridDim.z;
    unsigned sum, cnt, mine, sp = 0u;
    for (;;) {
        sum = 0u; cnt = 0u; mine = 0u;
#pragma unroll
        for (unsigned j = 0; j < 16; ++j) { const unsigned c = xb_ld(&bar[XB_XCNT(j)]); sum += c; cnt += (c > 0u) ? 1u : 0u; mine = (j == x) ? c : mine; }
        if (sum == G) break;
        __builtin_amdgcn_s_sleep(1);
        if ((++sp & 255u) == 0u) { if (xb_ld(&bar[XB_TMO])) break; if (sp > XB_SPIN_CAP) { atomicAdd(&bar[XB_TMO], 1u); break; } }
    }
    nloc = mine > 0u ? mine : 1u; nx = cnt > 0u ? cnt : 1u;
}
__device__ __forceinline__ void xcd_barrier(const XcdBarrier& b_in) {
    XcdBarrier b = b_in; asm volatile("" : "+s"(b.bar), "+s"(b.x));
    asm volatile("s_waitcnt vmcnt(0)" ::: "memory");
    __syncthreads();
    if (threadIdx.x == 0) {
        unsigned* bar = b.bar;
        __builtin_amdgcn_s_waitcnt(0);
        unsigned nloc = b.st[0], nx = b.st[1];
        if (nloc == 0u) { xcd_barrier_complete(bar, b.x, nloc, nx); b.st[0] = nloc; b.st[1] = nx; }
        const unsigned old = xb_add(&bar[XB_XSUB(b.x)], 1u);
        const unsigned gen = old / nloc;
        if (old + 1u == (gen + 1u) * nloc) {
            __builtin_amdgcn_fence(__ATOMIC_RELEASE, "agent");
            asm volatile("s_waitcnt vmcnt(0)" ::: "memory");
            const unsigned og = xb_add(&bar[XB_TOP], 1u);
            const unsigned tg = og / nx;
            if (og + 1u == (tg + 1u) * nx) xb_add(&bar[XB_TOPGEN], 1u);
            else XB_SPIN(xb_ld(&bar[XB_TOPGEN]) == tg, bar);
            __builtin_amdgcn_fence(__ATOMIC_ACQUIRE, "agent");
            xb_add(&bar[XB_XGEN(b.x)], 1u);
            asm volatile("s_waitcnt vmcnt(0)" ::: "memory");
        } else {
            XB_SPIN(xb_ld(&bar[XB_XGEN(b.x)]) == gen, bar);
            __builtin_amdgcn_fence(__ATOMIC_ACQUIRE, "agent");
            asm volatile("s_waitcnt vmcnt(0)" ::: "memory");
        }
    }
    __syncthreads();
}

struct Args { const float* in[23]; float* out; unsigned char* ws; int l_lo, l_hi, ph_lo, ph_hi, pro, pad; };
enum { I_X = 0, I_WIN, I_HGLB, I_HGNORM, I_CONVW, I_CONVB, I_WA, I_BA, I_WX, I_BX, I_LAM, I_LRUNORM, I_WOUT, I_LN1G, I_LN1B, I_RW, I_RB, I_WGU, I_BGU, I_WDN, I_BDN, I_LN2G, I_LN2B };
enum { PH_PROJ = 1, PH_HG = 2, PH_LRUAU = 3, PH_LRUSCAN = 4, PH_COMB = 5, PH_OUTG = 6, PH_LN1R = 7, PH_MOE1 = 8, PH_MOE2 = 9, PH_LN2 = 10, PH_END = 11 };

__device__ __forceinline__ void transpose_item(const float* W, int N, int k0, int n0, bf16_t* WT, size_t dst_row0, int KP, LAS float* scr, int lane) {
#pragma unroll 8
    for (int i = 0; i < 32; ++i) { const int kk = 2 * i + (lane >> 5); scr[kk * 33 + (lane & 31)] = W[(size_t)(k0 + kk) * N + n0 + (lane & 31)]; }
    LDS_WAIT(); asm volatile("" ::: "memory");
    const int c = lane & 7;
#pragma unroll
    for (int j = 0; j < 4; ++j) { const int n = (lane >> 3) + 8 * j; const LAS float* s = scr + (8 * c) * 33 + n;
        u32x4 o; o.x = pk2(s[0 * 33], s[1 * 33]); o.y = pk2(s[2 * 33], s[3 * 33]); o.z = pk2(s[4 * 33], s[5 * 33]); o.w = pk2(s[6 * 33], s[7 * 33]);
        *(u32x4*)(WT + (dst_row0 + n) * KP + k0 + 8 * c) = o; }
    LDS_WAIT(); asm volatile("" ::: "memory");
}

__device__ __forceinline__ void transpose_item_q(const float* W, int N, int k0, int n0, unsigned char* WT, size_t dst_row0, int KP, float mul, LAS float* scr, int lane) {
#pragma unroll 8
    for (int i = 0; i < 32; ++i) { const int kk = 2 * i + (lane >> 5); scr[kk * 33 + (lane & 31)] = W[(size_t)(k0 + kk) * N + n0 + (lane & 31)]; }
    LDS_WAIT(); asm volatile("" ::: "memory");
    const int c = lane & 7;
#pragma unroll
    for (int j = 0; j < 4; ++j) { const int n = (lane >> 3) + 8 * j; const LAS float* s = scr + (8 * c) * 33 + n; int w0 = 0, w1 = 0;
        w0 = __builtin_amdgcn_cvt_pk_fp8_f32(s[0 * 33] * mul, s[1 * 33] * mul, w0, false); w0 = __builtin_amdgcn_cvt_pk_fp8_f32(s[2 * 33] * mul, s[3 * 33] * mul, w0, true);
        w1 = __builtin_amdgcn_cvt_pk_fp8_f32(s[4 * 33] * mul, s[5 * 33] * mul, w1, false); w1 = __builtin_amdgcn_cvt_pk_fp8_f32(s[6 * 33] * mul, s[7 * 33] * mul, w1, true);
        *(u32x2*)(WT + (dst_row0 + n) * KP + k0 + 8 * c) = (u32x2){(unsigned)w0, (unsigned)w1}; }
    LDS_WAIT(); asm volatile("" ::: "memory");
}
__device__ __forceinline__ void transpose_item_q2(const float* W, int N, int k0, int n0, unsigned char* WT, size_t dst_row0, int KP, float mul, LAS float* scr, int lane) {
#pragma unroll 8
    for (int i = 0; i < 32; ++i) { const int kk = 4 * i + (lane >> 4), n = lane & 15; scr[n * 132 + kk] = W[(size_t)(k0 + kk) * N + n0 + n]; }
    LDS_WAIT(); asm volatile("" ::: "memory");
    const int c = lane & 15;
#pragma unroll
    for (int j = 0; j < 4; ++j) { const int n = (lane >> 4) + 4 * j; const f32x4 a = *(const LAS f32x4*)(scr + n * 132 + 8 * c), b = *(const LAS f32x4*)(scr + n * 132 + 8 * c + 4); int w0 = 0, w1 = 0;
        w0 = __builtin_amdgcn_cvt_pk_fp8_f32(a[0] * mul, a[1] * mul, w0, false); w0 = __builtin_amdgcn_cvt_pk_fp8_f32(a[2] * mul, a[3] * mul, w0, true);
        w1 = __builtin_amdgcn_cvt_pk_fp8_f32(b[0] * mul, b[1] * mul, w1, false); w1 = __builtin_amdgcn_cvt_pk_fp8_f32(b[2] * mul, b[3] * mul, w1, true);
        *(u32x2*)(WT + (dst_row0 + n) * KP + k0 + 8 * c) = (u32x2){(unsigned)w0, (unsigned)w1}; }
    LDS_WAIT(); asm volatile("" ::: "memory");
}
__device__ __forceinline__ int fp8_scale_exp(const float* W, int stride, int lane) {
    float a = 0.f;
#pragma unroll
    for (int q = 0; q < 8; ++q) a += fabsf(W[(size_t)(lane * 8 + q) * stride]);
    a = wave_sum(a) * (1.0f / 512.f);
    int s = (a > 0.f) ? (int)rintf(-log2f(a)) : 0; return s < -24 ? -24 : (s > 24 ? 24 : s);
}

typedef const __attribute__((address_space(4))) Args* CArgs;
#define PHASE_ENV() \
    CArgs A = (CArgs)__builtin_amdgcn_kernarg_segment_ptr(); asm volatile("" : "+s"(A)); \
    int tid_l_ = (int)threadIdx.x, bid_l_ = (int)blockIdx.x, G_l_ = (int)gridDim.x; asm volatile("" : "+v"(tid_l_), "+s"(bid_l_), "+s"(G_l_)); \
    const int tid = tid_l_, lane = tid & 63, wave = __builtin_amdgcn_readfirstlane(tid >> 6), G = G_l_, bid = bid_l_, gw = bid * NWAVES + wave, NGW = G * NWAVES; (void)lane; (void)gw; (void)NGW; \
    unsigned char* ws = A->ws; \
    unsigned* ctl = (unsigned*)(ws + WS_CTL); (void)ctl; \
    float* lbt = (float*)(ws + WS_LBT); (void)lbt; \
    bf16_t* rwh = (bf16_t*)(ws + WS_RWH); bf16_t* rwl = (bf16_t*)(ws + WS_RWL); (void)rwh; (void)rwl; \
    bf16_t* win_t = (bf16_t*)(ws + WS_WIN); bf16_t* wout_t = (bf16_t*)(ws + WS_WOUT); bf16_t* wgu_t = (bf16_t*)(ws + WS_WGU); bf16_t* wdn_t = (bf16_t*)(ws + WS_WDN); (void)win_t; (void)wout_t; (void)wgu_t; (void)wdn_t; \
    bf16_t* xb = (bf16_t*)(ws + WS_XB); float* xres = (float*)(ws + WS_XRES); bf16_t* proj = (bf16_t*)(ws + WS_PROJ); bf16_t* mix = (bf16_t*)(ws + WS_MIX); (void)xb; (void)xres; (void)proj; (void)mix; \
    float* ybuf = (float*)(ws + WS_Y); bf16_t* ybf = (bf16_t*)(ws + WS_Y); (void)ybf; float* x1 = (float*)(ws + WS_X1); bf16_t* x1b = (bf16_t*)(ws + WS_X1B); unsigned char* hid = ws + WS_HID; unsigned char* wguq = ws + WS_WGU; unsigned char* wdnq = ws + WS_WDN; unsigned char* x1q = ws + WS_X1Q; unsigned char* xq = ws + WS_XQ; unsigned char* winq = ws + WS_WINQ; (void)xq; (void)winq; (void)wguq; (void)wdnq; (void)x1q; unsigned char* ysl = ws + WS_YS; (void)ybuf; (void)x1; (void)x1b; (void)hid; (void)ysl; \
    int* rtok = (int*)(ws + WS_RTOK); float* rgate = (float*)(ws + WS_RGATE); int* tslot = (int*)(ws + WS_TSLOT); (void)rtok; (void)rgate; (void)tslot; \
    float* odir = (float*)(ws + WS_ODIR); float* hdir = (float*)(ws + WS_HDIR); float* aub = (float*)(ws + WS_AU); (void)odir; (void)hdir; (void)aub; \
    bf16_t* oloc = (bf16_t*)(ws + WS_OLOC); bf16_t* qseg = (bf16_t*)(ws + WS_QSEG); float* sfin = (float*)(ws + WS_SFIN); float* dseg = (float*)(ws + WS_DSEG); float* lsum = (float*)(ws + WS_LSUM); bf16_t* lruw = (bf16_t*)(ws + WS_LRUW); (void)oloc; (void)qseg; (void)sfin; (void)dseg; (void)lsum; (void)lruw; \
    const float* xin = (l == 0) ? A->in[I_X] : (const float*)xres; float* xout = (l == NL - 1) ? A->out : xres; unsigned* cntg = ctl + CW_CNT + 1024 * l; (void)xin; (void)xout; (void)cntg

#define MOE_TABLES(sclp) do { __syncthreads(); \
    if (tid < 32) { tabcnt[tid] = (int)__hip_atomic_load(cntg + 32 * tid, __ATOMIC_RELAXED, __HIP_MEMORY_SCOPE_AGENT); tabscl[tid] = (sclp) ? ((const int*)(sclp))[tid] : 0; } \
    __syncthreads(); \
    if (tid == 0) { int s_ = 0; for (int e_ = 0; e_ < 32; ++e_) { tabpblk[e_] = s_; s_ += (tabcnt[e_] + 255) >> 8; } tabpblk[32] = s_; } \
    __syncthreads(); \
    for (int i_ = tid; i_ < tabpblk[32] && i_ < 1024; i_ += NTHR) { int e_ = 0; for (int q2_ = 1; q2_ < 32; ++q2_) e_ += (tabpblk[q2_] <= i_) ? 1 : 0; tabeb[i_] = (unsigned short)e_; }     \
    __syncthreads(); } while (0)

template <int PH> __global__ void __launch_bounds__(NTHR, 2) mk_fwd(Args args) {
    extern __shared__ __attribute__((aligned(16))) unsigned char lds_raw[];
    LAS unsigned char* lds = (LAS unsigned char*)lds_raw;
    const int tid = threadIdx.x, lane = tid & 63, wave = __builtin_amdgcn_readfirstlane(tid >> 6);
    const int G = gridDim.x, bid = blockIdx.x;
    const int gw = bid * NWAVES + wave, NGW = G * NWAVES;
    LAS int* tabcnt = (LAS int*)(lds + 131072 + 1024); LAS int* tabpblk = (LAS int*)(lds + 131072 + 1024 + 256); LAS int* tabscl = (LAS int*)(lds + 131072 + 1024 + 512); LAS unsigned short* tabeb = (LAS unsigned short*)(lds + 131072 + 6144);
    XcdBarrier bar; bar.bar = nullptr; bar.x = 0; bar.st = nullptr;
    if (PH == 0) {
        volatile LAS unsigned* bst = (volatile LAS unsigned*)(lds + LDS_BYTES - 16);
        if (tid == 0) { bst[0] = 0u; bst[1] = 0u; }
        __syncthreads();
        bar = xcd_barrier_post((unsigned*)(args.ws + WS_CTL) + CW_BAR, bst);
    }
#define GRID_BAR() do { if (PH == 0) xcd_barrier(bar); } while (0)
#ifndef PROBE_REP
#define PROBE_REP 0
#endif
#define REPS(k) (((PROBE_REP >> (k)) & 1) ? 2 : 1)

    for (int rep_ = 0; rep_ < REPS(0); ++rep_) if (PH == -1 || PH == 0) {
        const int l = 0; PHASE_ENV();
        LAS float* scr = (LAS float*)(lds + wave * 16384);
        { constexpr int per = 8 * 224; for (int it = gw; it < NL * per; it += NGW) { const int ll = it / per, r = it % per, kb = r / 224, nb = r % 224; const float* src = A->in[I_WIN] + (size_t)ll * D * INC;
            const int sx = fp8_scale_exp(src, 7177, lane); if (r == 0 && lane == 0) ((int*)ctl)[CW_SIN + ll] = sx;
            transpose_item_q2(src, INC, kb * 128, nb * 16, winq + (size_t)ll * INC * D, (size_t)nb * 16, D, exp2f((float)sx), scr, lane); } }
        { constexpr int per = 16 * 32; for (int it = gw; it < NL * per; it += NGW) { const int ll = it / per, r = it % per, kb = r / 32, nb = r % 32;
            const float* src = A->in[I_WOUT] + (size_t)ll * D * D; const int sx = fp8_scale_exp(src, 2039, lane); if (r == 0 && lane == 0) ((int*)ctl)[CW_SOUT + ll] = sx;
            transpose_item_q(src, D, kb * 64, nb * 32, (unsigned char*)wout_t + (size_t)ll * D * D, (size_t)nb * 32, D, exp2f((float)sx), scr, lane); } }
        for (int pe = gw >> 4; pe < NL * NE; pe += NGW >> 4) { const float* src = A->in[I_WGU] + (size_t)pe * D * 2048; const int sx = fp8_scale_exp(src, 4099, lane); const float mul = exp2f((float)sx);
            if ((gw & 15) == 0 && lane == 0) ((int*)ctl)[CW_SGU + pe] = sx;
            for (int r = gw & 15; r < 8 * 128; r += 16) { const int kb = r / 128, nb = r % 128; const int n0 = nb * 16, cc = n0 & 1023, isup = n0 >> 10; const size_t drow = (size_t)(cc >> 7) * 256 + (size_t)isup * 128 + (cc & 127);
                transpose_item_q2(src, 2048, kb * 128, n0, wguq + (size_t)pe * 2048 * D, drow, D, mul, scr, lane); } }
        for (int pe = gw >> 4; pe < NL * NE; pe += NGW >> 4) { const float* src = A->in[I_WDN] + (size_t)pe * DE * D; const int sx = fp8_scale_exp(src, 2051, lane); const float mul = exp2f((float)sx);
            if ((gw & 15) == 0 && lane == 0) ((int*)ctl)[CW_SDN + pe] = sx;
            for (int r = gw & 15; r < 8 * 64; r += 16) { const int kb = r / 64, nb = r % 64;
                transpose_item_q2(src, D, kb * 128, nb * 16, wdnq + (size_t)pe * D * DE, (size_t)nb * 16, DE, mul, scr, lane); } }
        for (int i = bid * NTHR + tid; i < NL * NE * D; i += G * NTHR) { const int ll = i / (NE * D), r = i % (NE * D), e = r / D, d = r % D; const float w = A->in[I_RW][(size_t)ll * D * NE + (size_t)d * NE + e];
            const unsigned h = f2bf(w); rwh[i] = (bf16_t)h; rwl[i] = (bf16_t)f2bf(w - bf2f(h)); }
        for (int i = bid * NTHR + tid; i < NL * 2 * 2 * LRH * LHD * LHD; i += G * NTHR) { const int ii = i & 63, jj = (i >> 6) & 63, hh = (i >> 12) & 7, wh = (i >> 15) & 1, dl = i >> 16;
            const float* src = wh ? A->in[I_WX] : A->in[I_WA]; lruw[i] = (bf16_t)f2bf(src[((size_t)dl * LRH + hh) * LHD * LHD + (size_t)ii * LHD + jj]); }
        for (size_t i = (size_t)bid * NTHR + tid; i < (size_t)T * D / 4; i += (size_t)G * NTHR) { const f32x4 v = ((const f32x4*)A->in[I_X])[i]; u32x2 o; o.x = pk2(v[0], v[1]); o.y = pk2(v[2], v[3]); ((u32x2*)xb)[i] = o; int q_ = 0; q_ = __builtin_amdgcn_cvt_pk_fp8_f32(v[0], v[1], q_, false); q_ = __builtin_amdgcn_cvt_pk_fp8_f32(v[2], v[3], q_, true); ((int*)xq)[i] = q_; }
        for (int i = bid * NTHR + tid; i < 2 * HGW; i += G * NTHR) { const float* p = A->in[I_HGLB] + i; float v[NL], mx = -3.0e38f;
#pragma unroll
            for (int q = 0; q < NL; ++q) { v[q] = p[(size_t)q * 2 * HGW]; mx = fmaxf(mx, v[q]); }
            float s = 0.f;
#pragma unroll
            for (int q = 0; q < NL; ++q) { v[q] = expf(v[q] - mx); s += v[q]; }
            float cum = 0.f;
#pragma unroll
            for (int q = 0; q < NL; ++q) { if (q > 0) cum += v[q] / s; lbt[(size_t)q * 2 * HGW + i] = fminf(fmaxf(cum, 0.f), 1.0f - 1e-6f); } }
    }
    GRID_BAR();

    const int l_lo = (PH == 0) ? 0 : args.l_lo, l_hi = (PH == 0) ? NL : args.l_hi;
    for (int l = l_lo; l < l_hi; ++l) {
#define IN(k) (PH == 0 || PH == (k))

        for (int rep_ = 0; rep_ < REPS(PH_PROJ); ++rep_) if (IN(PH_PROJ)) {
            if (rep_) GRID_BAR();
            PHASE_ENV();
            ProbProjT<true> p; p.A = xq; p.Bt = winq + (size_t)l * INC * D; p.sw = ((const int*)ctl)[CW_SIN + l]; p.C = proj; p.ldc = INC; p.S.init(T, INC, G, bid);
            pg8::gemm_phase(lds, p);
        }
        GRID_BAR();
        for (int rep_ = 0; rep_ < REPS(PH_HG); ++rep_) if (IN(PH_HG)) {
            if (rep_) GRID_BAR();
            PHASE_ENV();
            for (int item = bid; item < 256; item += G) hg_phase_a(lds, item, l, proj, lbt, oloc, qseg, sfin, dseg);
        }
        for (int rep_ = 0; rep_ < REPS(PH_LRUAU); ++rep_) if (IN(PH_LRUAU)) {
            if (rep_) GRID_BAR();
            PHASE_ENV();
            for (int it = bid; it < BATCH * 32; it += G)
                lru_pair<0>(lds, it >> 5, it & 31, proj, A->in[I_CONVW] + (size_t)l * 4 * LRW, A->in[I_CONVB] + (size_t)l * LRW, lruw + (size_t)l * 2 * 2 * LRH * LHD * LHD,
                               A->in[I_BA] + (size_t)l * 2 * LRW, A->in[I_BX] + (size_t)l * 2 * LRW, A->in[I_LAM] + (size_t)l * 2 * LRW, lsum, nullptr, nullptr);
        }
        GRID_BAR();
        for (int rep_ = 0; rep_ < REPS(PH_COMB); ++rep_) if (IN(PH_COMB)) {
            if (rep_) GRID_BAR();
            PHASE_ENV();
            const float* hgn = A->in[I_HGNORM] + (size_t)l * HGW;
            for (int cb = bid; cb < 256; cb += G) hg_phase_c(lds, cb, l, proj, oloc, qseg, sfin, dseg, hgn, mix);
            for (int it = bid; it < BATCH * 32; it += G)
                lru_pair<1>(lds, it >> 5, it & 31, proj, A->in[I_CONVW] + (size_t)l * 4 * LRW, A->in[I_CONVB] + (size_t)l * LRW, lruw + (size_t)l * 2 * 2 * LRH * LHD * LHD,
                               A->in[I_BA] + (size_t)l * 2 * LRW, A->in[I_BX] + (size_t)l * 2 * LRW, A->in[I_LAM] + (size_t)l * 2 * LRW, lsum, A->in[I_LRUNORM] + (size_t)l * LRW, mix);
        }
        GRID_BAR();
        for (int rep_ = 0; rep_ < REPS(PH_OUTG); ++rep_) if (IN(PH_OUTG)) {
            if (rep_) GRID_BAR();
            PHASE_ENV();
            ProbProjT<true> p; p.A = mix; p.Bt = (const unsigned char*)wout_t + (size_t)l * D * D; p.sw = ((const int*)ctl)[CW_SOUT + l]; p.sxa = MIX_SHIFT; p.C = ybf; p.ldc = D; p.S.init(T, D, G, bid);
            pg8::gemm_phase(lds, p);
        }
        GRID_BAR();
        if (IN(PH_LN1R)) {
            PHASE_ENV();
            LAS float* S1 = (LAS float*)lds;
            LAS float* S2 = S1 + 256;
            LAS float* PART = S2 + 256;
            constexpr int LN1_MAXT = 16;
            LAS int* hist = (LAS int*)(PART + 8 * 32 * 36); LAS int* basee = hist + 32; LAS int* sel = basee + 32; LAS float* gsel = (LAS float*)(sel + LN1_MAXT * 128);
            LAS float* G1L = gsel + LN1_MAXT * 128; LAS float* B1L = G1L + D;
            const float* rb = A->in[I_RB] + (size_t)l * NE;
            const int tk = lane & 15, kq = lane >> 4, colb = wave * 128 + kq * 8;
            bf16x8 wfh[2][4], wfl[2][4];
#pragma unroll
            for (int et = 0; et < 2; ++et)
#pragma unroll
                for (int ks = 0; ks < 4; ++ks) { const size_t off = (size_t)l * NE * D + (size_t)(et * 16 + tk) * D + colb + 32 * ks; wfh[et][ks] = *(const bf16x8*)(rwh + off); wfl[et][ks] = *(const bf16x8*)(rwl + off); }
            if (tid < 32) hist[tid] = 0;
            { const float* src_ = (tid < 256) ? (A->in[I_LN1G] + (size_t)l * D + 4 * tid) : (A->in[I_LN1B] + (size_t)l * D + 4 * (tid - 256)); *(LAS f32x4*)(G1L + 4 * tid) = *(const f32x4*)src_; }
            int tix = 0;
            for (int tile = bid; tile < T / 32; tile += G, ++tix) {
                float tv[2][4][8];
#pragma unroll
                for (int tt = 0; tt < 2; ++tt) { const size_t row = (size_t)tile * 32 + tt * 16 + tk;
#pragma unroll
                    for (int ks = 0; ks < 4; ++ks) { const u32x4 xw = *(const u32x4*)(xb + row * D + colb + 32 * ks), yw = *(const u32x4*)(ybf + row * D + colb + 32 * ks);
#pragma unroll
                        for (int q = 0; q < 4; ++q) { tv[tt][ks][2 * q] = bf2f(xw[q] & 0xffffu) * ALPHA + bf2f(yw[q] & 0xffffu); tv[tt][ks][2 * q + 1] = bf2f(xw[q] >> 16) * ALPHA + bf2f(yw[q] >> 16); } } }
                float mean[2], rstd[2];
#pragma unroll
                for (int tt = 0; tt < 2; ++tt) { float s_ = 0.f;
#pragma unroll
                    for (int ks = 0; ks < 4; ++ks)
#pragma unroll
                        for (int q = 0; q < 8; ++q) s_ += tv[tt][ks][q];
                    s_ += __shfl_xor(s_, 16); s_ += __shfl_xor(s_, 32); if (kq == 0) S1[wave * 32 + tt * 16 + tk] = s_; }
                __syncthreads();
#pragma unroll
                for (int tt = 0; tt < 2; ++tt) { float m_ = 0.f;
#pragma unroll
                    for (int ww = 0; ww < 8; ++ww) m_ += S1[ww * 32 + tt * 16 + tk];
                    mean[tt] = m_ * (1.f / D); float s_ = 0.f;
#pragma unroll
                    for (int ks = 0; ks < 4; ++ks)
#pragma unroll
                        for (int q = 0; q < 8; ++q) { tv[tt][ks][q] -= mean[tt]; s_ += tv[tt][ks][q] * tv[tt][ks][q]; }
                    s_ += __shfl_xor(s_, 16); s_ += __shfl_xor(s_, 32); if (kq == 0) S2[wave * 32 + tt * 16 + tk] = s_; }
                __syncthreads();
                f32x4 acc[2][2];
#pragma unroll
                for (int et = 0; et < 2; ++et)
#pragma unroll
                    for (int tt = 0; tt < 2; ++tt) acc[et][tt] = (f32x4){0.f, 0.f, 0.f, 0.f};
#pragma unroll
                for (int tt = 0; tt < 2; ++tt) { float v_ = 0.f;
#pragma unroll
                    for (int ww = 0; ww < 8; ++ww) v_ += S2[ww * 32 + tt * 16 + tk];
                    rstd[tt] = rsqf_(v_ * (1.f / D) + LN_EPS); const size_t row = (size_t)tile * 32 + tt * 16 + tk;
#pragma unroll
                    for (int ks = 0; ks < 4; ++ks) { const f32x4 ga = *(const LAS f32x4*)(G1L + colb + 32 * ks), gb = *(const LAS f32x4*)(G1L + colb + 32 * ks + 4), ba_ = *(const LAS f32x4*)(B1L + colb + 32 * ks), bb_ = *(const LAS f32x4*)(B1L + colb + 32 * ks + 4);
                        float o[8]; unsigned hw[4], lw[4];
#pragma unroll
                        for (int q = 0; q < 8; ++q) o[q] = tv[tt][ks][q] * rstd[tt] * (q < 4 ? ga[q] : gb[q - 4]) + (q < 4 ? ba_[q] : bb_[q - 4]);
#pragma unroll
                        for (int q = 0; q < 4; ++q) { hw[q] = pk2(o[2 * q], o[2 * q + 1]); lw[q] = pk2(o[2 * q] - bf2f(hw[q] & 0xffffu), o[2 * q + 1] - bf2f(hw[q] >> 16)); }
                        *(u32x4*)(x1b + row * D + colb + 32 * ks) = (u32x4){hw[0], hw[1], hw[2], hw[3]};
                        { int q0 = 0, q1 = 0; q0 = __builtin_amdgcn_cvt_pk_fp8_f32(o[0], o[1], q0, false); q0 = __builtin_amdgcn_cvt_pk_fp8_f32(o[2], o[3], q0, true); q1 = __builtin_amdgcn_cvt_pk_fp8_f32(o[4], o[5], q1, false); q1 = __builtin_amdgcn_cvt_pk_fp8_f32(o[6], o[7], q1, true);
                          *(u32x2*)(x1q + row * D + colb + 32 * ks) = (u32x2){(unsigned)q0, (unsigned)q1}; }
                        const bf16x8 xh = __builtin_bit_cast(bf16x8, (u32x4){hw[0], hw[1], hw[2], hw[3]}), xl = __builtin_bit_cast(bf16x8, (u32x4){lw[0], lw[1], lw[2], lw[3]});
#pragma unroll
                        for (int et = 0; et < 2; ++et) { acc[et][tt] = __builtin_amdgcn_mfma_f32_16x16x32_bf16(wfh[et][ks], xh, acc[et][tt], 0, 0, 0); acc[et][tt] = __builtin_amdgcn_mfma_f32_16x16x32_bf16(wfl[et][ks], xh, acc[et][tt], 0, 0, 0); acc[et][tt] = __builtin_amdgcn_mfma_f32_16x16x32_bf16(wfh[et][ks], xl, acc[et][tt], 0, 0, 0); } } }
#pragma unroll
                for (int et = 0; et < 2; ++et)
#pragma unroll
                    for (int tt = 0; tt < 2; ++tt) *(LAS f32x4*)(PART + (wave * 32 + tt * 16 + tk) * 36 + et * 16 + 4 * kq) = acc[et][tt];
                __syncthreads();
                {
                    const int tok = tid >> 4, sub = tid & 15; float l0 = rb[2 * sub], l1 = rb[2 * sub + 1];
#pragma unroll
                    for (int ww = 0; ww < 8; ++ww) { const f32x2 pv = *(const LAS f32x2*)(PART + (ww * 32 + tok) * 36 + 2 * sub); l0 += pv[0]; l1 += pv[1]; }
                    float tvv[4]; int tee[4];
#pragma unroll
                    for (int k = 0; k < 4; ++k) { const bool hi_ = l1 > l0; float bv = hi_ ? l1 : l0; int bi = hi_ ? 2 * sub + 1 : 2 * sub;
#define TOPK_STEP(ctrl) { const float ov = __builtin_bit_cast(float, __builtin_amdgcn_update_dpp(0, __builtin_bit_cast(int, bv), ctrl, 0xf, 0xf, false)); const int oi = __builtin_amdgcn_update_dpp(0, bi, ctrl, 0xf, 0xf, false); \
                            const bool take = (ov > bv) | ((ov == bv) & (oi < bi)); bv = take ? ov : bv; bi = take ? oi : bi; }
                        TOPK_STEP(0xB1) TOPK_STEP(0x4E) TOPK_STEP(0x141) TOPK_STEP(0x140)
#undef TOPK_STEP
                        tvv[k] = bv; tee[k] = bi; l0 = (bi == 2 * sub) ? -3.3e38f : l0; l1 = (bi == 2 * sub + 1) ? -3.3e38f : l1; }
                    if (sub < 4) { float wsum = 0.f, wk = 0.f; int ek = 0;
#pragma unroll
                        for (int k = 0; k < 4; ++k) { const float wv_ = exp_(tvv[k] - tvv[0]); wsum += wv_; if (k == sub) { wk = wv_; ek = tee[k]; } }
                        const int lr = atomicAdd((int*)(hist + ek), 1); sel[tix * 128 + tok * 4 + sub] = ek * 65536 + lr; gsel[tix * 128 + tok * 4 + sub] = wk / wsum; } }
            }
            __syncthreads();
            if (tid < 32) { const int hh = hist[tid]; basee[tid] = hh ? (int)atomicAdd(cntg + 32 * tid, (unsigned)hh) : 0; }
            __syncthreads();
            for (int i = tid; i < tix * 128; i += NTHR) { const int sv = sel[i], e = sv >> 16, rank = basee[e] + (sv & 65535); const int tok = (bid + (i >> 7) * G) * 32 + ((i & 127) >> 2); const int idx = e * ECAP + rank;
                rtok[idx] = tok; rgate[idx] = gsel[i]; tslot[tok * 4 + (i & 3)] = idx; }
            __syncthreads();
        }
        GRID_BAR();
        for (int rep_ = 0; rep_ < REPS(PH_MOE1); ++rep_) if (IN(PH_MOE1)) {
            if (rep_) GRID_BAR();
            PHASE_ENV();
            MOE_TABLES((const int*)ctl + CW_SGU + l * NE);
            ProbMoe1 p; p.X = x1q; p.Wgu = wguq + (size_t)l * NE * 2048 * D; p.bgu = A->in[I_BGU] + (size_t)l * NE * 2048; p.hid = hid; p.rtok = rtok; p.tb.cnt = tabcnt; p.tb.pblk = tabpblk; p.tb.scl = tabscl; p.tb.eb = tabeb; p.G = G; p.c = bid;
            pg8::gemm_phase(lds, p);
        }
        GRID_BAR();
        for (int rep_ = 0; rep_ < REPS(PH_MOE2); ++rep_) if (IN(PH_MOE2)) {
            if (rep_) GRID_BAR();
            PHASE_ENV();
            MOE_TABLES((const int*)ctl + CW_SDN + l * NE);
            ProbMoe2 p; p.hid = hid; p.Wdn = wdnq + (size_t)l * NE * D * DE; p.bdn = A->in[I_BDN] + (size_t)l * NE * D; p.ys = ysl; p.rgate = rgate; p.tb.cnt = tabcnt; p.tb.pblk = tabpblk; p.tb.scl = tabscl; p.tb.eb = tabeb; p.G = G; p.c = bid;
            pg8::gemm_phase(lds, p);
        }
        GRID_BAR();
        for (int rep_ = 0; rep_ < REPS(PH_LN2); ++rep_) if (IN(PH_LN2)) {
            if (rep_) GRID_BAR();
            PHASE_ENV();
            MOE_TABLES((const int*)nullptr);
            const float* g2 = A->in[I_LN2G] + (size_t)l * D; const float* b2 = A->in[I_LN2B] + (size_t)l * D;
            typedef int i32x4 __attribute__((ext_vector_type(4)));
            const int c0 = lane * 16; const int rstep = NGW;
#define LN2_CL(rp) ((rp) < T ? (rp) : T - 1)
#define LN2_TS(rp, TS) do { TS = *(const i32x4*)(tslot + (size_t)LN2_CL(rp) * 4); } while (0)
#define LN2_LOAD(rp, TS, YV, XV, GK) do { _Pragma("unroll") for (int k = 0; k < 4; ++k) { const int idx = TS[k]; GK[k] = rgate[idx]; const int e = idx >> 15, rank = idx & (ECAP - 1); \
                        YV[k] = *(const u32x4*)(ysl + (size_t)(tabpblk[e] * 256 + rank) * D + lane * 16); } \
                    XV[0] = *(const u32x4*)(x1b + (size_t)LN2_CL(rp) * D + lane * 16); XV[1] = *(const u32x4*)(x1b + (size_t)LN2_CL(rp) * D + lane * 16 + 8); } while (0)
#define LN2_COMPUTE(rp, YV, XV, GK_) do { const int row = (rp); float v[16]; float s_ = 0.f; const float GK[4] = {GK_[0] * (1.0f / YS_SCALE), GK_[1] * (1.0f / YS_SCALE), GK_[2] * (1.0f / YS_SCALE), GK_[3] * (1.0f / YS_SCALE)}; \
                    _Pragma("unroll") for (int q = 0; q < 4; ++q) { float m0 = 0.f, m1 = 0.f, m2 = 0.f, m3 = 0.f; \
                        _Pragma("unroll") for (int k = 0; k < 4; ++k) { const f32x2 lo2 = __builtin_amdgcn_cvt_pk_f32_fp8((int)YV[k][q], false), hi2 = __builtin_amdgcn_cvt_pk_f32_fp8((int)YV[k][q], true); \
                            m0 += GK[k] * lo2[0]; m1 += GK[k] * lo2[1]; m2 += GK[k] * hi2[0]; m3 += GK[k] * hi2[1]; } \
                        const unsigned xa = XV[q >> 1][(q & 1) * 2], xb_ = XV[q >> 1][(q & 1) * 2 + 1]; \
                        v[4 * q] = bf2f(xa & 0xffffu) * ALPHA + m0; v[4 * q + 1] = bf2f(xa >> 16) * ALPHA + m1; v[4 * q + 2] = bf2f(xb_ & 0xffffu) * ALPHA + m2; v[4 * q + 3] = bf2f(xb_ >> 16) * ALPHA + m3; \
                        s_ += (v[4 * q] + v[4 * q + 1]) + (v[4 * q + 2] + v[4 * q + 3]); } \
                    const float mean = wave_sum(s_) * (1.f / D); float s2 = 0.f; \
                    _Pragma("unroll") for (int q = 0; q < 16; ++q) { v[q] -= mean; s2 += v[q] * v[q]; } \
                    const float rstd = rsqf_(wave_sum(s2) * (1.f / D) + LN_EPS); float o[16]; \
                    _Pragma("unroll") for (int q4 = 0; q4 < 4; ++q4) { const f32x4 gg = g2r[q4], bb = b2r[q4]; _Pragma("unroll") for (int i = 0; i < 4; ++i) o[4 * q4 + i] = v[4 * q4 + i] * rstd * gg[i] + bb[i]; } \
                    if (l == NL - 1) { _Pragma("unroll") for (int q4 = 0; q4 < 4; ++q4) *(f32x4*)(A->out + (size_t)row * D + c0 + 4 * q4) = (f32x4){o[4 * q4], o[4 * q4 + 1], o[4 * q4 + 2], o[4 * q4 + 3]}; } \
                    else { *(u32x4*)(xb + (size_t)row * D + c0) = (u32x4){pk2(o[0], o[1]), pk2(o[2], o[3]), pk2(o[4], o[5]), pk2(o[6], o[7])}; *(u32x4*)(xb + (size_t)row * D + c0 + 8) = (u32x4){pk2(o[8], o[9]), pk2(o[10], o[11]), pk2(o[12], o[13]), pk2(o[14], o[15])}; \
                        int q4_[4]; _Pragma("unroll") for (int qq = 0; qq < 4; ++qq) { int t_ = 0; t_ = __builtin_amdgcn_cvt_pk_fp8_f32(o[4 * qq], o[4 * qq + 1], t_, false); t_ = __builtin_amdgcn_cvt_pk_fp8_f32(o[4 * qq + 2], o[4 * qq + 3], t_, true); q4_[qq] = t_; } \
                        *(u32x4*)(xq + (size_t)row * D + c0) = (u32x4){(unsigned)q4_[0], (unsigned)q4_[1], (unsigned)q4_[2], (unsigned)q4_[3]}; } } while (0)
            f32x4 g2r[4], b2r[4];
#pragma unroll
            for (int q4 = 0; q4 < 4; ++q4) { g2r[q4] = *(const f32x4*)(g2 + c0 + 4 * q4); b2r[q4] = *(const f32x4*)(b2 + c0 + 4 * q4); }
            int rowp = gw;
            i32x4 tsA0, tsA1, tsB0, tsB1;
            u32x4 yvA0[4], xvA0[2], yvA1[4], xvA1[2], yvB0[4], xvB0[2], yvB1[4], xvB1[2]; float gkA0[4], gkA1[4], gkB0[4], gkB1[4];
            LN2_TS(rowp, tsA0); LN2_TS(rowp + rstep, tsA1); LN2_TS(rowp + 2 * rstep, tsB0); LN2_TS(rowp + 3 * rstep, tsB1);
            LN2_LOAD(rowp, tsA0, yvA0, xvA0, gkA0);
            LN2_LOAD(rowp + rstep, tsA1, yvA1, xvA1, gkA1);
            for (; rowp < T; rowp += 4 * rstep) {
                LN2_LOAD(rowp + 2 * rstep, tsB0, yvB0, xvB0, gkB0);
                LN2_LOAD(rowp + 3 * rstep, tsB1, yvB1, xvB1, gkB1);
                LN2_TS(rowp + 4 * rstep, tsA0); LN2_TS(rowp + 5 * rstep, tsA1);
                LN2_COMPUTE(rowp, yvA0, xvA0, gkA0);
                if (rowp + rstep < T) LN2_COMPUTE(rowp + rstep, yvA1, xvA1, gkA1);
                LN2_LOAD(rowp + 4 * rstep, tsA0, yvA0, xvA0, gkA0);
                LN2_LOAD(rowp + 5 * rstep, tsA1, yvA1, xvA1, gkA1);
                LN2_TS(rowp + 6 * rstep, tsB0); LN2_TS(rowp + 7 * rstep, tsB1);
                if (rowp + 2 * rstep < T) LN2_COMPUTE(rowp + 2 * rstep, yvB0, xvB0, gkB0);
                if (rowp + 3 * rstep < T) LN2_COMPUTE(rowp + 3 * rstep, yvB1, xvB1, gkB1);
            }
#undef LN2_TS
#undef LN2_CL
#undef LN2_LOAD
#undef LN2_COMPUTE
        }
        if (l + 1 < l_hi) GRID_BAR();
#undef IN
    }
}

extern "C" void kernel_launch(void* const* d_in, const int* in_sizes, int n_in, void* d_out, int out_size, void* d_ws, size_t ws_size, hipStream_t stream) {
    static int grid = 0;
    if (grid == 0) {
        if (n_in != 23 || out_size != T * D || ws_size < WS_END) { fprintf(stderr, "kernel_launch: unexpected shapes (n_in %d, out %d, ws %zu)\n", n_in, out_size, ws_size); grid = -1; return; }
        int dev = 0, cus = 0;
        if (hipGetDevice(&dev) != hipSuccess || hipDeviceGetAttribute(&cus, hipDeviceAttributeMultiprocessorCount, dev) != hipSuccess) { grid = -1; return; }
        bool ok = true;
#define SETA(k) ok = ok && (hipFuncSetAttribute((const void*)mk_fwd<k>, hipFuncAttributeMaxDynamicSharedMemorySize, LDS_BYTES) == hipSuccess)
#ifdef MULTI_LAUNCH
        SETA(0); SETA(-1); SETA(PH_PROJ); SETA(PH_HG); SETA(PH_LRUAU); SETA(PH_COMB); SETA(PH_OUTG); SETA(PH_LN1R); SETA(PH_MOE1); SETA(PH_MOE2); SETA(PH_LN2);
#else
        SETA(0);
#endif
#undef SETA
        if (!ok) { fprintf(stderr, "kernel_launch: hipFuncSetAttribute failed\n"); grid = -1; return; }
        (void)hipGetLastError();
        grid = cus;
    }
    if (grid < 0) return;
    (void)hipMemsetAsync((char*)d_ws + WS_CTL, 0, CTL_BYTES, stream);
    Args a{};
    for (int i = 0; i < 23; ++i) a.in[i] = (const float*)d_in[i];
    a.out = (float*)d_out; a.ws = (unsigned char*)d_ws;
    a.l_lo = 0; a.l_hi = NL; a.ph_lo = 0; a.ph_hi = PH_END; a.pro = 1; a.pad = 0;
#ifdef MULTI_LAUNCH
    hipLaunchKernelGGL(mk_fwd<-1>, dim3(grid), dim3(NTHR), LDS_BYTES, stream, a);
    for (int l = 0; l < NL; ++l) {
        a.l_lo = l; a.l_hi = l + 1;
        hipLaunchKernelGGL(mk_fwd<PH_PROJ>, dim3(grid), dim3(NTHR), LDS_BYTES, stream, a);
        hipLaunchKernelGGL(mk_fwd<PH_HG>, dim3(grid), dim3(NTHR), LDS_BYTES, stream, a);
        hipLaunchKernelGGL(mk_fwd<PH_LRUAU>, dim3(grid), dim3(NTHR), LDS_BYTES, stream, a);
        hipLaunchKernelGGL(mk_fwd<PH_COMB>, dim3(grid), dim3(NTHR), LDS_BYTES, stream, a);
        hipLaunchKernelGGL(mk_fwd<PH_OUTG>, dim3(grid), dim3(NTHR), LDS_BYTES, stream, a);
        hipLaunchKernelGGL(mk_fwd<PH_LN1R>, dim3(grid), dim3(NTHR), LDS_BYTES, stream, a);
        hipLaunchKernelGGL(mk_fwd<PH_MOE1>, dim3(grid), dim3(NTHR), LDS_BYTES, stream, a);
        hipLaunchKernelGGL(mk_fwd<PH_MOE2>, dim3(grid), dim3(NTHR), LDS_BYTES, stream, a);
        hipLaunchKernelGGL(mk_fwd<PH_LN2>, dim3(grid), dim3(NTHR), LDS_BYTES, stream, a);
    }
#else
    hipLaunchKernelGGL(mk_fwd<0>, dim3(grid), dim3(NTHR), LDS_BYTES, stream, a);
#endif
}
```

```cpp
#include <hip/hip_runtime.h>
#include <cstdio>
#include <cstdint>

#define GAS __attribute__((address_space(1)))
#define LAS __attribute__((address_space(3)))
typedef unsigned short bf16_t;
typedef short bf16x8 __attribute__((ext_vector_type(8)));
typedef float f32x4 __attribute__((ext_vector_type(4)));
typedef float f32x2 __attribute__((ext_vector_type(2)));
typedef unsigned u32x4 __attribute__((ext_vector_type(4)));
typedef unsigned u32x2 __attribute__((ext_vector_type(2)));

constexpr int BATCH = 8, SEQ = 4096, D = 1024, T = BATCH * SEQ, NL = 4;
constexpr int HGW = 512, LRW = 512, HGH = 4, HD = 128, LRH = 8, LHD = 64;
constexpr int INC = 3584, NE = 32, TOPK = 4, DE = 1024;
constexpr int ECAP = 32768;
constexpr int NSLOT = T * TOPK + NE * 256;
constexpr float ALPHA = 1.6817928305074290f;
constexpr float LN_EPS = 1e-5f, RMS_EPS = 1e-6f;
constexpr int NWAVES = 8, NTHR = 512;
constexpr int LDS_BYTES = 147456;

constexpr size_t MiB = 1u << 20;
constexpr size_t WS_CTL = 0, CTL_BYTES = 1 * MiB;
constexpr size_t WS_LBT = 1 * MiB;
constexpr size_t WS_RWH = 2 * MiB, WS_RWL = 3 * MiB;
constexpr size_t WS_WIN = 4 * MiB;
constexpr size_t WS_WOUT = 32 * MiB;
constexpr size_t WS_WGU = 40 * MiB;
constexpr size_t WS_WDN = 552 * MiB;
constexpr size_t WS_XB = 808 * MiB;
constexpr size_t WS_XRES = 872 * MiB;
constexpr size_t WS_PROJ = 1000 * MiB;
constexpr size_t WS_MIX = 1224 * MiB;
constexpr size_t WS_Y = 1288 * MiB;
constexpr size_t WS_X1 = 1416 * MiB;
constexpr size_t WS_X1B = 1544 * MiB;
constexpr size_t WS_HID = 1608 * MiB;
constexpr size_t WS_YS = 1880 * MiB;
constexpr size_t WS_RTOK = 2152 * MiB;
constexpr size_t WS_RGATE = 2156 * MiB;
constexpr size_t WS_TSLOT = 2160 * MiB;
constexpr size_t WS_ODIR = 2162 * MiB;
constexpr size_t WS_HDIR = 2290 * MiB;
constexpr size_t WS_AU = 2418 * MiB;
constexpr size_t WS_SFIN = 2674 * MiB;
constexpr size_t WS_DSEG = 2690 * MiB;
constexpr size_t WS_LSUM = 2691 * MiB;
constexpr size_t WS_LRUW = 2696 * MiB;
constexpr size_t WS_END = 2700 * MiB;
constexpr size_t WS_OLOC = WS_ODIR, WS_QSEG = WS_ODIR + 64 * MiB;
constexpr size_t WS_XQ = WS_XRES, WS_WINQ = WS_XRES + 64 * MiB;
constexpr size_t WS_X1Q = WS_X1;
constexpr int MIX_SHIFT = 1; constexpr float MIX_SCALE = 2.0f;
constexpr int CW_CNT = 16384, CW_SGU = 2048, CW_SDN = 2304, CW_SIN = 2560, CW_SOUT = 2624, CW_BAR = 8192;

#define LDS_WAIT() asm volatile("s_waitcnt lgkmcnt(0)" ::: "memory")
typedef __bf16 bf16x2_t __attribute__((ext_vector_type(2)));
__device__ __forceinline__ unsigned pk2(float lo, float hi) { bf16x2_t v; v[0] = (__bf16)lo; v[1] = (__bf16)hi; return __builtin_bit_cast(unsigned, v); }
__device__ __forceinline__ unsigned f2bf(float f) { return pk2(f, 0.f) & 0xffffu; }
__device__ __forceinline__ float bf2f(unsigned b) { return __builtin_bit_cast(float, b << 16); }
__device__ __forceinline__ float wave_sum(float v) {
#define WS_DPP(ctrl) v += __builtin_bit_cast(float, __builtin_amdgcn_update_dpp(0, __builtin_bit_cast(int, v), ctrl, 0xf, 0xf, false))
    WS_DPP(0xB1); WS_DPP(0x4E); WS_DPP(0x141); WS_DPP(0x140);
#undef WS_DPP
    const int vi = __builtin_bit_cast(int, v);
    return (__builtin_bit_cast(float, __builtin_amdgcn_readlane(vi, 0)) + __builtin_bit_cast(float, __builtin_amdgcn_readlane(vi, 16))) + (__builtin_bit_cast(float, __builtin_amdgcn_readlane(vi, 32)) + __builtin_bit_cast(float, __builtin_amdgcn_readlane(vi, 48)));
}
__device__ __forceinline__ float rcpf_(float x) { return __builtin_amdgcn_rcpf(x); }
__device__ __forceinline__ float rsqf_(float x) { return __builtin_amdgcn_rsqf(x); }
__device__ __forceinline__ float exp_(float x) { return __builtin_amdgcn_exp2f(x * 1.4426950408889634f); }
__device__ __forceinline__ float log_(float x) { return __builtin_amdgcn_logf(x) * 0.6931471805599453f; }
__device__ __forceinline__ float sigmoidf_(float z) { return rcpf_(1.0f + __builtin_amdgcn_exp2f(z * -1.4426950408889634f)); }
__device__ __forceinline__ float gelu_tanh_(float z) { return z * sigmoidf_(1.5957691216057308f * (z + 0.044715f * z * z * z)); }

namespace pg8 {
constexpr int BM = 256, BK = 64, HALF = 128, HTB = HALF * BK * 2, STAGE_BYTES = 8 * HTB, NXCD = 8, WGM = 8;
constexpr int KD = 1024;
__host__ __device__ __forceinline__ int lds_byte(int r, int c) { const int st = (r >> 4) * 2 + (c >> 5), rr = r & 15, cc = c & 31, ob = rr * 64 + cc * 2; return st * 1024 + (ob ^ (((ob >> 9) & 1) << 5)); }
__host__ __device__ __forceinline__ void stage_rc(int b, int& R, int& C) { const int st = b / 1024, sb = b % 1024, swz = sb ^ (((sb >> 9) & 1) << 5); R = (st >> 1) * 16 + swz / 64; C = (st & 1) * 32 + (swz % 64) / 2; }
__host__ __device__ __forceinline__ int perm32(int rho) { const int n = rho >> 4, i = rho & 15; return 8 * (i >> 2) + 4 * n + (i & 3); }
struct Unit { int pm, pn, e, j; };
typedef int i32x8 __attribute__((ext_vector_type(8)));
__device__ __forceinline__ i32x8 cat8(bf16x8 a, bf16x8 b) { const u32x4 x = __builtin_bit_cast(u32x4, a), y = __builtin_bit_cast(u32x4, b); return (i32x8){(int)x[0], (int)x[1], (int)x[2], (int)x[3], (int)y[0], (int)y[1], (int)y[2], (int)y[3]}; }
__device__ __forceinline__ unsigned cvt_pk_bf16(float lo, float hi) { return pk2(lo, hi); }

struct StaticOrder {
    int nM, nN, nwg, G, c;
    __device__ void init(int M, int N, int G_, int c_) { nM = M / BM; nN = N / BM; nwg = nM * nN; G = G_; c = c_; }
    __device__ bool next(int i, Unit& u) const {
        const long L = (long)i * G + c; if (L >= nwg) return false;
        int wgid = (int)L; { const int q = nwg / NXCD, r = nwg % NXCD, xcd = wgid % NXCD, off = wgid / NXCD; wgid = (xcd < r ? xcd * (q + 1) : r * (q + 1) + (xcd - r) * q) + off; }
        const int nig = WGM * nN, gid = wgid / nig, fm = gid * WGM, gsz = (nM - fm) < WGM ? (nM - fm) : WGM;
        u.pm = fm + ((wgid % nig) % gsz); u.pn = (wgid % nig) / gsz; u.e = 0; u.j = 0; return true;
    }
};

template <class P>
__device__ __forceinline__ void gemm_phase(LAS unsigned char* lds, const P& p) {
    int tid_l = (int)threadIdx.x; asm volatile("" : "+v"(tid_l));
    const int tid = tid_l, wid = __builtin_amdgcn_readfirstlane(tid >> 6), lane = tid & 63, wr = wid >> 2, wc = wid & 3, fr = lane & 15, fq = lane >> 4;
    constexpr int RB = P::FP8 ? KD : 2 * KD;
    constexpr int nt = RB / 128;
    unsigned voffB[2];
#pragma unroll
    for (int i = 0; i < 2; ++i) { int R, C; stage_rc(tid * 16 + i * 8192, R, C); const int r32_ = R & 31;
        const int Rb = P::WIDE ? (64 * (R >> 5) + 16 * ((r32_ & 15) >> 2) + 4 * (r32_ >> 4) + (r32_ & 3))
                             : (P::PERM ? ((R & ~31) + perm32(r32_)) : R);
        voffB[i] = (unsigned)(Rb * RB + C * 2); }
    constexpr unsigned hstepB = (unsigned)(P::WIDE ? 8 : HALF) * RB;
    const unsigned ldsw = (unsigned)wid * 1024u;
    const int aoff = lds_byte(wr * 64 + fr, fq * 8), boff = lds_byte(wc * 32 + fr, fq * 8);
    const char* const abase = p.a_base();
#define PG8_SA(b, h) (((b) * 2 + (h)) * HTB)
#define PG8_SB(b, h) ((4 + (b) * 2 + (h)) * HTB)
#define PG8_STAGE_A(bufoff, o, koff) do { _Pragma("unroll") for (int _i = 0; _i < 2; ++_i) \
        __builtin_amdgcn_global_load_lds((const unsigned*)(abase + (size_t)(o)[_i] + (koff)), (LAS unsigned*)(lds + (bufoff) + ldsw + _i * 8192), 16, 0, 0); } while (0)
#define PG8_STAGE_B(bufoff, gbase, koff) do { _Pragma("unroll") for (int _i = 0; _i < 2; ++_i) \
        __builtin_amdgcn_global_load_lds((const unsigned*)((gbase) + (size_t)(voffB[_i] + (koff))), (LAS unsigned*)(lds + (bufoff) + ldsw + _i * 8192), 16, 0, 0); } while (0)
#define PG8_LDA(dst, b, h) do { _Pragma("unroll") for (int m = 0; m < 4; ++m) _Pragma("unroll") for (int k = 0; k < 2; ++k) dst[m][k] = *(const LAS bf16x8*)(lds + PG8_SA(b, h) + aoff + m * 2048 + k * 1024); } while (0)
#define PG8_LDB(dst, b, h) do { _Pragma("unroll") for (int n = 0; n < 2; ++n) _Pragma("unroll") for (int k = 0; k < 2; ++k) dst[n][k] = *(const LAS bf16x8*)(lds + PG8_SB(b, h) + boff + n * 2048 + k * 1024); } while (0)
#define PG8_MMA(ai, bj, At, Bt) do { __builtin_amdgcn_s_setprio(1); _Pragma("unroll") for (int m = 0; m < 4; ++m) _Pragma("unroll") for (int n = 0; n < 2; ++n) { \
        if constexpr (P::FP8) { const i32x8 b8_ = cat8(Bt[n][0], Bt[n][1]), a8_ = cat8(At[m][0], At[m][1]); \
            asm volatile("v_mfma_scale_f32_16x16x128_f8f6f4 %0, %1, %2, %0, %3, %4 op_sel_hi:[0,0,0]" : "+v"(acc[ai][bj][m][n]) : "v"(b8_), "v"(a8_), "v"(sclW), "v"(sclX)); } \
        else { _Pragma("unroll") for (int k = 0; k < 2; ++k) acc[ai][bj][m][n] = __builtin_amdgcn_mfma_f32_16x16x32_bf16(Bt[n][k], At[m][k], acc[ai][bj][m][n], 0, 0, 0); } } __builtin_amdgcn_s_setprio(0); } while (0)
#define PG8_WAIT_V(n) asm volatile("s_waitcnt vmcnt(" #n ")" ::: "memory")
#define PG8_WAIT_L(n) asm volatile("s_waitcnt lgkmcnt(" #n ")" ::: "memory")
#define PG8_BAR __builtin_amdgcn_s_barrier()
#define PG8_SCHED __builtin_amdgcn_sched_barrier(0)
    Unit cur, nxt; int ui = 0; nxt.pm = nxt.pn = nxt.e = nxt.j = 0;
    constexpr int UL_OFF = STAGE_BYTES + 12288, UL_MAX = 32;
    if constexpr (P::ULIST) { if (tid < UL_MAX) { Unit t_; const bool ok_ = p.next(tid, t_); ((LAS unsigned*)(lds + UL_OFF))[tid] = ok_ ? ((unsigned)t_.pm | ((unsigned)t_.pn << 16)) : 0xffffffffu; } __syncthreads(); }
    auto next_unit = [&](int i_, Unit& u_) -> bool {
        if constexpr (P::ULIST) { if (i_ >= UL_MAX) return p.next(i_, u_); const unsigned w_ = __builtin_amdgcn_readfirstlane(((const volatile LAS unsigned*)(lds + UL_OFF))[i_]); if (w_ == 0xffffffffu) return false; u_.pm = (int)(w_ & 0xffffu); u_.pn = (int)(w_ >> 16); u_.e = 0; u_.j = 0; return true; }
        else return p.next(i_, u_); };
    if (!next_unit(0, cur)) return;
    f32x4 acc[2][2][4][2];
    if constexpr (!P::ACC_BIAS) {
#pragma unroll
    for (int a = 0; a < 2; ++a)
#pragma unroll
        for (int b = 0; b < 2; ++b)
#pragma unroll
            for (int m = 0; m < 4; ++m)
#pragma unroll
                for (int n = 0; n < 2; ++n) acc[a][b][m][n] = (f32x4){0.f, 0.f, 0.f, 0.f};
    }
    bf16x8 At[4][2], B0[2][2], B1[2][2];
    unsigned oC[2][2];
    int kN[2][2];
    constexpr int RC_OFF = STAGE_BYTES + 8192;
    { int Ra_, Ca_, Rb_, Cb_; stage_rc(tid * 16, Ra_, Ca_); stage_rc(tid * 16 + 8192, Rb_, Cb_); *(LAS u32x2*)(lds + RC_OFF + tid * 8) = (u32x2){(unsigned)(Ra_ | (Ca_ << 16)), (unsigned)(Rb_ | (Cb_ << 16))}; }
    LDS_WAIT();
#define PG8_RC(i, R_, C_) int R_, C_; { int t2_ = tid; asm volatile("" : "+v"(t2_)); const unsigned w_ = *(const volatile LAS unsigned*)(lds + RC_OFF + t2_ * 8 + (i) * 4); R_ = (int)(w_ & 0xffffu); C_ = (int)(w_ >> 16); }
    { PG8_RC(0, R0, C0); PG8_RC(1, R1, C1); const int RR[2] = {R0, R1}; p.a_key(cur, RR, kN);
#pragma unroll
      for (int h = 0; h < 2; ++h) { oC[h][0] = (unsigned)(kN[h][0] * RB + C0 * 2); oC[h][1] = (unsigned)(kN[h][1] * RB + C1 * 2); } }
    const char* cB = p.b_base(cur);
    constexpr int BIAS_OFF = STAGE_BYTES + 2048;
    if (P::HAS_BIAS && wid == 0) p.dma_bias(cur, (LAS unsigned*)(lds + BIAS_OFF), lane);
    int sclW = p.scale_w(cur); const int sclX = p.scale_x();
    PG8_STAGE_B(PG8_SB(0, 0), cB, 0u); PG8_STAGE_B(PG8_SB(0, 1), cB + hstepB, 0u); PG8_STAGE_A(PG8_SA(0, 0), oC[0], 0u); PG8_STAGE_A(PG8_SA(0, 1), oC[1], 0u);
    if (wr == 1) PG8_BAR;
    PG8_WAIT_V(2); PG8_BAR;
    PG8_STAGE_B(PG8_SB(1, 0), cB, 128u); PG8_STAGE_A(PG8_SA(1, 0), oC[0], 128u); PG8_STAGE_B(PG8_SB(1, 1), cB + hstepB, 128u);
    PG8_WAIT_V(6); PG8_BAR;
    if constexpr (P::ACC_BIAS) p.acc_init(acc, (const LAS float*)(lds + BIAS_OFF), wc, fq);
    for (;;) {
        const bool has_next = next_unit(ui + 1, nxt);
        const char* nB = cB;
        if (has_next) { PG8_RC(0, R0, C0); PG8_RC(1, R1, C1); (void)C0; (void)C1; const int RR[2] = {R0, R1}; p.a_key(nxt, RR, kN); nB = p.b_base(nxt);
            if (P::HAS_BIAS && wid == 0) p.dma_bias(nxt, (LAS unsigned*)(lds + BIAS_OFF + ((ui + 1) & 1) * 1024), lane); }
#pragma unroll 1
        for (int t = 0; t < nt; t += 2) {
            const bool last = (t == nt - 2);
            const unsigned k1 = (unsigned)(t + 1) * 128u, k2 = last ? 0u : (unsigned)(t + 2) * 128u, k3 = k2 + 128u;
            unsigned o2[2][2];
            if (last) { asm volatile("" : "+v"(kN[0][0]), "+v"(kN[0][1]), "+v"(kN[1][0]), "+v"(kN[1][1])); PG8_RC(0, R0, C0); PG8_RC(1, R1, C1); (void)R0; (void)R1;
#pragma unroll
                for (int h = 0; h < 2; ++h) { o2[h][0] = (unsigned)(kN[h][0] * RB + C0 * 2); o2[h][1] = (unsigned)(kN[h][1] * RB + C1 * 2); } }
            else {
#pragma unroll
                for (int h = 0; h < 2; ++h)
#pragma unroll
                    for (int i = 0; i < 2; ++i) o2[h][i] = oC[h][i]; }
            const char* b2 = last ? nB : cB;
            PG8_LDB(B0, 0, 0); PG8_LDB(B1, 0, 1); PG8_SCHED; PG8_LDA(At, 0, 0); PG8_STAGE_A(PG8_SA(1, 1), oC[1], k1);
            PG8_WAIT_V(8); PG8_WAIT_L(0); PG8_BAR; PG8_MMA(0, 0, At, B0); PG8_MMA(0, 1, At, B1); PG8_BAR; PG8_SCHED;
            PG8_LDA(At, 0, 1); PG8_STAGE_B(PG8_SB(0, 0), b2, k2); PG8_STAGE_B(PG8_SB(0, 1), b2 + hstepB, k2); PG8_STAGE_A(PG8_SA(0, 0), o2[0], k2);
            PG8_WAIT_V(8); PG8_WAIT_L(0); PG8_BAR; PG8_MMA(1, 0, At, B0); PG8_MMA(1, 1, At, B1); PG8_BAR; PG8_SCHED;
            PG8_LDB(B0, 1, 0); PG8_LDB(B1, 1, 1); PG8_SCHED; PG8_LDA(At, 1, 0); PG8_STAGE_A(PG8_SA(0, 1), o2[1], k2);
            PG8_WAIT_V(8); PG8_WAIT_L(0); PG8_BAR; PG8_MMA(0, 0, At, B0); PG8_MMA(0, 1, At, B1); PG8_BAR; PG8_SCHED;
            PG8_LDA(At, 1, 1); PG8_STAGE_B(PG8_SB(1, 0), b2, k3); PG8_STAGE_B(PG8_SB(1, 1), b2 + hstepB, k3); PG8_STAGE_A(PG8_SA(1, 0), o2[0], k3);
            PG8_WAIT_V(8); PG8_WAIT_L(0); PG8_BAR; PG8_MMA(1, 0, At, B0); PG8_MMA(1, 1, At, B1); PG8_BAR; PG8_SCHED;
        }
        if (wr == 0) PG8_BAR;
        if constexpr (P::FP8) asm volatile("s_nop 15\n\ts_nop 7" ::: "memory");
        p.epi(acc, cur, (const LAS float*)(lds + BIAS_OFF + (ui & 1) * 1024), wr, wc, fr, fq);
        if (!has_next) break;
        if constexpr (P::ACC_BIAS) p.acc_init(acc, (const LAS float*)(lds + BIAS_OFF + ((ui + 1) & 1) * 1024), wc, fq);
        else {
#pragma unroll
        for (int a = 0; a < 2; ++a)
#pragma unroll
            for (int b = 0; b < 2; ++b)
#pragma unroll
                for (int m = 0; m < 4; ++m)
#pragma unroll
                    for (int n = 0; n < 2; ++n) acc[a][b][m][n] = (f32x4){0.f, 0.f, 0.f, 0.f};
        }
        cur = nxt; cB = nB; ++ui; sclW = p.scale_w(cur);
        { PG8_RC(0, R0, C0); PG8_RC(1, R1, C1); (void)R0; (void)R1;
#pragma unroll
          for (int h = 0; h < 2; ++h) { oC[h][0] = (unsigned)(kN[h][0] * RB + C0 * 2); oC[h][1] = (unsigned)(kN[h][1] * RB + C1 * 2); } }
        if (wr == 1) PG8_BAR;
    }
    PG8_WAIT_V(0);
    PG8_BAR;
#undef PG8_RC
#undef PG8_SA
#undef PG8_SB
#undef PG8_STAGE_A
#undef PG8_STAGE_B
#undef PG8_LDA
#undef PG8_LDB
#undef PG8_MMA
#undef PG8_WAIT_V
#undef PG8_WAIT_L
#undef PG8_BAR
#undef PG8_SCHED
}
}

template <bool Q> struct ProbProjT {
    static constexpr bool WIDE = false;
    static constexpr bool HAS_BIAS = false; __device__ __forceinline__ void dma_bias(const pg8::Unit&, LAS unsigned*, int) const {}
    static constexpr bool PERM = true, FP8 = Q; static constexpr bool ACC_BIAS = false; static constexpr bool ULIST = true;
    __device__ __forceinline__ int scale_w(const pg8::Unit&) const { return (127 - sw) * 0x01010101; }
    __device__ __forceinline__ int scale_x() const { return (127 - sxa) * 0x01010101; }
    const void* A; const void* Bt; bf16_t* C; int ldc; int sw; int sxa = 0; pg8::StaticOrder S;
    __device__ __forceinline__ bool next(int i, pg8::Unit& u) const { return S.next(i, u); }
    __device__ __forceinline__ const char* a_base() const { return (const char*)A; }
    __device__ __forceinline__ void a_key(const pg8::Unit& u, const int (&R)[2], int (&k)[2][2]) const {
#pragma unroll
        for (int h = 0; h < 2; ++h)
#pragma unroll
            for (int i = 0; i < 2; ++i) k[h][i] = u.pm * 256 + h * 128 + R[i];
    }
    __device__ __forceinline__ const char* b_base(const pg8::Unit& u) const { return (const char*)Bt + (size_t)u.pn * 256 * pg8::KD * (Q ? 1 : 2); }
    __device__ __forceinline__ void epi(const f32x4 (&acc)[2][2][4][2], const pg8::Unit& u, const LAS float*, int wr, int wc, int fr, int fq) const {
        const int row0 = u.pm * 256 + wr * 64 + fr, col0 = u.pn * 256 + wc * 32 + 8 * fq;
#pragma unroll
        for (int ai = 0; ai < 2; ++ai)
#pragma unroll
            for (int m = 0; m < 4; ++m) { bf16_t* rowp = C + (size_t)(row0 + ai * 128 + m * 16) * ldc + col0;
#pragma unroll
                for (int bj = 0; bj < 2; ++bj) { const f32x4 v0 = acc[ai][bj][m][0], v1 = acc[ai][bj][m][1];
                    u32x4 w; w.x = pg8::cvt_pk_bf16(v0[0], v0[1]); w.y = pg8::cvt_pk_bf16(v0[2], v0[3]); w.z = pg8::cvt_pk_bf16(v1[0], v1[1]); w.w = pg8::cvt_pk_bf16(v1[2], v1[3]);
                    *(u32x4*)(rowp + bj * 128) = w; } }
    }
};
struct ProbOut {
    static constexpr bool WIDE = false;
    static constexpr bool HAS_BIAS = false; __device__ __forceinline__ void dma_bias(const pg8::Unit&, LAS unsigned*, int) const {}
    static constexpr bool PERM = false, FP8 = false; static constexpr bool ACC_BIAS = false; static constexpr bool ULIST = false;
    __device__ __forceinline__ int scale_w(const pg8::Unit&) const { return 0; }
    __device__ __forceinline__ int scale_x() const { return 0; }
    const bf16_t* A; const bf16_t* Bt; float* C; pg8::StaticOrder S;
    __device__ __forceinline__ bool next(int i, pg8::Unit& u) const { return S.next(i, u); }
    __device__ __forceinline__ const char* a_base() const { return (const char*)A; }
    __device__ __forceinline__ void a_key(const pg8::Unit& u, const int (&R)[2], int (&k)[2][2]) const {
#pragma unroll
        for (int h = 0; h < 2; ++h)
#pragma unroll
            for (int i = 0; i < 2; ++i) k[h][i] = u.pm * 256 + h * 128 + R[i];
    }
    __device__ __forceinline__ const char* b_base(const pg8::Unit& u) const { return (const char*)Bt + (size_t)u.pn * 256 * pg8::KD * 2; }
    __device__ __forceinline__ void epi(const f32x4 (&acc)[2][2][4][2], const pg8::Unit& u, const LAS float*, int wr, int wc, int fr, int fq) const {
        const int row0 = u.pm * 256 + wr * 64 + fr, col0 = u.pn * 256 + wc * 32 + 4 * fq;
#pragma unroll
        for (int ai = 0; ai < 2; ++ai)
#pragma unroll
            for (int m = 0; m < 4; ++m) { float* rowp = C + (size_t)(row0 + ai * 128 + m * 16) * D + col0;
#pragma unroll
                for (int bj = 0; bj < 2; ++bj)
#pragma unroll
                    for (int n = 0; n < 2; ++n) *(f32x4*)(rowp + bj * 128 + n * 16) = acc[ai][bj][m][n]; }
    }
};
struct MoeTab { const LAS int* cnt; const LAS int* pblk; const LAS int* scl; const LAS unsigned short* eb; };
__device__ __forceinline__ bool moe_next(const MoeTab& tb, int npn, int G, int c, int i, pg8::Unit& u) {
    const int nb = tb.pblk[32]; int blk, pn;
    if (G == 256) {
        const int x = c & 7, q = c >> 3, npnh = npn >> 2, tau = 8 * i + x, sr = tau / npnh, pnh = tau - sr * npnh;
        blk = sr * 8 + (q & 7); pn = pnh * 4 + (q >> 3); if (blk >= nb) return false;
    } else { const long L = (long)i * G + c; if (L >= (long)nb * npn) return false; blk = (int)(L / npn); pn = (int)(L % npn); }
    const int e = tb.eb[blk];
    u.e = __builtin_amdgcn_readfirstlane(e); u.pm = __builtin_amdgcn_readfirstlane(blk); u.pn = __builtin_amdgcn_readfirstlane(pn); u.j = u.pm - tb.pblk[u.e]; u.j = __builtin_amdgcn_readfirstlane(u.j);
    return true;
}
constexpr float YS_SCALE = 8.0f;
constexpr float HID_SCALE = 4.0f; constexpr int HID_SCALE_LOG2 = 2;
struct ProbMoe1 {
    static constexpr bool WIDE = false;
    static constexpr bool HAS_BIAS = true;
    __device__ __forceinline__ void dma_bias(const pg8::Unit& u, LAS unsigned* slot, int lane) const {
        const float* src = bgu + (size_t)u.e * 2048 + u.pn * 128 + (lane < 32 ? 4 * lane : 1024 + 4 * (lane - 32)); __builtin_amdgcn_global_load_lds((const unsigned*)src, slot, 16, 0, 0); }
    static constexpr bool PERM = true, FP8 = true; static constexpr bool ULIST = false; static constexpr bool ACC_BIAS = true;
    __device__ __forceinline__ void acc_init(f32x4 (&acc)[2][2][4][2], const LAS float* bs, int wc, int fq) const { const int cl = wc * 32 + 8 * fq;
        const f32x4 bg0 = *(const LAS f32x4*)(bs + cl), bg1 = *(const LAS f32x4*)(bs + cl + 4), bu0 = *(const LAS f32x4*)(bs + 128 + cl), bu1 = *(const LAS f32x4*)(bs + 128 + cl + 4);
#pragma unroll
        for (int ai = 0; ai < 2; ++ai)
#pragma unroll
            for (int m = 0; m < 4; ++m) { acc[ai][0][m][0] = bg0; acc[ai][0][m][1] = bg1; acc[ai][1][m][0] = bu0; acc[ai][1][m][1] = bu1; } }
    const unsigned char* X; const unsigned char* Wgu; const float* bgu; unsigned char* hid; const int* rtok; MoeTab tb; int G, c;
    __device__ __forceinline__ int scale_w(const pg8::Unit& u) const { return (127 - tb.scl[u.e]) * 0x01010101; }
    __device__ __forceinline__ int scale_x() const { return 0x7f7f7f7f; }
    __device__ __forceinline__ bool next(int i, pg8::Unit& u) const { return moe_next(tb, 8, G, c, i, u); }
    __device__ __forceinline__ const char* a_base() const { return (const char*)X; }
    __device__ __forceinline__ void a_key(const pg8::Unit& u, const int (&R)[2], int (&k)[2][2]) const {
        const int n1 = tb.cnt[u.e] - 1;
#pragma unroll
        for (int h = 0; h < 2; ++h)
#pragma unroll
            for (int i = 0; i < 2; ++i) { const int rank = u.j * 256 + h * 128 + R[i]; k[h][i] = rtok[u.e * ECAP + (rank < n1 ? rank : n1)]; }
    }
    __device__ __forceinline__ const char* b_base(const pg8::Unit& u) const { return (const char*)Wgu + ((size_t)u.e * 2048 + (size_t)u.pn * 256) * pg8::KD; }
    __device__ __forceinline__ void epi(const f32x4 (&acc)[2][2][4][2], const pg8::Unit& u, const LAS float* bs, int wr, int wc, int fr, int fq) const {
        const int row0 = u.pm * 256 + wr * 64 + fr, col0 = u.pn * 128 + wc * 32 + 8 * fq; const int cl = wc * 32 + 8 * fq;
#pragma unroll
        for (int ai = 0; ai < 2; ++ai)
#pragma unroll
            for (int m = 0; m < 4; ++m) {
                float hv[8];
#pragma unroll
                for (int n = 0; n < 2; ++n) { const f32x4 g4 = acc[ai][0][m][n], u4 = acc[ai][1][m][n];
#pragma unroll
                    for (int q = 0; q < 4; q += 2) {
                        f32x2 g = {fminf(g4[q], 7.0f), fminf(g4[q + 1], 7.0f)}, up = {__builtin_amdgcn_fmed3f(u4[q], -7.0f, 7.0f), __builtin_amdgcn_fmed3f(u4[q + 1], -7.0f, 7.0f)};
                        const f32x2 ar = g * (f32x2){-1.702f * 1.4426950408889634f, -1.702f * 1.4426950408889634f};
                        f32x2 den = {__builtin_amdgcn_exp2f(ar[0]), __builtin_amdgcn_exp2f(ar[1])}; den = den + (f32x2){1.0f, 1.0f};
                        const f32x2 sg = {__builtin_amdgcn_rcpf(den[0]), __builtin_amdgcn_rcpf(den[1])};
                        const f32x2 r = (up * (f32x2){HID_SCALE, HID_SCALE} + (f32x2){HID_SCALE, HID_SCALE}) * (g * sg);
                        hv[n * 4 + q] = r[0]; hv[n * 4 + q + 1] = r[1]; } }
                int w0 = 0, w1 = 0;
                w0 = __builtin_amdgcn_cvt_pk_fp8_f32(hv[0], hv[1], w0, false); w0 = __builtin_amdgcn_cvt_pk_fp8_f32(hv[2], hv[3], w0, true);
                w1 = __builtin_amdgcn_cvt_pk_fp8_f32(hv[4], hv[5], w1, false); w1 = __builtin_amdgcn_cvt_pk_fp8_f32(hv[6], hv[7], w1, true);
                *(u32x2*)(hid + (size_t)(row0 + ai * 128 + m * 16) * DE + col0) = (u32x2){(unsigned)w0, (unsigned)w1}; }
    }
};
struct ProbMoe2 {
    static constexpr bool WIDE = true;
    static constexpr bool HAS_BIAS = true;
    __device__ __forceinline__ void dma_bias(const pg8::Unit& u, LAS unsigned* slot, int lane) const { __builtin_amdgcn_global_load_lds((const unsigned*)(bdn + (size_t)u.e * 1024 + u.pn * 256 + 4 * lane), slot, 16, 0, 0); }
    static constexpr bool PERM = true, FP8 = true; static constexpr bool ULIST = false; static constexpr bool ACC_BIAS = true;
    __device__ __forceinline__ void acc_init(f32x4 (&acc)[2][2][4][2], const LAS float* bs, int wc, int fq) const { const int cl = wc * 64 + 16 * fq;
#pragma unroll
        for (int bj = 0; bj < 2; ++bj)
#pragma unroll
            for (int n = 0; n < 2; ++n) { const f32x4 b8 = *(const LAS f32x4*)(bs + cl + 8 * bj + 4 * n) * YS_SCALE;
#pragma unroll
                for (int ai = 0; ai < 2; ++ai)
#pragma unroll
                    for (int m = 0; m < 4; ++m) acc[ai][bj][m][n] = b8; } }
    const unsigned char* hid; const unsigned char* Wdn; const float* bdn; unsigned char* ys; const float* rgate; MoeTab tb; int G, c;
    __device__ __forceinline__ int scale_w(const pg8::Unit& u) const { return (127 - tb.scl[u.e]) * 0x01010101; }
    __device__ __forceinline__ int scale_x() const { return (int)((unsigned)(127 - HID_SCALE_LOG2 + 3) * 0x01010101u); }
    __device__ __forceinline__ bool next(int i, pg8::Unit& u) const { return moe_next(tb, 4, G, c, i, u); }
    __device__ __forceinline__ const char* a_base() const { return (const char*)hid; }
    __device__ __forceinline__ void a_key(const pg8::Unit& u, const int (&R)[2], int (&k)[2][2]) const {
#pragma unroll
        for (int h = 0; h < 2; ++h)
#pragma unroll
            for (int i = 0; i < 2; ++i) k[h][i] = u.pm * 256 + h * 128 + R[i];
    }
    __device__ __forceinline__ const char* b_base(const pg8::Unit& u) const { return (const char*)Wdn + ((size_t)u.e * 1024 + (size_t)u.pn * 256) * pg8::KD; }
    __device__ __forceinline__ void epi(const f32x4 (&acc)[2][2][4][2], const pg8::Unit& u, const LAS float* bs, int wr, int wc, int fr, int fq) const {
        const int row0 = u.pm * 256 + wr * 64 + fr, col0 = u.pn * 256 + wc * 64 + 16 * fq; const int cl = wc * 64 + 16 * fq;
#pragma unroll
        for (int ai = 0; ai < 2; ++ai)
#pragma unroll
            for (int m = 0; m < 4; ++m) { int w4[4];
#pragma unroll
                for (int bj = 0; bj < 2; ++bj)
#pragma unroll
                    for (int n = 0; n < 2; ++n) { const f32x4 v = acc[ai][bj][m][n]; int t_ = 0; t_ = __builtin_amdgcn_cvt_pk_fp8_f32(v[0], v[1], t_, false); t_ = __builtin_amdgcn_cvt_pk_fp8_f32(v[2], v[3], t_, true); w4[bj * 2 + n] = t_; }
                *(u32x4*)(ys + (size_t)(row0 + ai * 128 + m * 16) * D + col0) = (u32x4){(unsigned)w4[0], (unsigned)w4[1], (unsigned)w4[2], (unsigned)w4[3]}; }
    }
};

constexpr int HA_QH = 0, HA_KH = 8704, HA_QT = 17408, HA_KT = 26112, HA_VT = 36352, HA_DEC = 46592, HA_OPB = 47104;
constexpr int HA_ST = 2 * HA_OPB, HA_P = HA_ST + 34816, HA_TOT = HA_P + 2560;
__device__ __forceinline__ void hg_phase_a(LAS unsigned char* lds, int item, int l, const bf16_t* proj, const float* lbt, bf16_t* oloc, bf16_t* qseg, float* sfin, float* dseg) {
    int tid_l = (int)threadIdx.x; asm volatile("" : "+v"(tid_l));
    const int tid = tid_l, lane = tid & 63, w = __builtin_amdgcn_readfirstlane(tid >> 6), fr = lane & 15, fq = lane >> 4;
    const int seg = item & 3, dir = (item >> 2) & 1, h = (item >> 3) & 3, b = item >> 5;
    const int d0 = 2 * lane;
    const f32x2 lb2 = *(const f32x2*)(lbt + (size_t)l * 2 * HGW + dir * HGW + h * 128 + d0); const f32x2 omlb2 = (f32x2){1.0f, 1.0f} - lb2;
    LAS float* tot = (LAS float*)(lds + HA_TOT);
    __syncthreads();
    { unsigned z_ = 0u; asm volatile("" : "+v"(z_));
      for (int i = tid; i < 34816 / 16; i += NTHR) *(LAS u32x4*)(lds + HA_ST + i * 16) = (u32x4){z_, z_, z_, z_}; }
    f32x4 accS[8];
#pragma unroll
    for (int i = 0; i < 8; ++i) accS[i] = (f32x4){0.f, 0.f, 0.f, 0.f};
    f32x2 Gc2 = {0.f, 0.f};
    unsigned rq[4], ri[4], rf[4];
    f32x2 cs2[4], kk2[4], qq2[4]; unsigned vv[4];
    const unsigned colq2_ = (unsigned)(h * 128 + d0) * 2u;
    const unsigned oloff_ = ((unsigned)(dir ? 15 - fr : fr) * (unsigned)HGW + (unsigned)(h * 128 + w * 16 + 4 * fq)) * 2u;
#define HG_ROW(c, p) ((unsigned)(b * SEQ + (dir ? (SEQ - 1 - (seg * 1024 + (c) * 32 + (p))) : (seg * 1024 + (c) * 32 + (p)))))
#define HG_LOAD(c) do { unsigned colq2 = colq2_; asm volatile("" : "+v"(colq2)); _Pragma("unroll") for (int i = 0; i < 4; ++i) { const char* rp_ = (const char*)proj + (size_t)HG_ROW(c, 4 * w + i) * (INC * 2); const char* rpf_ = rp_ + (size_t)dir * 1024; \
            rq[i] = *(const unsigned*)(rp_ + colq2); ri[i] = *(const unsigned*)(rp_ + (colq2 + 1024u)); rf[i] = *(const unsigned*)(rpf_ + (colq2 + 2048u)); } } while (0)
#define HG_X2(v_) (f32x2){__builtin_amdgcn_exp2f((v_)[0]), __builtin_amdgcn_exp2f((v_)[1])}
#define HG_R2(v_) (f32x2){__builtin_amdgcn_rcpf((v_)[0]), __builtin_amdgcn_rcpf((v_)[1])}
#define HG_E1() do { const f32x2 nl2_ = {-1.4426950408889634f, -1.4426950408889634f}, one2_ = {1.0f, 1.0f}, ln2_ = {0.6931471805599453f, 0.6931471805599453f}; f32x2 run2 = {0.f, 0.f}; \
            _Pragma("unroll") for (int i = 0; i < 4; ++i) {                                    \
                const f32x2 z2 = {bf2f(rf[i] & 0xffffu), bf2f(rf[i] >> 16)}; const f32x2 dz = HG_X2(z2 * nl2_) + one2_; const f32x2 sg = HG_R2(dz); const f32x2 f2 = lb2 + omlb2 * sg; \
                run2 += (f32x2){__builtin_amdgcn_logf(f2[0]), __builtin_amdgcn_logf(f2[1])} * ln2_; cs2[i] = run2; kk2[i] = omlb2 - omlb2 * sg; \
                const f32x2 q2 = {bf2f(rq[i] & 0xffffu), bf2f(rq[i] >> 16)}; const f32x2 dq = HG_X2(q2 * nl2_) + one2_; qq2[i] = q2 * HG_R2(dq); vv[i] = ri[i]; } \
            *(LAS f32x2*)(tot + w * 128 + d0) = run2; } while (0)
#define HG_E2(c, ob) do { unsigned colq2 = colq2_; asm volatile("" : "+v"(colq2)); f32x2 off = {0.f, 0.f}, gref = {0.f, 0.f}, glast = {0.f, 0.f}; const f32x2 l2e_ = {1.4426950408889634f, 1.4426950408889634f}; \
          _Pragma("unroll") for (int g_ = 0; g_ < 8; ++g_) { const f32x2 t_ = *(const LAS f32x2*)(tot + g_ * 128 + d0); if (g_ < w) off += t_; if (g_ < 4) gref += t_; glast += t_; } \
          const f32x2 grl = gref * l2e_, egref = HG_X2(grl), eglr = HG_X2((glast - gref) * l2e_), egc = HG_X2((gref + Gc2) * l2e_); \
          f32x2 kt2[4]; \
          _Pragma("unroll") for (int i = 0; i < 4; ++i) { const int p = 4 * w + i; const f32x2 e1 = HG_X2((off + cs2[i]) * l2e_ - grl), e2 = HG_R2(e1); const f32x2 qh = qq2[i] * e1, kh = kk2[i] * e2; kt2[i] = kh * eglr; \
              const f32x2 qt = qh * egref; \
              *(LAS unsigned*)(lds + (ob) + HA_QH + p * 272 + d0 * 2) = pk2(qh[0], qh[1]); *(LAS unsigned*)(lds + (ob) + HA_KH + p * 272 + d0 * 2) = pk2(kh[0], kh[1]); \
              *(LAS unsigned*)(lds + (ob) + HA_QT + p * 272 + d0 * 2) = pk2(qt[0], qt[1]); if (seg != 0) { const f32x2 qs = qh * egc; *(unsigned*)((char*)qseg + (size_t)((unsigned)dir * T + HG_ROW(c, p)) * (HGW * 2) + colq2) = pk2(qs[0], qs[1]); } } \
          _Pragma("unroll") for (int e = 0; e < 2; ++e) { \
              *(LAS u32x2*)(lds + (ob) + HA_KT + (d0 + e) * 80 + w * 8) = (u32x2){pk2(kt2[0][e], kt2[1][e]), pk2(kt2[2][e], kt2[3][e])}; \
              *(LAS u32x2*)(lds + (ob) + HA_VT + (d0 + e) * 80 + w * 8) = e ? (u32x2){(vv[0] >> 16) | (vv[1] & 0xffff0000u), (vv[2] >> 16) | (vv[3] & 0xffff0000u)} : (u32x2){(vv[0] & 0xffffu) | (vv[1] << 16), (vv[2] & 0xffffu) | (vv[3] << 16)}; } \
          if (w == 0) *(LAS f32x2*)(lds + (ob) + HA_DEC + d0 * 4) = HG_X2(glast * l2e_); Gc2 += glast; } while (0)
    HG_LOAD(0);
    HG_E1();
    HG_LOAD(1);
    __syncthreads();
    HG_E2(0, 0);
#define HG_XM() do { \
        if (w < 4) { const int tt = w >> 1, st = w & 1; f32x4 sc = (f32x4){0.f, 0.f, 0.f, 0.f}; \
            if (st <= tt) { \
        _Pragma("unroll") \
                for (int ks = 0; ks < 4; ++ks) { const bf16x8 a = *(const LAS bf16x8*)(lds + ob + HA_QH + (tt * 16 + fr) * 272 + ks * 64 + fq * 16), bb = *(const LAS bf16x8*)(lds + ob + HA_KH + (st * 16 + fr) * 272 + ks * 64 + fq * 16); \
                    sc = __builtin_amdgcn_mfma_f32_16x16x32_bf16(a, bb, sc, 0, 0, 0); } } \
        _Pragma("unroll") \
            for (int r = 0; r < 4; ++r) { const int t = tt * 16 + 4 * fq + r, s_ = st * 16 + fr; *(LAS unsigned short*)(lds + HA_P + t * 80 + s_ * 2) = (unsigned short)((s_ <= t) ? f2bf(sc[r]) : 0u); } } \
        _Pragma("unroll") \
        for (int ks = 0; ks < 4; ++ks) { const bf16x8 bs = *(const LAS bf16x8*)(lds + HA_ST + (w * 16 + fr) * 272 + ks * 64 + fq * 16); \
        _Pragma("unroll") \
            for (int tt = 0; tt < 2; ++tt) { const bf16x8 a = *(const LAS bf16x8*)(lds + ob + HA_QT + (tt * 16 + fr) * 272 + ks * 64 + fq * 16); ao[tt] = __builtin_amdgcn_mfma_f32_16x16x32_bf16(bs, a, ao[tt], 0, 0, 0); } } \
    } while (0)
#define HG_YM() do { \
        { const bf16x8 bv = *(const LAS bf16x8*)(lds + ob + HA_VT + (w * 16 + fr) * 80 + fq * 16); unsigned oloff = oloff_; asm volatile("" : "+v"(oloff)); \
        _Pragma("unroll") \
          for (int tt = 0; tt < 2; ++tt) { const bf16x8 a = *(const LAS bf16x8*)(lds + HA_P + (tt * 16 + fr) * 80 + fq * 16); ao[tt] = __builtin_amdgcn_mfma_f32_16x16x32_bf16(bv, a, ao[tt], 0, 0, 0); \
              const unsigned srow = dir ? HG_ROW(c, tt * 16 + 15) : HG_ROW(c, tt * 16); *(u32x2*)((char*)oloc + (size_t)((unsigned)dir * T + srow) * (HGW * 2) + oloff) = (u32x2){pk2(ao[tt][0], ao[tt][1]), pk2(ao[tt][2], ao[tt][3])}; } } \
        { const bf16x8 ak = *(const LAS bf16x8*)(lds + ob + HA_KT + (w * 16 + fr) * 80 + fq * 16); \
          const f32x4 dv = *(const LAS f32x4*)(lds + ob + HA_DEC + (w * 16 + 4 * fq) * 4); \
          bf16x8 bvs[8]; \
        _Pragma("unroll") \
          for (int vt = 0; vt < 8; ++vt) bvs[vt] = *(const LAS bf16x8*)(lds + ob + HA_VT + (vt * 16 + fr) * 80 + fq * 16); \
        _Pragma("unroll") \
          for (int vt = 0; vt < 8; ++vt) accS[vt] = accS[vt] * dv; \
        _Pragma("unroll") \
          for (int vt = 0; vt < 8; ++vt) accS[vt] = __builtin_amdgcn_mfma_f32_16x16x32_bf16(ak, bvs[vt], accS[vt], 0, 0, 0); \
        _Pragma("unroll") \
          for (int vt = 0; vt < 8; ++vt) { u32x2 sw; sw.x = pk2(accS[vt][0], accS[vt][1]); sw.y = pk2(accS[vt][2], accS[vt][3]); \
              *(LAS u32x2*)(lds + HA_ST + (vt * 16 + fr) * 272 + (w * 16 + 4 * fq) * 2) = sw; } } \
    } while (0)
    for (int c = 0; c < 32; ++c) {
        const int ob = (c & 1) * HA_OPB, obn = ((c + 1) & 1) * HA_OPB;
        __syncthreads();
        f32x4 ao[2] = {(f32x4){0.f, 0.f, 0.f, 0.f}, (f32x4){0.f, 0.f, 0.f, 0.f}};
        if (w < 4) { HG_XM(); HG_E1(); } else { HG_E1(); HG_XM(); }
        { const int cn_ = c + 2 < 32 ? c + 2 : 31; HG_LOAD(cn_); }
        __syncthreads();
        if (w < 4) { HG_YM(); if (c + 1 < 32) HG_E2(c + 1, obn); } else { if (c + 1 < 32) HG_E2(c + 1, obn); HG_YM(); }
    }
#undef HG_XM
#undef HG_YM
#undef HG_ROW
#undef HG_LOAD
#undef HG_E1
#undef HG_E2
#undef HG_X2
#undef HG_R2
    if (seg != 3)
#pragma unroll
    for (int vt = 0; vt < 8; ++vt) *(f32x4*)(sfin + (size_t)item * 16384 + (size_t)(vt * 16 + fr) * 128 + w * 16 + 4 * fq) = accS[vt];
    if (w == 0) *(f32x2*)(dseg + (size_t)item * 128 + d0) = (f32x2){exp_(Gc2[0]), exp_(Gc2[1])};
    __syncthreads();
}

__device__ __forceinline__ void hg_phase_c(LAS unsigned char* lds, int cb, int l, const bf16_t* proj, const bf16_t* oloc, const bf16_t* qseg, const float* sfin, const float* dseg, const float* hgn, bf16_t* mix) {
    int tid_l = (int)threadIdx.x; asm volatile("" : "+v"(tid_l));
    const int tid = tid_l, lane = tid & 63, w = __builtin_amdgcn_readfirstlane(tid >> 6), fr = lane & 15, fq = lane >> 4;
    const int half = cb & 1, segtok = (cb >> 1) & 3, h = (cb >> 3) & 3, b = cb >> 5;
    __syncthreads();
#pragma unroll
    for (int dir = 0; dir < 2; ++dir) { const int k = dir ? 3 - segtok : segtok; const int item0 = ((b * 4 + h) * 2 + dir) * 4;
        f32x4 s0[8], s1[8], s2[8], d1[8], d2[8];
#pragma unroll
        for (int i = 0; i < 8; ++i) { const int e4 = tid + NTHR * i; const int v = e4 >> 5, d0 = (e4 & 31) * 4; const size_t so = (size_t)v * 128 + d0;
            s0[i] = k > 0 ? *(const f32x4*)(sfin + (size_t)(item0 + 0) * 16384 + so) : (f32x4){0.f, 0.f, 0.f, 0.f};
            s1[i] = k > 1 ? *(const f32x4*)(sfin + (size_t)(item0 + 1) * 16384 + so) : (f32x4){0.f, 0.f, 0.f, 0.f};
            s2[i] = k > 2 ? *(const f32x4*)(sfin + (size_t)(item0 + 2) * 16384 + so) : (f32x4){0.f, 0.f, 0.f, 0.f};
            d1[i] = k > 1 ? *(const f32x4*)(dseg + (size_t)(item0 + 1) * 128 + d0) : (f32x4){1.f, 1.f, 1.f, 1.f};
            d2[i] = k > 2 ? *(const f32x4*)(dseg + (size_t)(item0 + 2) * 128 + d0) : (f32x4){1.f, 1.f, 1.f, 1.f}; }
#pragma unroll
        for (int i = 0; i < 8; ++i) { const int e4 = tid + NTHR * i; const int v = e4 >> 5, d0 = (e4 & 31) * 4; f32x4 cv = s0[i];
            if (k > 1) cv = cv * d1[i] + s1[i];
            if (k > 2) cv = cv * d2[i] + s2[i];
            u32x2 cw; cw.x = pk2(cv[0], cv[1]); cw.y = pk2(cv[2], cv[3]); *(LAS u32x2*)(lds + dir * 34816 + v * 272 + d0 * 2) = cw; } }
    __syncthreads();
    f32x4 gnv[8];
#pragma unroll
    for (int vt = 0; vt < 8; ++vt) gnv[vt] = *(const f32x4*)(hgn + h * 128 + vt * 16 + 4 * fq);
    const int kf = segtok, kb = 3 - segtok;
#pragma unroll 1
    for (int tile = 0; tile < 4; ++tile) {
        const int t = segtok * 1024 + (half * 4 + tile) * 128 + w * 16 + fr; const size_t row = (size_t)b * SEQ + t;
        bf16x8 bq[2][4]; u32x2 olf[8], olb[8], zgv[8];
#pragma unroll
        for (int dir = 0; dir < 2; ++dir)
#pragma unroll
            for (int ks = 0; ks < 4; ++ks) bq[dir][ks] = *(const bf16x8*)(qseg + ((size_t)dir * T + row) * HGW + h * 128 + ks * 32 + fq * 8);
#pragma unroll
        for (int vt = 0; vt < 8; ++vt) { const int v0 = vt * 16 + 4 * fq; olf[vt] = *(const u32x2*)(oloc + (size_t)row * HGW + h * 128 + v0); olb[vt] = *(const u32x2*)(oloc + ((size_t)T + row) * HGW + h * 128 + v0);
            zgv[vt] = *(const u32x2*)(proj + row * INC + 2048 + h * 128 + v0); }
        f32x4 acc[8];
#pragma unroll
        for (int i = 0; i < 8; ++i) acc[i] = (f32x4){0.f, 0.f, 0.f, 0.f};
#pragma unroll
        for (int dir = 0; dir < 2; ++dir) { const int k = dir ? kb : kf;
            if (k > 0) {
#pragma unroll
                for (int ks = 0; ks < 4; ++ks) {
#pragma unroll
                    for (int vt = 0; vt < 8; ++vt) { const bf16x8 ac = *(const LAS bf16x8*)(lds + dir * 34816 + (vt * 16 + fr) * 272 + ks * 64 + fq * 16); acc[vt] = __builtin_amdgcn_mfma_f32_16x16x32_bf16(ac, bq[dir][ks], acc[vt], 0, 0, 0); } } } }
        float ss = 0.f;
#pragma unroll
        for (int vt = 0; vt < 8; ++vt) { const u32x2 of = olf[vt], ob = olb[vt];
            acc[vt][0] += bf2f(of.x & 0xffffu) + bf2f(ob.x & 0xffffu); acc[vt][1] += bf2f(of.x >> 16) + bf2f(ob.x >> 16); acc[vt][2] += bf2f(of.y & 0xffffu) + bf2f(ob.y & 0xffffu); acc[vt][3] += bf2f(of.y >> 16) + bf2f(ob.y >> 16);
            ss += (acc[vt][0] * acc[vt][0] + acc[vt][1] * acc[vt][1]) + (acc[vt][2] * acc[vt][2] + acc[vt][3] * acc[vt][3]); }
        ss += __shfl_xor(ss, 16); ss += __shfl_xor(ss, 32);
        const float rs = rsqf_(ss * (1.0f / 128.f) + RMS_EPS);
#pragma unroll
        for (int vt = 0; vt < 8; ++vt) { const int v0 = vt * 16 + 4 * fq; const u32x2 zg = zgv[vt]; const f32x4 gn = gnv[vt];
            const float z0 = bf2f(zg.x & 0xffffu), z1 = bf2f(zg.x >> 16), z2 = bf2f(zg.y & 0xffffu), z3 = bf2f(zg.y >> 16);
            const float rs2 = rs * MIX_SCALE; int q_ = 0; q_ = __builtin_amdgcn_cvt_pk_fp8_f32(acc[vt][0] * rs2 * gn[0] * (z0 * sigmoidf_(z0)), acc[vt][1] * rs2 * gn[1] * (z1 * sigmoidf_(z1)), q_, false);
            q_ = __builtin_amdgcn_cvt_pk_fp8_f32(acc[vt][2] * rs2 * gn[2] * (z2 * sigmoidf_(z2)), acc[vt][3] * rs2 * gn[3] * (z3 * sigmoidf_(z3)), q_, true);
            *(int*)((unsigned char*)mix + row * D + h * 128 + v0) = q_; }
    }
}

constexpr int LR_XC = 0, LR_CAR = 65536, LR_RED = 73728, LR_HS = 75776;
template <int MODE>
__device__ __forceinline__ void lru_pair(LAS unsigned char* lds, int b, int kpair, const bf16_t* proj, const float* cw, const float* cbias, const bf16_t* lruw_l, const float* ba_l, const float* bx_l, const float* lam_l, float* lsum, const float* lrn, bf16_t* mix) {
    int tid_l = (int)threadIdx.x; asm volatile("" : "+v"(tid_l));
    const int tid = tid_l, lane = tid & 63, w = __builtin_amdgcn_readfirstlane(tid >> 6), fr = lane & 15, fq = lane >> 4;
    __syncthreads();
    if (MODE == 1) {
        const int c0 = tid, k0s = 2 * kpair; float cf = 0.f, cbk = 0.f;
        const float* Af = lsum + ((size_t)(0 * 2 + 0) * BATCH + b) * 64 * LRW + c0; const float* Hf = lsum + ((size_t)(0 * 2 + 1) * BATCH + b) * 64 * LRW + c0;
        const float* Ab = lsum + ((size_t)(1 * 2 + 0) * BATCH + b) * 64 * LRW + c0; const float* Hb = lsum + ((size_t)(1 * 2 + 1) * BATCH + b) * 64 * LRW + c0;
        for (int k0 = 0; k0 < k0s; k0 += 16) { float av[16], hv[16];
#pragma unroll
            for (int q = 0; q < 16; ++q) { const int kk = k0 + q; const bool ok = kk < k0s; av[q] = ok ? Af[(size_t)kk * LRW] : 1.0f; hv[q] = ok ? Hf[(size_t)kk * LRW] : 0.0f; }
#pragma unroll
            for (int q = 0; q < 16; ++q) cf = av[q] * cf + hv[q]; }
        for (int k0 = 63; k0 > k0s + 1; k0 -= 16) { float av[16], hv[16];
#pragma unroll
            for (int q = 0; q < 16; ++q) { const int kk = k0 - q; const bool ok = kk > k0s + 1; av[q] = ok ? Ab[(size_t)kk * LRW] : 1.0f; hv[q] = ok ? Hb[(size_t)kk * LRW] : 0.0f; }
#pragma unroll
            for (int q = 0; q < 16; ++q) cbk = av[q] * cbk + hv[q]; }
        LAS float* car = (LAS float*)(lds + LR_CAR);
        car[(0 * 2 + 0) * 512 + c0] = cf; car[(1 * 2 + 0) * 512 + c0] = Af[(size_t)k0s * LRW] * cf + Hf[(size_t)k0s * LRW];
        car[(1 * 2 + 1) * 512 + c0] = cbk; car[(0 * 2 + 1) * 512 + c0] = Ab[(size_t)(k0s + 1) * LRW] * cbk + Hb[(size_t)(k0s + 1) * LRW];
    }
#pragma unroll 1
    for (int sub = 0; sub < 2; ++sub) {
        const int ksub = 2 * kpair + sub; const size_t row0 = (size_t)b * SEQ + (size_t)ksub * 64;
        if (sub) __syncthreads();
        { const int cp = (tid & 255) * 2, th = tid >> 8; const int t0 = ksub * 64 + th * 32;
          const f32x2 w0 = *(const f32x2*)(cw + cp), w1 = *(const f32x2*)(cw + LRW + cp), w2 = *(const f32x2*)(cw + 2 * LRW + cp), w3 = *(const f32x2*)(cw + 3 * LRW + cp), bs = *(const f32x2*)(cbias + cp);
          const bf16_t* zp = proj + ((size_t)b * SEQ + t0) * INC + 2560 + cp;
          unsigned zr[35];
#pragma unroll
          for (int q = 0; q < 35; ++q) { const bool edge = (q < 2) || (q == 34); const bool ok = (q < 2) ? (t0 != 0) : (t0 + 32 < SEQ);
              const long ro = edge ? (ok ? (long)(q - 2) : 0L) : (long)(q - 2); const unsigned zv = *(const unsigned*)(zp + ro * INC); zr[q] = (edge && !ok) ? 0u : zv; }
          const int hd = cp >> 6, ii = cp & 63;
#pragma unroll
          for (int q = 0; q < 32; ++q) { const int tl = th * 32 + q;
              const float x0 = bs[0] + w0[0] * bf2f(zr[q] & 0xffffu) + w1[0] * bf2f(zr[q + 1] & 0xffffu) + w2[0] * bf2f(zr[q + 2] & 0xffffu) + w3[0] * bf2f(zr[q + 3] & 0xffffu);
              const float x1 = bs[1] + w0[1] * bf2f(zr[q] >> 16) + w1[1] * bf2f(zr[q + 1] >> 16) + w2[1] * bf2f(zr[q + 2] >> 16) + w3[1] * bf2f(zr[q + 3] >> 16);
              *(LAS unsigned*)(lds + LR_XC + hd * 8192 + tl * 128 + ((((ii >> 3) ^ (tl & 7))) << 4) + (ii & 7) * 2) = pk2(x0, x1); } }
        __syncthreads();
        float ssq[16];
#pragma unroll
        for (int k = 0; k < 16; ++k) ssq[k] = 0.f;
        bf16x8 bw[2][4]; float cst[2][3];
#pragma unroll
        for (int q_ = 0; q_ < 4; ++q_) bw[1][q_] = (bf16x8){0, 0, 0, 0, 0, 0, 0, 0};
        cst[1][0] = cst[1][1] = cst[1][2] = 0.f;
#define LR_LOADW(it, buf) do { const int jt_ = (it) >> 1, dir_ = (it) & 1, j_ = jt_ * 16 + fr, c_ = w * 64 + j_; \
            _Pragma("unroll") for (int ks_ = 0; ks_ < 2; ++ks_) { bw[buf][ks_ * 2 + 0] = *(const bf16x8*)(lruw_l + ((size_t)((dir_ * 2 + 0) * LRH + w) * 64 + j_) * 64 + ks_ * 32 + fq * 8); \
                                                                  bw[buf][ks_ * 2 + 1] = *(const bf16x8*)(lruw_l + ((size_t)((dir_ * 2 + 1) * LRH + w) * 64 + j_) * 64 + ks_ * 32 + fq * 8); } \
            cst[buf][0] = ba_l[dir_ * LRW + c_]; cst[buf][1] = bx_l[dir_ * LRW + c_]; cst[buf][2] = lam_l[dir_ * LRW + c_]; } while (0)
        LR_LOADW(0, 0);
#pragma unroll 1
        for (int jt = 0; jt < 4; ++jt) {
            const int j = jt * 16 + fr, c = w * 64 + j;
            float xcv[16], hsum[16];
#pragma unroll
            for (int k = 0; k < 16; ++k) { const int tl = 16 * fq + k; xcv[k] = bf2f(*(const LAS unsigned short*)(lds + LR_XC + w * 8192 + tl * 128 + ((((j >> 3) ^ (tl & 7))) << 4) + (j & 7) * 2)); }
#pragma unroll
            for (int dir = 0; dir < 2; ++dir) {
                constexpr int dummy = 0; (void)dummy;
                const int it = jt * 2 + dir; constexpr int dummy2 = 0; (void)dummy2; const int buf = dir;
                { const int itn_ = (it + 1 < 8) ? it + 1 : 7; LR_LOADW(itn_, dir ^ 1); }
                const float bav = cst[buf][0], bxv = cst[buf][1], lamv = cst[buf][2];
                const float sp8 = -8.0f * ((lamv < -20.f) ? -lamv : log_(1.0f + exp_(-lamv)));
                f32x4 aR[4], aI[4];
#pragma unroll
                for (int tt = 0; tt < 4; ++tt) { aR[tt] = (f32x4){0.f, 0.f, 0.f, 0.f}; aI[tt] = (f32x4){0.f, 0.f, 0.f, 0.f}; }
#pragma unroll
                for (int ks = 0; ks < 2; ++ks) {
#pragma unroll
                    for (int tt = 0; tt < 4; ++tt) { const int tla = 16 * (fr >> 2) + 4 * tt + (fr & 3); const bf16x8 av = *(const LAS bf16x8*)(lds + LR_XC + w * 8192 + tla * 128 + ((((ks * 4 + fq) ^ (tla & 7))) << 4));
                        aR[tt] = __builtin_amdgcn_mfma_f32_16x16x32_bf16(av, bw[buf][ks * 2 + 0], aR[tt], 0, 0, 0); aI[tt] = __builtin_amdgcn_mfma_f32_16x16x32_bf16(av, bw[buf][ks * 2 + 1], aI[tt], 0, 0, 0); } }
                float hl[16], pc[16]; float hh = 0.f, pp = 1.0f;
                { constexpr float NL2E = -1.4426950408889634f; const f32x2 nl2 = {NL2E, NL2E}, one2 = {1.0f, 1.0f}, bar2 = {bav * NL2E, bav * NL2E}, bxr2 = {bxv * NL2E, bxv * NL2E}, spl2 = {sp8 * -NL2E, sp8 * -NL2E};
#pragma unroll
                  for (int k = 0; k < 16; k += 2) { const int tt = k >> 2, r = k & 3;
                    const f32x2 er = (f32x2){aR[tt][r], aR[tt][r + 1]} * nl2 + bar2, ei = (f32x2){aI[tt][r], aI[tt][r + 1]} * nl2 + bxr2;
                    const f32x2 dr = (f32x2){__builtin_amdgcn_exp2f(er[0]), __builtin_amdgcn_exp2f(er[1])} + one2, di = (f32x2){__builtin_amdgcn_exp2f(ei[0]), __builtin_amdgcn_exp2f(ei[1])} + one2;
                    const f32x2 rr = {__builtin_amdgcn_rcpf(dr[0]), __builtin_amdgcn_rcpf(dr[1])}, ig = {__builtin_amdgcn_rcpf(di[0]), __builtin_amdgcn_rcpf(di[1])};
                    const f32x2 ea = rr * spl2; const f32x2 a = {__builtin_amdgcn_exp2f(ea[0]), __builtin_amdgcn_exp2f(ea[1])};
                    const f32x2 om = one2 - a * a; const f32x2 sq = {__builtin_amdgcn_sqrtf(__builtin_fabsf(om[0])), __builtin_amdgcn_sqrtf(__builtin_fabsf(om[1]))};
                    const f32x2 u = sq * (ig * (f32x2){xcv[k], xcv[k + 1]});
                    pc[k] = a[0]; pc[k + 1] = a[1]; hl[k] = u[0]; hl[k + 1] = u[1]; } }
#pragma unroll
                for (int kk = 0; kk < 16; ++kk) { const int k = dir ? 15 - kk : kk; hh = pc[k] * hh + hl[k]; pp = pp * pc[k]; hl[k] = hh; pc[k] = pp; }
                const float P0 = __shfl(pp, fr), P1 = __shfl(pp, fr + 16), P2 = __shfl(pp, fr + 32), P3 = __shfl(pp, fr + 48);
                const float H0 = __shfl(hh, fr), H1 = __shfl(hh, fr + 16), H2 = __shfl(hh, fr + 32), H3 = __shfl(hh, fr + 48);
                float cin, pin, Ht, At;
                if (dir == 0) { const float c1 = H0, c2 = P1 * c1 + H1, c3 = P2 * c2 + H2; const float p1 = P0, p2 = P0 * P1, p3 = p2 * P2;
                    cin = fq == 0 ? 0.f : (fq == 1 ? c1 : (fq == 2 ? c2 : c3)); pin = fq == 0 ? 1.0f : (fq == 1 ? p1 : (fq == 2 ? p2 : p3)); Ht = P3 * c3 + H3; At = p3 * P3; }
                else { const float c2 = H3, c1 = P2 * c2 + H2, c0_ = P1 * c1 + H1; const float p2 = P3, p1 = P3 * P2, p0 = p1 * P1;
                    cin = fq == 3 ? 0.f : (fq == 2 ? c2 : (fq == 1 ? c1 : c0_)); pin = fq == 3 ? 1.0f : (fq == 2 ? p2 : (fq == 1 ? p1 : p0)); Ht = P0 * c0_ + H0; At = p0 * P0; }
                if (MODE == 0) { if (fq == 0) { lsum[(((size_t)(dir * 2 + 0) * BATCH + b) * 64 + ksub) * LRW + c] = At; lsum[(((size_t)(dir * 2 + 1) * BATCH + b) * 64 + ksub) * LRW + c] = Ht; } }
                else { const float ein = cin + pin * ((const LAS float*)(lds + LR_CAR))[(sub * 2 + dir) * 512 + c];
#pragma unroll
                    for (int k = 0; k < 16; ++k) { const float hv = hl[k] + pc[k] * ein; hsum[k] = dir ? hsum[k] + hv : hv; } }
            }
            if (MODE == 1) {
#pragma unroll
                for (int k = 0; k < 16; ++k) { ssq[k] += hsum[k] * hsum[k]; *(LAS unsigned short*)(lds + LR_HS + (16 * fq + k) * 1024 + c * 2) = (unsigned short)f2bf(hsum[k]); }
            }
        }
#undef LR_LOADW
        if (MODE == 1) {
            LAS float* red = (LAS float*)(lds + LR_RED);
#pragma unroll
            for (int k = 0; k < 16; ++k) {
#define LR_DPP_ADD(ctrl) ssq[k] += __builtin_bit_cast(float, __builtin_amdgcn_update_dpp(0, __builtin_bit_cast(int, ssq[k]), ctrl, 0xf, 0xf, false))
                LR_DPP_ADD(0xB1); LR_DPP_ADD(0x4E); LR_DPP_ADD(0x141); LR_DPP_ADD(0x140);
#undef LR_DPP_ADD
            }
            if (fr == 0) {
#pragma unroll
                for (int k = 0; k < 16; ++k) red[w * 64 + 16 * fq + k] = ssq[k]; }
            __syncthreads();
#pragma unroll 2
            for (int i = 0; i < 8; ++i) { const int idx = tid + NTHR * i, tk = idx >> 6, c8 = (idx & 63) * 8; float t_ = 0.f;
#pragma unroll
                for (int ww = 0; ww < 8; ++ww) t_ += red[ww * 64 + tk];
                const float rs = rsqf_(t_ * (1.0f / 512.f) + RMS_EPS);
                const u32x4 hw = *(const LAS u32x4*)(lds + LR_HS + tk * 1024 + c8 * 2); const size_t row = row0 + tk; const u32x4 zw = *(const u32x4*)(proj + row * INC + 3072 + c8);
                const f32x4 g0 = *(const f32x4*)(lrn + c8), g1 = *(const f32x4*)(lrn + c8 + 4); unsigned ow[4];
#pragma unroll
                for (int q = 0; q < 4; ++q) {
                    const f32x2 hv = {bf2f(hw[q] & 0xffffu), bf2f(hw[q] >> 16)}, zz = {bf2f(zw[q] & 0xffffu), bf2f(zw[q] >> 16)};
                    const f32x2 gq = (q < 2) ? (f32x2){g0[2 * q], g0[2 * q + 1]} : (f32x2){g1[2 * q - 4], g1[2 * q - 3]};
                    const f32x2 tt_ = zz * zz * (f32x2){0.044715f, 0.044715f} + (f32x2){1.0f, 1.0f};
                    const f32x2 ar_ = zz * tt_ * (f32x2){-1.5957691216057308f * 1.4426950408889634f, -1.5957691216057308f * 1.4426950408889634f};
                    const f32x2 dn_ = (f32x2){__builtin_amdgcn_exp2f(ar_[0]), __builtin_amdgcn_exp2f(ar_[1])} + (f32x2){1.0f, 1.0f};
                    const f32x2 ge_ = zz * (f32x2){__builtin_amdgcn_rcpf(dn_[0]), __builtin_amdgcn_rcpf(dn_[1])};
                    const f32x2 rr = hv * (gq * (f32x2){rs * MIX_SCALE, rs * MIX_SCALE}) * ge_;
                    ow[q >> 1] = (unsigned)((q & 1) ? __builtin_amdgcn_cvt_pk_fp8_f32(rr[0], rr[1], (int)ow[q >> 1], true) : __builtin_amdgcn_cvt_pk_fp8_f32(rr[0], rr[1], 0, false)); }
                *(u32x2*)((unsigned char*)mix + row * D + 512 + c8) = (u32x2){ow[0], ow[1]}; }
        }
    }
}

#define XB_TMO      128
#define XB_XCNT(j)  (256  + 64 * (j))
#define XB_XSUB(j)  (1280 + 64 * (j))
#define XB_XGEN(j)  (2304 + 64 * (j))
#define XB_TOP      3328
#define XB_TOPGEN   3392
#define XCD_BAR_WORDS 3456
#define XB_SPIN_CAP (1u << 18)
__device__ __forceinline__ unsigned xb_ld(unsigned* p)              { return __hip_atomic_load(p, __ATOMIC_RELAXED, __HIP_MEMORY_SCOPE_AGENT); }
__device__ __forceinline__ unsigned xb_add(unsigned* p, unsigned v) { return __hip_atomic_fetch_add(p, v, __ATOMIC_RELAXED, __HIP_MEMORY_SCOPE_AGENT); }
__device__ __forceinline__ unsigned xb_xcc_id() { return (unsigned)__builtin_amdgcn_s_getreg((3 << 11) | 20) & 0xFu; }
#define XB_SPIN(cond, bar) do { unsigned _sp = 0; while (cond) { __builtin_amdgcn_s_sleep(1); \
    if ((++_sp & 255u) == 0u) { if (xb_ld(&(bar)[XB_TMO])) break; if (_sp > XB_SPIN_CAP) { atomicAdd(&(bar)[XB_TMO], 1u); break; } } } } while (0)
struct XcdBarrier { unsigned* bar; unsigned x; volatile LAS unsigned* st; };
__device__ __forceinline__ XcdBarrier xcd_barrier_post(unsigned* bar, volatile LAS unsigned* st) {
    XcdBarrier b; b.bar = bar; b.x = xb_xcc_id(); b.st = st;
    if (threadIdx.x == 0) (void)xb_add(&bar[XB_XCNT(b.x)], 1u);
    return b;
}
__device__ __forceinline__ void xcd_barrier_complete(unsigned* bar, unsigned x, unsigned& nloc, unsigned& nx) {
    const unsigned G = gridDim.x * gridDim.y * gridDim.z;
    unsigned sum, cnt, mine, sp = 0u;
    for (;;) {
        sum = 0u; cnt = 0u; mine = 0u;
#pragma unroll
        for (unsigned j = 0; j < 16; ++j) { const unsigned c = xb_ld(&bar[XB_XCNT(j)]); sum += c; cnt += (c > 0u) ? 1u : 0u; mine = (j == x) ? c : mine; }
        if (sum == G) break;
        __builtin_amdgcn_s_sleep(1);
        if ((++sp & 255u) == 0u) { if (xb_ld(&bar[XB_TMO])) break; if (sp > XB_SPIN_CAP) { atomicAdd(&bar[XB_TMO], 1u); break; } }
    }
    nloc = mine > 0u ? mine : 1u; nx = cnt > 0u ? cnt : 1u;
}
__device__ __forceinline__ void xcd_barrier(const XcdBarrier& b_in) {
    XcdBarrier b = b_in; asm volatile("" : "+s"(b.bar), "+s"(b.x));
    asm volatile("s_waitcnt vmcnt(0)" ::: "memory");
    __syncthreads();
    if (threadIdx.x == 0) {
        unsigned* bar = b.bar;
        __builtin_amdgcn_s_waitcnt(0);
        unsigned nloc = b.st[0], nx = b.st[1];
        if (nloc == 0u) { xcd_barrier_complete(bar, b.x, nloc, nx); b.st[0] = nloc; b.st[1] = nx; }
        const unsigned old = xb_add(&bar[XB_XSUB(b.x)], 1u);
        const unsigned gen = old / nloc;
        if (old + 1u == (gen + 1u) * nloc) {
            __builtin_amdgcn_fence(__ATOMIC_RELEASE, "agent");
            asm volatile("s_waitcnt vmcnt(0)" ::: "memory");
            const unsigned og = xb_add(&bar[XB_TOP], 1u);
            const unsigned tg = og / nx;
            if (og + 1u == (tg + 1u) * nx) xb_add(&bar[XB_TOPGEN], 1u);
            else XB_SPIN(xb_ld(&bar[XB_TOPGEN]) == tg, bar);
            __builtin_amdgcn_fence(__ATOMIC_ACQUIRE, "agent");
            xb_add(&bar[XB_XGEN(b.x)], 1u);
            asm volatile("s_waitcnt vmcnt(0)" ::: "memory");
        } else {
            XB_SPIN(xb_ld(&bar[XB_XGEN(b.x)]) == gen, bar);
            __builtin_amdgcn_fence(__ATOMIC_ACQUIRE, "agent");
            asm volatile("s_waitcnt vmcnt(0)" ::: "memory");
        }
    }
    __syncthreads();
}

struct Args { const float* in[23]; float* out; unsigned char* ws; int l_lo, l_hi, ph_lo, ph_hi, pro, pad; };
enum { I_X = 0, I_WIN, I_HGLB, I_HGNORM, I_CONVW, I_CONVB, I_WA, I_BA, I_WX, I_BX, I_LAM, I_LRUNORM, I_WOUT, I_LN1G, I_LN1B, I_RW, I_RB, I_WGU, I_BGU, I_WDN, I_BDN, I_LN2G, I_LN2B };
enum { PH_PROJ = 1, PH_HG = 2, PH_LRUAU = 3, PH_LRUSCAN = 4, PH_COMB = 5, PH_OUTG = 6, PH_LN1R = 7, PH_MOE1 = 8, PH_MOE2 = 9, PH_LN2 = 10, PH_END = 11 };

__device__ __forceinline__ void transpose_item(const float* W, int N, int k0, int n0, bf16_t* WT, size_t dst_row0, int KP, LAS float* scr, int lane) {
#pragma unroll 8
    for (int i = 0; i < 32; ++i) { const int kk = 2 * i + (lane >> 5); scr[kk * 33 + (lane & 31)] = W[(size_t)(k0 + kk) * N + n0 + (lane & 31)]; }
    LDS_WAIT(); asm volatile("" ::: "memory");
    const int c = lane & 7;
#pragma unroll
    for (int j = 0; j < 4; ++j) { const int n = (lane >> 3) + 8 * j; const LAS float* s = scr + (8 * c) * 33 + n;
        u32x4 o; o.x = pk2(s[0 * 33], s[1 * 33]); o.y = pk2(s[2 * 33], s[3 * 33]); o.z = pk2(s[4 * 33], s[5 * 33]); o.w = pk2(s[6 * 33], s[7 * 33]);
        *(u32x4*)(WT + (dst_row0 + n) * KP + k0 + 8 * c) = o; }
    LDS_WAIT(); asm volatile("" ::: "memory");
}

__device__ __forceinline__ void transpose_item_q(const float* W, int N, int k0, int n0, unsigned char* WT, size_t dst_row0, int KP, float mul, LAS float* scr, int lane) {
#pragma unroll 8
    for (int i = 0; i < 32; ++i) { const int kk = 2 * i + (lane >> 5); scr[kk * 33 + (lane & 31)] = W[(size_t)(k0 + kk) * N + n0 + (lane & 31)]; }
    LDS_WAIT(); asm volatile("" ::: "memory");
    const int c = lane & 7;
#pragma unroll
    for (int j = 0; j < 4; ++j) { const int n = (lane >> 3) + 8 * j; const LAS float* s = scr + (8 * c) * 33 + n; int w0 = 0, w1 = 0;
        w0 = __builtin_amdgcn_cvt_pk_fp8_f32(s[0 * 33] * mul, s[1 * 33] * mul, w0, false); w0 = __builtin_amdgcn_cvt_pk_fp8_f32(s[2 * 33] * mul, s[3 * 33] * mul, w0, true);
        w1 = __builtin_amdgcn_cvt_pk_fp8_f32(s[4 * 33] * mul, s[5 * 33] * mul, w1, false); w1 = __builtin_amdgcn_cvt_pk_fp8_f32(s[6 * 33] * mul, s[7 * 33] * mul, w1, true);
        *(u32x2*)(WT + (dst_row0 + n) * KP + k0 + 8 * c) = (u32x2){(unsigned)w0, (unsigned)w1}; }
    LDS_WAIT(); asm volatile("" ::: "memory");
}
__device__ __forceinline__ void transpose_item_q2(const float* W, int N, int k0, int n0, unsigned char* WT, size_t dst_row0, int KP, float mul, LAS float* scr, int lane) {
#pragma unroll 8
    for (int i = 0; i < 32; ++i) { const int kk = 4 * i + (lane >> 4), n = lane & 15; scr[n * 132 + kk] = W[(size_t)(k0 + kk) * N + n0 + n]; }
    LDS_WAIT(); asm volatile("" ::: "memory");
    const int c = lane & 15;
#pragma unroll
    for (int j = 0; j < 4; ++j) { const int n = (lane >> 4) + 4 * j; const f32x4 a = *(const LAS f32x4*)(scr + n * 132 + 8 * c), b = *(const LAS f32x4*)(scr + n * 132 + 8 * c + 4); int w0 = 0, w1 = 0;
        w0 = __builtin_amdgcn_cvt_pk_fp8_f32(a[0] * mul, a[1] * mul, w0, false); w0 = __builtin_amdgcn_cvt_pk_fp8_f32(a[2] * mul, a[3] * mul, w0, true);
        w1 = __builtin_amdgcn_cvt_pk_fp8_f32(b[0] * mul, b[1] * mul, w1, false); w1 = __builtin_amdgcn_cvt_pk_fp8_f32(b[2] * mul, b[3] * mul, w1, true);
        *(u32x2*)(WT + (dst_row0 + n) * KP + k0 + 8 * c) = (u32x2){(unsigned)w0, (unsigned)w1}; }
    LDS_WAIT(); asm volatile("" ::: "memory");
}
__device__ __forceinline__ int fp8_scale_exp(const float* W, int stride, int lane) {
    float a = 0.f;
#pragma unroll
    for (int q = 0; q < 8; ++q) a += fabsf(W[(size_t)(lane * 8 + q) * stride]);
    a = wave_sum(a) * (1.0f / 512.f);
    int s = (a > 0.f) ? (int)rintf(-log2f(a)) : 0; return s < -24 ? -24 : (s > 24 ? 24 : s);
}

typedef const __attribute__((address_space(4))) Args* CArgs;
#define PHASE_ENV() \
    CArgs A = (CArgs)__builtin_amdgcn_kernarg_segment_ptr(); asm volatile("" : "+s"(A)); \
    int tid_l_ = (int)threadIdx.x, bid_l_ = (int)blockIdx.x, G_l_ = (int)gridDim.x; asm volatile("" : "+v"(tid_l_), "+s"(bid_l_), "+s"(G_l_)); \
    const int tid = tid_l_, lane = tid & 63, wave = __builtin_amdgcn_readfirstlane(tid >> 6), G = G_l_, bid = bid_l_, gw = bid * NWAVES + wave, NGW = G * NWAVES; (void)lane; (void)gw; (void)NGW; \
    unsigned char* ws = A->ws; \
    unsigned* ctl = (unsigned*)(ws + WS_CTL); (void)ctl; \
    float* lbt = (float*)(ws + WS_LBT); (void)lbt; \
    bf16_t* rwh = (bf16_t*)(ws + WS_RWH); bf16_t* rwl = (bf16_t*)(ws + WS_RWL); (void)rwh; (void)rwl; \
    bf16_t* win_t = (bf16_t*)(ws + WS_WIN); bf16_t* wout_t = (bf16_t*)(ws + WS_WOUT); bf16_t* wgu_t = (bf16_t*)(ws + WS_WGU); bf16_t* wdn_t = (bf16_t*)(ws + WS_WDN); (void)win_t; (void)wout_t; (void)wgu_t; (void)wdn_t; \
    bf16_t* xb = (bf16_t*)(ws + WS_XB); float* xres = (float*)(ws + WS_XRES); bf16_t* proj = (bf16_t*)(ws + WS_PROJ); bf16_t* mix = (bf16_t*)(ws + WS_MIX); (void)xb; (void)xres; (void)proj; (void)mix; \
    float* ybuf = (float*)(ws + WS_Y); bf16_t* ybf = (bf16_t*)(ws + WS_Y); (void)ybf; float* x1 = (float*)(ws + WS_X1); bf16_t* x1b = (bf16_t*)(ws + WS_X1B); unsigned char* hid = ws + WS_HID; unsigned char* wguq = ws + WS_WGU; unsigned char* wdnq = ws + WS_WDN; unsigned char* x1q = ws + WS_X1Q; unsigned char* xq = ws + WS_XQ; unsigned char* winq = ws + WS_WINQ; (void)xq; (void)winq; (void)wguq; (void)wdnq; (void)x1q; unsigned char* ysl = ws + WS_YS; (void)ybuf; (void)x1; (void)x1b; (void)hid; (void)ysl; \
    int* rtok = (int*)(ws + WS_RTOK); float* rgate = (float*)(ws + WS_RGATE); int* tslot = (int*)(ws + WS_TSLOT); (void)rtok; (void)rgate; (void)tslot; \
    float* odir = (float*)(ws + WS_ODIR); float* hdir = (float*)(ws + WS_HDIR); float* aub = (float*)(ws + WS_AU); (void)odir; (void)hdir; (void)aub; \
    bf16_t* oloc = (bf16_t*)(ws + WS_OLOC); bf16_t* qseg = (bf16_t*)(ws + WS_QSEG); float* sfin = (float*)(ws + WS_SFIN); float* dseg = (float*)(ws + WS_DSEG); float* lsum = (float*)(ws + WS_LSUM); bf16_t* lruw = (bf16_t*)(ws + WS_LRUW); (void)oloc; (void)qseg; (void)sfin; (void)dseg; (void)lsum; (void)lruw; \
    const float* xin = (l == 0) ? A->in[I_X] : (const float*)xres; float* xout = (l == NL - 1) ? A->out : xres; unsigned* cntg = ctl + CW_CNT + 1024 * l; (void)xin; (void)xout; (void)cntg

#define MOE_TABLES(sclp) do { __syncthreads(); \
    if (tid < 32) { tabcnt[tid] = (int)__hip_atomic_load(cntg + 32 * tid, __ATOMIC_RELAXED, __HIP_MEMORY_SCOPE_AGENT); tabscl[tid] = (sclp) ? ((const int*)(sclp))[tid] : 0; } \
    __syncthreads(); \
    if (tid == 0) { int s_ = 0; for (int e_ = 0; e_ < 32; ++e_) { tabpblk[e_] = s_; s_ += (tabcnt[e_] + 255) >> 8; } tabpblk[32] = s_; } \
    __syncthreads(); \
    for (int i_ = tid; i_ < tabpblk[32] && i_ < 1024; i_ += NTHR) { int e_ = 0; for (int q2_ = 1; q2_ < 32; ++q2_) e_ += (tabpblk[q2_] <= i_) ? 1 : 0; tabeb[i_] = (unsigned short)e_; }     \
    __syncthreads(); } while (0)

template <int PH> __global__ void __launch_bounds__(NTHR, 2) mk_fwd(Args args) {
    extern __shared__ __attribute__((aligned(16))) unsigned char lds_raw[];
    LAS unsigned char* lds = (LAS unsigned char*)lds_raw;
    const int tid = threadIdx.x, lane = tid & 63, wave = __builtin_amdgcn_readfirstlane(tid >> 6);
    const int G = gridDim.x, bid = blockIdx.x;
    const int gw = bid * NWAVES + wave, NGW = G * NWAVES;
    LAS int* tabcnt = (LAS int*)(lds + 131072 + 1024); LAS int* tabpblk = (LAS int*)(lds + 131072 + 1024 + 256); LAS int* tabscl = (LAS int*)(lds + 131072 + 1024 + 512); LAS unsigned short* tabeb = (LAS unsigned short*)(lds + 131072 + 6144);
    XcdBarrier bar; bar.bar = nullptr; bar.x = 0; bar.st = nullptr;
    if (PH == 0) {
        volatile LAS unsigned* bst = (volatile LAS unsigned*)(lds + LDS_BYTES - 16);
        if (tid == 0) { bst[0] = 0u; bst[1] = 0u; }
        __syncthreads();
        bar = xcd_barrier_post((unsigned*)(args.ws + WS_CTL) + CW_BAR, bst);
    }
#define GRID_BAR() do { if (PH == 0) xcd_barrier(bar); } while (0)
#ifndef PROBE_REP
#define PROBE_REP 0
#endif
#define REPS(k) (((PROBE_REP >> (k)) & 1) ? 2 : 1)

    for (int rep_ = 0; rep_ < REPS(0); ++rep_) if (PH == -1 || PH == 0) {
        const int l = 0; PHASE_ENV();
        LAS float* scr = (LAS float*)(lds + wave * 16384);
        { constexpr int per = 8 * 224; for (int it = gw; it < NL * per; it += NGW) { const int ll = it / per, r = it % per, kb = r / 224, nb = r % 224; const float* src = A->in[I_WIN] + (size_t)ll * D * INC;
            const int sx = fp8_scale_exp(src, 7177, lane); if (r == 0 && lane == 0) ((int*)ctl)[CW_SIN + ll] = sx;
            transpose_item_q2(src, INC, kb * 128, nb * 16, winq + (size_t)ll * INC * D, (size_t)nb * 16, D, exp2f((float)sx), scr, lane); } }
        { constexpr int per = 16 * 32; for (int it = gw; it < NL * per; it += NGW) { const int ll = it / per, r = it % per, kb = r / 32, nb = r % 32;
            const float* src = A->in[I_WOUT] + (size_t)ll * D * D; const int sx = fp8_scale_exp(src, 2039, lane); if (r == 0 && lane == 0) ((int*)ctl)[CW_SOUT + ll] = sx;
            transpose_item_q(src, D, kb * 64, nb * 32, (unsigned char*)wout_t + (size_t)ll * D * D, (size_t)nb * 32, D, exp2f((float)sx), scr, lane); } }
        for (int pe = gw >> 4; pe < NL * NE; pe += NGW >> 4) { const float* src = A->in[I_WGU] + (size_t)pe * D * 2048; const int sx = fp8_scale_exp(src, 4099, lane); const float mul = exp2f((float)sx);
            if ((gw & 15) == 0 && lane == 0) ((int*)ctl)[CW_SGU + pe] = sx;
            for (int r = gw & 15; r < 8 * 128; r += 16) { const int kb = r / 128, nb = r % 128; const int n0 = nb * 16, cc = n0 & 1023, isup = n0 >> 10; const size_t drow = (size_t)(cc >> 7) * 256 + (size_t)isup * 128 + (cc & 127);
                transpose_item_q2(src, 2048, kb * 128, n0, wguq + (size_t)pe * 2048 * D, drow, D, mul, scr, lane); } }
        for (int pe = gw >> 4; pe < NL * NE; pe += NGW >> 4) { const float* src = A->in[I_WDN] + (size_t)pe * DE * D; const int sx = fp8_scale_exp(src, 2051, lane); const float mul = exp2f((float)sx);
            if ((gw & 15) == 0 && lane == 0) ((int*)ctl)[CW_SDN + pe] = sx;
            for (int r = gw & 15; r < 8 * 64; r += 16) { const int kb = r / 64, nb = r % 64;
                transpose_item_q2(src, D, kb * 128, nb * 16, wdnq + (size_t)pe * D * DE, (size_t)nb * 16, DE, mul, scr, lane); } }
        for (int i = bid * NTHR + tid; i < NL * NE * D; i += G * NTHR) { const int ll = i / (NE * D), r = i % (NE * D), e = r / D, d = r % D; const float w = A->in[I_RW][(size_t)ll * D * NE + (size_t)d * NE + e];
            const unsigned h = f2bf(w); rwh[i] = (bf16_t)h; rwl[i] = (bf16_t)f2bf(w - bf2f(h)); }
        for (int i = bid * NTHR + tid; i < NL * 2 * 2 * LRH * LHD * LHD; i += G * NTHR) { const int ii = i & 63, jj = (i >> 6) & 63, hh = (i >> 12) & 7, wh = (i >> 15) & 1, dl = i >> 16;
            const float* src = wh ? A->in[I_WX] : A->in[I_WA]; lruw[i] = (bf16_t)f2bf(src[((size_t)dl * LRH + hh) * LHD * LHD + (size_t)ii * LHD + jj]); }
        for (size_t i = (size_t)bid * NTHR + tid; i < (size_t)T * D / 4; i += (size_t)G * NTHR) { const f32x4 v = ((const f32x4*)A->in[I_X])[i]; u32x2 o; o.x = pk2(v[0], v[1]); o.y = pk2(v[2], v[3]); ((u32x2*)xb)[i] = o; int q_ = 0; q_ = __builtin_amdgcn_cvt_pk_fp8_f32(v[0], v[1], q_, false); q_ = __builtin_amdgcn_cvt_pk_fp8_f32(v[2], v[3], q_, true); ((int*)xq)[i] = q_; }
        for (int i = bid * NTHR + tid; i < 2 * HGW; i += G * NTHR) { const float* p = A->in[I_HGLB] + i; float v[NL], mx = -3.0e38f;
#pragma unroll
            for (int q = 0; q < NL; ++q) { v[q] = p[(size_t)q * 2 * HGW]; mx = fmaxf(mx, v[q]); }
            float s = 0.f;
#pragma unroll
            for (int q = 0; q < NL; ++q) { v[q] = expf(v[q] - mx); s += v[q]; }
            float cum = 0.f;
#pragma unroll
            for (int q = 0; q < NL; ++q) { if (q > 0) cum += v[q] / s; lbt[(size_t)q * 2 * HGW + i] = fminf(fmaxf(cum, 0.f), 1.0f - 1e-6f); } }
    }
    GRID_BAR();

    const int l_lo = (PH == 0) ? 0 : args.l_lo, l_hi = (PH == 0) ? NL : args.l_hi;
    for (int l = l_lo; l < l_hi; ++l) {
#define IN(k) (PH == 0 || PH == (k))

        for (int rep_ = 0; rep_ < REPS(PH_PROJ); ++rep_) if (IN(PH_PROJ)) {
            if (rep_) GRID_BAR();
            PHASE_ENV();
            ProbProjT<true> p; p.A = xq; p.Bt = winq + (size_t)l * INC * D; p.sw = ((const int*)ctl)[CW_SIN + l]; p.C = proj; p.ldc = INC; p.S.init(T, INC, G, bid);
            pg8::gemm_phase(lds, p);
        }
        GRID_BAR();
        for (int rep_ = 0; rep_ < REPS(PH_HG); ++rep_) if (IN(PH_HG)) {
            if (rep_) GRID_BAR();
            PHASE_ENV();
            for (int item = bid; item < 256; item += G) hg_phase_a(lds, item, l, proj, lbt, oloc, qseg, sfin, dseg);
        }
        for (int rep_ = 0; rep_ < REPS(PH_LRUAU); ++rep_) if (IN(PH_LRUAU)) {
            if (rep_) GRID_BAR();
            PHASE_ENV();
            for (int it = bid; it < BATCH * 32; it += G)
                lru_pair<0>(lds, it >> 5, it & 31, proj, A->in[I_CONVW] + (size_t)l * 4 * LRW, A->in[I_CONVB] + (size_t)l * LRW, lruw + (size_t)l * 2 * 2 * LRH * LHD * LHD,
                               A->in[I_BA] + (size_t)l * 2 * LRW, A->in[I_BX] + (size_t)l * 2 * LRW, A->in[I_LAM] + (size_t)l * 2 * LRW, lsum, nullptr, nullptr);
        }
        GRID_BAR();
        for (int rep_ = 0; rep_ < REPS(PH_COMB); ++rep_) if (IN(PH_COMB)) {
            if (rep_) GRID_BAR();
            PHASE_ENV();
            const float* hgn = A->in[I_HGNORM] + (size_t)l * HGW;
            for (int cb = bid; cb < 256; cb += G) hg_phase_c(lds, cb, l, proj, oloc, qseg, sfin, dseg, hgn, mix);
            for (int it = bid; it < BATCH * 32; it += G)
                lru_pair<1>(lds, it >> 5, it & 31, proj, A->in[I_CONVW] + (size_t)l * 4 * LRW, A->in[I_CONVB] + (size_t)l * LRW, lruw + (size_t)l * 2 * 2 * LRH * LHD * LHD,
                               A->in[I_BA] + (size_t)l * 2 * LRW, A->in[I_BX] + (size_t)l * 2 * LRW, A->in[I_LAM] + (size_t)l * 2 * LRW, lsum, A->in[I_LRUNORM] + (size_t)l * LRW, mix);
        }
        GRID_BAR();
        for (int rep_ = 0; rep_ < REPS(PH_OUTG); ++rep_) if (IN(PH_OUTG)) {
            if (rep_) GRID_BAR();
            PHASE_ENV();
            ProbProjT<true> p; p.A = mix; p.Bt = (const unsigned char*)wout_t + (size_t)l * D * D; p.sw = ((const int*)ctl)[CW_SOUT + l]; p.sxa = MIX_SHIFT; p.C = ybf; p.ldc = D; p.S.init(T, D, G, bid);
            pg8::gemm_phase(lds, p);
        }
        GRID_BAR();
        if (IN(PH_LN1R)) {
            PHASE_ENV();
            LAS float* S1 = (LAS float*)lds;
            LAS float* S2 = S1 + 256;
            LAS float* PART = S2 + 256;
            constexpr int LN1_MAXT = 16;
            LAS int* hist = (LAS int*)(PART + 8 * 32 * 36); LAS int* basee = hist + 32; LAS int* sel = basee + 32; LAS float* gsel = (LAS float*)(sel + LN1_MAXT * 128);
            LAS float* G1L = gsel + LN1_MAXT * 128; LAS float* B1L = G1L + D;
            const float* rb = A->in[I_RB] + (size_t)l * NE;
            const int tk = lane & 15, kq = lane >> 4, colb = wave * 128 + kq * 8;
            bf16x8 wfh[2][4], wfl[2][4];
#pragma unroll
            for (int et = 0; et < 2; ++et)
#pragma unroll
                for (int ks = 0; ks < 4; ++ks) { const size_t off = (size_t)l * NE * D + (size_t)(et * 16 + tk) * D + colb + 32 * ks; wfh[et][ks] = *(const bf16x8*)(rwh + off); wfl[et][ks] = *(const bf16x8*)(rwl + off); }
            if (tid < 32) hist[tid] = 0;
            { const float* src_ = (tid < 256) ? (A->in[I_LN1G] + (size_t)l * D + 4 * tid) : (A->in[I_LN1B] + (size_t)l * D + 4 * (tid - 256)); *(LAS f32x4*)(G1L + 4 * tid) = *(const f32x4*)src_; }
            int tix = 0;
            for (int tile = bid; tile < T / 32; tile += G, ++tix) {
                f32x2 tv[2][4][4];
#pragma unroll
                for (int tt = 0; tt < 2; ++tt) { const size_t row = (size_t)tile * 32 + tt * 16 + tk;
#pragma unroll
                    for (int ks = 0; ks < 4; ++ks) { const u32x4 xw = *(const u32x4*)(xb + row * D + colb + 32 * ks), yw = *(const u32x4*)(ybf + row * D + colb + 32 * ks);
#pragma unroll
                        for (int q = 0; q < 4; ++q) tv[tt][ks][q] = (f32x2){bf2f(xw[q] & 0xffffu), bf2f(xw[q] >> 16)} * (f32x2){ALPHA, ALPHA} + (f32x2){bf2f(yw[q] & 0xffffu), bf2f(yw[q] >> 16)}; } }
                float mean[2], rstd[2];
#pragma unroll
                for (int tt = 0; tt < 2; ++tt) { f32x2 s2_ = {0.f, 0.f};
#pragma unroll
                    for (int ks = 0; ks < 4; ++ks)
#pragma unroll
                        for (int q = 0; q < 4; ++q) s2_ += tv[tt][ks][q];
                    float s_ = s2_[0] + s2_[1];
                    s_ += __shfl_xor(s_, 16); s_ += __shfl_xor(s_, 32); if (kq == 0) S1[wave * 32 + tt * 16 + tk] = s_; }
                __syncthreads();
#pragma unroll
                for (int tt = 0; tt < 2; ++tt) { float m_ = 0.f;
#pragma unroll
                    for (int ww = 0; ww < 8; ++ww) m_ += S1[ww * 32 + tt * 16 + tk];
                    mean[tt] = m_ * (1.f / D); f32x2 s2_ = {0.f, 0.f}; const f32x2 mn2_ = {mean[tt], mean[tt]};
#pragma unroll
                    for (int ks = 0; ks < 4; ++ks)
#pragma unroll
                        for (int q = 0; q < 4; ++q) { tv[tt][ks][q] -= mn2_; s2_ += tv[tt][ks][q] * tv[tt][ks][q]; }
                    float s_ = s2_[0] + s2_[1];
                    s_ += __shfl_xor(s_, 16); s_ += __shfl_xor(s_, 32); if (kq == 0) S2[wave * 32 + tt * 16 + tk] = s_; }
                __syncthreads();
                f32x4 acc[2][2];
#pragma unroll
                for (int et = 0; et < 2; ++et)
#pragma unroll
                    for (int tt = 0; tt < 2; ++tt) acc[et][tt] = (f32x4){0.f, 0.f, 0.f, 0.f};
#pragma unroll
                for (int tt = 0; tt < 2; ++tt) { float v_ = 0.f;
#pragma unroll
                    for (int ww = 0; ww < 8; ++ww) v_ += S2[ww * 32 + tt * 16 + tk];
                    rstd[tt] = rsqf_(v_ * (1.f / D) + LN_EPS); const size_t row = (size_t)tile * 32 + tt * 16 + tk;
#pragma unroll
                    for (int ks = 0; ks < 4; ++ks) { const f32x4 ga = *(const LAS f32x4*)(G1L + colb + 32 * ks), gb = *(const LAS f32x4*)(G1L + colb + 32 * ks + 4), ba_ = *(const LAS f32x4*)(B1L + colb + 32 * ks), bb_ = *(const LAS f32x4*)(B1L + colb + 32 * ks + 4);
                        float o[8]; unsigned hw[4], lw[4]; const f32x2 rs2_ = {rstd[tt], rstd[tt]};
#pragma unroll
                        for (int q = 0; q < 4; ++q) { const f32x2 g2_ = (q < 2) ? (f32x2){ga[2 * q], ga[2 * q + 1]} : (f32x2){gb[2 * q - 4], gb[2 * q - 3]}, b2_ = (q < 2) ? (f32x2){ba_[2 * q], ba_[2 * q + 1]} : (f32x2){bb_[2 * q - 4], bb_[2 * q - 3]};
                            const f32x2 o2_ = tv[tt][ks][q] * (rs2_ * g2_) + b2_; o[2 * q] = o2_[0]; o[2 * q + 1] = o2_[1];
                            hw[q] = pk2(o2_[0], o2_[1]); const f32x2 l2_ = o2_ - (f32x2){bf2f(hw[q] & 0xffffu), bf2f(hw[q] >> 16)}; lw[q] = pk2(l2_[0], l2_[1]); }
                        *(u32x4*)(x1b + row * D + colb + 32 * ks) = (u32x4){hw[0], hw[1], hw[2], hw[3]};
                        { int q0 = 0, q1 = 0; q0 = __builtin_amdgcn_cvt_pk_fp8_f32(o[0], o[1], q0, false); q0 = __builtin_amdgcn_cvt_pk_fp8_f32(o[2], o[3], q0, true); q1 = __builtin_amdgcn_cvt_pk_fp8_f32(o[4], o[5], q1, false); q1 = __builtin_amdgcn_cvt_pk_fp8_f32(o[6], o[7], q1, true);
                          *(u32x2*)(x1q + row * D + colb + 32 * ks) = (u32x2){(unsigned)q0, (unsigned)q1}; }
                        const bf16x8 xh = __builtin_bit_cast(bf16x8, (u32x4){hw[0], hw[1], hw[2], hw[3]}), xl = __builtin_bit_cast(bf16x8, (u32x4){lw[0], lw[1], lw[2], lw[3]});
#pragma unroll
                        for (int et = 0; et < 2; ++et) { acc[et][tt] = __builtin_amdgcn_mfma_f32_16x16x32_bf16(wfh[et][ks], xh, acc[et][tt], 0, 0, 0); acc[et][tt] = __builtin_amdgcn_mfma_f32_16x16x32_bf16(wfl[et][ks], xh, acc[et][tt], 0, 0, 0); acc[et][tt] = __builtin_amdgcn_mfma_f32_16x16x32_bf16(wfh[et][ks], xl, acc[et][tt], 0, 0, 0); } } }
#pragma unroll
                for (int et = 0; et < 2; ++et)
#pragma unroll
                    for (int tt = 0; tt < 2; ++tt) *(LAS f32x4*)(PART + (wave * 32 + tt * 16 + tk) * 36 + et * 16 + 4 * kq) = acc[et][tt];
                __syncthreads();
                {
                    const int tok = tid >> 4, sub = tid & 15; float l0 = rb[2 * sub], l1 = rb[2 * sub + 1];
#pragma unroll
                    for (int ww = 0; ww < 8; ++ww) { const f32x2 pv = *(const LAS f32x2*)(PART + (ww * 32 + tok) * 36 + 2 * sub); l0 += pv[0]; l1 += pv[1]; }
                    float tvv[4]; int tee[4];
#pragma unroll
                    for (int k = 0; k < 4; ++k) { const bool hi_ = l1 > l0; float bv = hi_ ? l1 : l0; int bi = hi_ ? 2 * sub + 1 : 2 * sub;
#define TOPK_STEP(ctrl) { const float ov = __builtin_bit_cast(float, __builtin_amdgcn_update_dpp(0, __builtin_bit_cast(int, bv), ctrl, 0xf, 0xf, false)); const int oi = __builtin_amdgcn_update_dpp(0, bi, ctrl, 0xf, 0xf, false); \
                            const bool take = (ov > bv) | ((ov == bv) & (oi < bi)); bv = take ? ov : bv; bi = take ? oi : bi; }
                        TOPK_STEP(0xB1) TOPK_STEP(0x4E) TOPK_STEP(0x141) TOPK_STEP(0x140)
#undef TOPK_STEP
                        tvv[k] = bv; tee[k] = bi; l0 = (bi == 2 * sub) ? -3.3e38f : l0; l1 = (bi == 2 * sub + 1) ? -3.3e38f : l1; }
                    if (sub < 4) { float wsum = 0.f, wk = 0.f; int ek = 0;
#pragma unroll
                        for (int k = 0; k < 4; ++k) { const float wv_ = exp_(tvv[k] - tvv[0]); wsum += wv_; if (k == sub) { wk = wv_; ek = tee[k]; } }
                        const int lr = atomicAdd((int*)(hist + ek), 1); sel[tix * 128 + tok * 4 + sub] = ek * 65536 + lr; gsel[tix * 128 + tok * 4 + sub] = wk / wsum; } }
            }
            __syncthreads();
            if (tid < 32) { const int hh = hist[tid]; basee[tid] = hh ? (int)atomicAdd(cntg + 32 * tid, (unsigned)hh) : 0; }
            __syncthreads();
            for (int i = tid; i < tix * 128; i += NTHR) { const int sv = sel[i], e = sv >> 16, rank = basee[e] + (sv & 65535); const int tok = (bid + (i >> 7) * G) * 32 + ((i & 127) >> 2); const int idx = e * ECAP + rank;
                rtok[idx] = tok; rgate[idx] = gsel[i]; tslot[tok * 4 + (i & 3)] = idx; }
            __syncthreads();
        }
        GRID_BAR();
        for (int rep_ = 0; rep_ < REPS(PH_MOE1); ++rep_) if (IN(PH_MOE1)) {
            if (rep_) GRID_BAR();
            PHASE_ENV();
            MOE_TABLES((const int*)ctl + CW_SGU + l * NE);
            ProbMoe1 p; p.X = x1q; p.Wgu = wguq + (size_t)l * NE * 2048 * D; p.bgu = A->in[I_BGU] + (size_t)l * NE * 2048; p.hid = hid; p.rtok = rtok; p.tb.cnt = tabcnt; p.tb.pblk = tabpblk; p.tb.scl = tabscl; p.tb.eb = tabeb; p.G = G; p.c = bid;
            pg8::gemm_phase(lds, p);
        }
        GRID_BAR();
        for (int rep_ = 0; rep_ < REPS(PH_MOE2); ++rep_) if (IN(PH_MOE2)) {
            if (rep_) GRID_BAR();
            PHASE_ENV();
            MOE_TABLES((const int*)ctl + CW_SDN + l * NE);
            ProbMoe2 p; p.hid = hid; p.Wdn = wdnq + (size_t)l * NE * D * DE; p.bdn = A->in[I_BDN] + (size_t)l * NE * D; p.ys = ysl; p.rgate = rgate; p.tb.cnt = tabcnt; p.tb.pblk = tabpblk; p.tb.scl = tabscl; p.tb.eb = tabeb; p.G = G; p.c = bid;
            pg8::gemm_phase(lds, p);
        }
        GRID_BAR();
        for (int rep_ = 0; rep_ < REPS(PH_LN2); ++rep_) if (IN(PH_LN2)) {
            if (rep_) GRID_BAR();
            PHASE_ENV();
            MOE_TABLES((const int*)nullptr);
            const float* g2 = A->in[I_LN2G] + (size_t)l * D; const float* b2 = A->in[I_LN2B] + (size_t)l * D;
            typedef int i32x4 __attribute__((ext_vector_type(4)));
            const int c0 = lane * 16; const int rstep = NGW;
#define LN2_CL(rp) ((rp) < T ? (rp) : T - 1)
#define LN2_TS(rp, TS) do { TS = *(const i32x4*)(tslot + (size_t)LN2_CL(rp) * 4); } while (0)
#define LN2_LOAD(rp, TS, YV, XV, GK) do { _Pragma("unroll") for (int k = 0; k < 4; ++k) { const int idx = TS[k]; GK[k] = rgate[idx]; const int e = idx >> 15, rank = idx & (ECAP - 1); \
                        YV[k] = *(const u32x4*)(ysl + (size_t)(tabpblk[e] * 256 + rank) * D + lane * 16); } \
                    XV[0] = *(const u32x4*)(x1b + (size_t)LN2_CL(rp) * D + lane * 16); XV[1] = *(const u32x4*)(x1b + (size_t)LN2_CL(rp) * D + lane * 16 + 8); } while (0)
#define LN2_COMPUTE(rp, YV, XV, GK_) do { const int row = (rp); float v[16]; float s_ = 0.f; const float GK[4] = {GK_[0] * (1.0f / YS_SCALE), GK_[1] * (1.0f / YS_SCALE), GK_[2] * (1.0f / YS_SCALE), GK_[3] * (1.0f / YS_SCALE)}; \
                    _Pragma("unroll") for (int q = 0; q < 4; ++q) { float m0 = 0.f, m1 = 0.f, m2 = 0.f, m3 = 0.f; \
                        _Pragma("unroll") for (int k = 0; k < 4; ++k) { const f32x2 lo2 = __builtin_amdgcn_cvt_pk_f32_fp8((int)YV[k][q], false), hi2 = __builtin_amdgcn_cvt_pk_f32_fp8((int)YV[k][q], true); \
                            m0 += GK[k] * lo2[0]; m1 += GK[k] * lo2[1]; m2 += GK[k] * hi2[0]; m3 += GK[k] * hi2[1]; } \
                        const unsigned xa = XV[q >> 1][(q & 1) * 2], xb_ = XV[q >> 1][(q & 1) * 2 + 1]; \
                        v[4 * q] = bf2f(xa & 0xffffu) * ALPHA + m0; v[4 * q + 1] = bf2f(xa >> 16) * ALPHA + m1; v[4 * q + 2] = bf2f(xb_ & 0xffffu) * ALPHA + m2; v[4 * q + 3] = bf2f(xb_ >> 16) * ALPHA + m3; \
                        s_ += (v[4 * q] + v[4 * q + 1]) + (v[4 * q + 2] + v[4 * q + 3]); } \
                    const float mean = wave_sum(s_) * (1.f / D); float s2 = 0.f; \
                    _Pragma("unroll") for (int q = 0; q < 16; ++q) { v[q] -= mean; s2 += v[q] * v[q]; } \
                    const float rstd = rsqf_(wave_sum(s2) * (1.f / D) + LN_EPS); float o[16]; \
                    _Pragma("unroll") for (int q4 = 0; q4 < 4; ++q4) { const f32x4 gg = g2r[q4], bb = b2r[q4]; _Pragma("unroll") for (int i = 0; i < 4; ++i) o[4 * q4 + i] = v[4 * q4 + i] * rstd * gg[i] + bb[i]; } \
                    if (l == NL - 1) { _Pragma("unroll") for (int q4 = 0; q4 < 4; ++q4) *(f32x4*)(A->out + (size_t)row * D + c0 + 4 * q4) = (f32x4){o[4 * q4], o[4 * q4 + 1], o[4 * q4 + 2], o[4 * q4 + 3]}; } \
                    else { *(u32x4*)(xb + (size_t)row * D + c0) = (u32x4){pk2(o[0], o[1]), pk2(o[2], o[3]), pk2(o[4], o[5]), pk2(o[6], o[7])}; *(u32x4*)(xb + (size_t)row * D + c0 + 8) = (u32x4){pk2(o[8], o[9]), pk2(o[10], o[11]), pk2(o[12], o[13]), pk2(o[14], o[15])}; \
                        int q4_[4]; _Pragma("unroll") for (int qq = 0; qq < 4; ++qq) { int t_ = 0; t_ = __builtin_amdgcn_cvt_pk_fp8_f32(o[4 * qq], o[4 * qq + 1], t_, false); t_ = __builtin_amdgcn_cvt_pk_fp8_f32(o[4 * qq + 2], o[4 * qq + 3], t_, true); q4_[qq] = t_; } \
                        *(u32x4*)(xq + (size_t)row * D + c0) = (u32x4){(unsigned)q4_[0], (unsigned)q4_[1], (unsigned)q4_[2], (unsigned)q4_[3]}; } } while (0)
            f32x4 g2r[4], b2r[4];
#pragma unroll
            for (int q4 = 0; q4 < 4; ++q4) { g2r[q4] = *(const f32x4*)(g2 + c0 + 4 * q4); b2r[q4] = *(const f32x4*)(b2 + c0 + 4 * q4); }
            int rowp = gw;
            i32x4 tsA0, tsA1, tsB0, tsB1;
            u32x4 yvA0[4], xvA0[2], yvA1[4], xvA1[2], yvB0[4], xvB0[2], yvB1[4], xvB1[2]; float gkA0[4], gkA1[4], gkB0[4], gkB1[4];
            LN2_TS(rowp, tsA0); LN2_TS(rowp + rstep, tsA1); LN2_TS(rowp + 2 * rstep, tsB0); LN2_TS(rowp + 3 * rstep, tsB1);
            LN2_LOAD(rowp, tsA0, yvA0, xvA0, gkA0);
            LN2_LOAD(rowp + rstep, tsA1, yvA1, xvA1, gkA1);
            for (; rowp < T; rowp += 4 * rstep) {
                LN2_LOAD(rowp + 2 * rstep, tsB0, yvB0, xvB0, gkB0);
                LN2_LOAD(rowp + 3 * rstep, tsB1, yvB1, xvB1, gkB1);
                LN2_TS(rowp + 4 * rstep, tsA0); LN2_TS(rowp + 5 * rstep, tsA1);
                LN2_COMPUTE(rowp, yvA0, xvA0, gkA0);
                if (rowp + rstep < T) LN2_COMPUTE(rowp + rstep, yvA1, xvA1, gkA1);
                LN2_LOAD(rowp + 4 * rstep, tsA0, yvA0, xvA0, gkA0);
                LN2_LOAD(rowp + 5 * rstep, tsA1, yvA1, xvA1, gkA1);
                LN2_TS(rowp + 6 * rstep, tsB0); LN2_TS(rowp + 7 * rstep, tsB1);
                if (rowp + 2 * rstep < T) LN2_COMPUTE(rowp + 2 * rstep, yvB0, xvB0, gkB0);
                if (rowp + 3 * rstep < T) LN2_COMPUTE(rowp + 3 * rstep, yvB1, xvB1, gkB1);
            }
#undef LN2_TS
#undef LN2_CL
#undef LN2_LOAD
#undef LN2_COMPUTE
        }
        if (l + 1 < l_hi) GRID_BAR();
#undef IN
    }
}

extern "C" void kernel_launch(void* const* d_in, const int* in_sizes, int n_in, void* d_out, int out_size, void* d_ws, size_t ws_size, hipStream_t stream) {
    static int grid = 0;
    if (grid == 0) {
        if (n_in != 23 || out_size != T * D || ws_size < WS_END) { fprintf(stderr, "kernel_launch: unexpected shapes (n_in %d, out %d, ws %zu)\n", n_in, out_size, ws_size); grid = -1; return; }
        int dev = 0, cus = 0;
        if (hipGetDevice(&dev) != hipSuccess || hipDeviceGetAttribute(&cus, hipDeviceAttributeMultiprocessorCount, dev) != hipSuccess) { grid = -1; return; }
        bool ok = true;
#define SETA(k) ok = ok && (hipFuncSetAttribute((const void*)mk_fwd<k>, hipFuncAttributeMaxDynamicSharedMemorySize, LDS_BYTES) == hipSuccess)
#ifdef MULTI_LAUNCH
        SETA(0); SETA(-1); SETA(PH_PROJ); SETA(PH_HG); SETA(PH_LRUAU); SETA(PH_COMB); SETA(PH_OUTG); SETA(PH_LN1R); SETA(PH_MOE1); SETA(PH_MOE2); SETA(PH_LN2);
#else
        SETA(0);
#endif
#undef SETA
        if (!ok) { fprintf(stderr, "kernel_launch: hipFuncSetAttribute failed\n"); grid = -1; return; }
        (void)hipGetLastError();
        grid = cus;
    }
    if (grid < 0) return;
    (void)hipMemsetAsync((char*)d_ws + WS_CTL, 0, CTL_BYTES, stream);
    Args a{};
    for (int i = 0; i < 23; ++i) a.in[i] = (const float*)d_in[i];
    a.out = (float*)d_out; a.ws = (unsigned char*)d_ws;
    a.l_lo = 0; a.l_hi = NL; a.ph_lo = 0; a.ph_hi = PH_END; a.pro = 1; a.pad = 0;
#ifdef MULTI_LAUNCH
    hipLaunchKernelGGL(mk_fwd<-1>, dim3(grid), dim3(NTHR), LDS_BYTES, stream, a);
    for (int l = 0; l < NL; ++l) {
        a.l_lo = l; a.l_hi = l + 1;
        hipLaunchKernelGGL(mk_fwd<PH_PROJ>, dim3(grid), dim3(NTHR), LDS_BYTES, stream, a);
        hipLaunchKernelGGL(mk_fwd<PH_HG>, dim3(grid), dim3(NTHR), LDS_BYTES, stream, a);
        hipLaunchKernelGGL(mk_fwd<PH_LRUAU>, dim3(grid), dim3(NTHR), LDS_BYTES, stream, a);
        hipLaunchKernelGGL(mk_fwd<PH_COMB>, dim3(grid), dim3(NTHR), LDS_BYTES, stream, a);
        hipLaunchKernelGGL(mk_fwd<PH_OUTG>, dim3(grid), dim3(NTHR), LDS_BYTES, stream, a);
        hipLaunchKernelGGL(mk_fwd<PH_LN1R>, dim3(grid), dim3(NTHR), LDS_BYTES, stream, a);
        hipLaunchKernelGGL(mk_fwd<PH_MOE1>, dim3(grid), dim3(NTHR), LDS_BYTES, stream, a);
        hipLaunchKernelGGL(mk_fwd<PH_MOE2>, dim3(grid), dim3(NTHR), LDS_BYTES, stream, a);
        hipLaunchKernelGGL(mk_fwd<PH_LN2>, dim3(grid), dim3(NTHR), LDS_BYTES, stream, a);
    }
#else
    hipLaunchKernelGGL(mk_fwd<0>, dim3(grid), dim3(NTHR), LDS_BYTES, stream, a);
#endif
}
```
